# Optimizing an MI355X kernel written in HIP

```python
import jax, jax.numpy as jnp
from jax import lax
import numpy as np

D_MODEL = 4096
BATCH = 2
SEQ = 8192
DEPTH = 2

CHUNK = 64
EPS = 1e-6
CONV_W = 4
HG_DK = 128
HG_DV = 128
HG_HEADS = D_MODEL // HG_DK
HG_WIDTH = HG_HEADS * HG_DK
LRU_WIDTH = D_MODEL
LRU_BLOCK = 128
LRU_BLOCKS = LRU_WIDTH // LRU_BLOCK
LRU_C = 8.0
EVEN_IN = 4 * HG_WIDTH + 2 * LRU_WIDTH
EVEN_MIX = HG_WIDTH + LRU_WIDTH
SSD_INNER = 2 * D_MODEL
SSD_HEADDIM = 64
SSD_HEADS = SSD_INNER // SSD_HEADDIM
SSD_GROUPS = 8
SSD_HPG = SSD_HEADS // SSD_GROUPS
SSD_STATE = 128
SSD_CONV_DIM = SSD_INNER + 2 * SSD_GROUPS * SSD_STATE
ODD_IN = SSD_INNER + SSD_CONV_DIM + SSD_HEADS
N_EVEN = (DEPTH + 1) // 2
N_ODD = DEPTH // 2

kernel_name = "hybrid_hgrn2_rglru_mamba2_trunk"


def rmsnorm(x, w):
    xf = x.astype(jnp.float32)
    y = xf * lax.rsqrt(jnp.mean(xf * xf, axis=-1, keepdims=True) + EPS)
    return y * w.astype(jnp.float32)


def causal_conv(x, w, b):
    k_w = w.shape[0]
    s = x.shape[1]
    xp = jnp.pad(x, ((0, 0), (k_w - 1, 0), (0, 0)))
    out = b.astype(jnp.float32) + xp[:, 0:s] * w[0]
    for k in range(1, k_w):
        out = out + xp[:, k:k + s] * w[k]
    return out


def hgrn2(q_pre, f_pre, i_val, lb):
    bsz, s, _ = q_pre.shape
    n = s // CHUNK
    q = jax.nn.silu(q_pre.astype(jnp.float32))
    z = f_pre.astype(jnp.float32)
    lb = lb.astype(jnp.float32)
    logf = jnp.logaddexp(jnp.log(lb), jnp.log1p(-lb) + jax.nn.log_sigmoid(z))
    k = (1.0 - lb) * jax.nn.sigmoid(-z)

    def heads(t, d):
        return t.reshape(bsz, n, CHUNK, HG_HEADS, d).transpose(0, 3, 1, 2, 4)

    q, k, logf = heads(q, HG_DK), heads(k, HG_DK), heads(logf, HG_DK)
    v = heads(i_val.astype(jnp.float32), HG_DV)
    b = jnp.cumsum(logf, axis=3)
    ref = b[:, :, :, CHUNK // 2 - 1:CHUNK // 2]
    q_in = q * jnp.exp(b - ref)
    k_in = k * jnp.exp(ref - b)
    scores = jnp.einsum('bhnld,bhnsd->bhnls', q_in, k_in)
    causal = jnp.tril(jnp.ones((CHUNK, CHUNK), dtype=bool))
    scores = jnp.where(causal, scores, 0.0)
    o_intra = jnp.einsum('bhnls,bhnsv->bhnlv', scores, v)
    q_out = q * jnp.exp(b)
    k_st = k * jnp.exp(b[:, :, :, -1:] - b)
    g_last = jnp.exp(b[:, :, :, -1])

    def step(state, inp):
        qo, ks, vv, gl = inp
        o = jnp.einsum('bhld,bhdv->bhlv', qo, state)
        state = state * gl[..., None] + jnp.einsum('bhld,bhlv->bhdv', ks, vv)
        return state, o

    s0 = jnp.zeros((bsz, HG_HEADS, HG_DK, HG_DV), jnp.float32)
    xs = (jnp.moveaxis(q_out, 2, 0), jnp.moveaxis(k_st, 2, 0),
          jnp.moveaxis(v, 2, 0), jnp.moveaxis(g_last, 2, 0))
    _, o_inter = lax.scan(step, s0, xs)
    o = o_intra + jnp.moveaxis(o_inter, 0, 2)
    return o.transpose(0, 2, 3, 1, 4).reshape(bsz, s, HG_HEADS * HG_DV)


def _lin_combine(c1, c2):
    a1, b1 = c1
    a2, b2 = c2
    return a1 * a2, a2 * b1 + b2


def rglru(x, wa, ba, wx, bx, lam):
    bsz, s, _ = x.shape
    xf = x.astype(jnp.float32)
    xb = xf.reshape(bsz, s, LRU_BLOCKS, LRU_BLOCK)
    r = jax.nn.sigmoid(jnp.einsum('bsnj,njk->bsnk', xb, wa).reshape(bsz, s, LRU_WIDTH) + ba)
    ig = jax.nn.sigmoid(jnp.einsum('bsnj,njk->bsnk', xb, wx).reshape(bsz, s, LRU_WIDTH) + bx)
    log_a = -LRU_C * r * jax.nn.softplus(-lam.astype(jnp.float32))
    a = jnp.exp(log_a)
    u = jnp.sqrt(-jnp.expm1(2.0 * log_a)) * (ig * xf)
    _, h = lax.associative_scan(_lin_combine, (a, u), axis=1)
    return h


def ssd(x, dt, a_log, bm, cm, d_skip):
    bsz, s = x.shape[:2]
    n = s // CHUNK
    a = -jnp.exp(a_log.astype(jnp.float32))
    adt = (dt * a).reshape(bsz, n, CHUNK, SSD_GROUPS, SSD_HPG)
    cs = jnp.cumsum(adt, axis=2)
    xg = x.reshape(bsz, n, CHUNK, SSD_GROUPS, SSD_HPG, SSD_HEADDIM)
    xdt = xg * dt.reshape(bsz, n, CHUNK, SSD_GROUPS, SSD_HPG)[..., None]
    bc = bm.reshape(bsz, n, CHUNK, SSD_GROUPS, SSD_STATE)
    cc = cm.reshape(bsz, n, CHUNK, SSD_GROUPS, SSD_STATE)
    seg = cs[:, :, :, None] - cs[:, :, None, :]
    causal = jnp.tril(jnp.ones((CHUNK, CHUNK), dtype=bool))[:, :, None, None]
    decay = jnp.exp(jnp.where(causal, seg, -jnp.inf))
    cb = jnp.einsum('bnlgk,bnmgk->bnlmg', cc, bc)
    y_diag = jnp.einsum('bnlmgh,bnmghp->bnlghp', cb[..., None] * decay, xdt)
    dec_out = jnp.exp(cs)
    dec_st = jnp.exp(cs[:, :, -1:] - cs)
    g_last = jnp.exp(cs[:, :, -1])

    def step(state, inp):
        c_c, b_c, x_c, d_o, d_s, g_l = inp
        y = jnp.einsum('blgk,bghpk,blgh->blghp', c_c, state, d_o)
        state = state * g_l[..., None, None] + jnp.einsum('blgk,blgh,blghp->bghpk', b_c, d_s, x_c)
        return state, y

    s0 = jnp.zeros((bsz, SSD_GROUPS, SSD_HPG, SSD_HEADDIM, SSD_STATE), jnp.float32)
    xs = tuple(jnp.moveaxis(t, 1, 0) for t in (cc, bc, xdt, dec_out, dec_st, g_last))
    _, y_off = lax.scan(step, s0, xs)
    y = y_diag + jnp.moveaxis(y_off, 0, 1)
    y = y + xg * d_skip.reshape(SSD_GROUPS, SSD_HPG)[..., None]
    return y.reshape(bsz, s, SSD_INNER)


def even_layer(h, w_in, lb, a_norm_w, conv_w, conv_b, wa, ba, wx, bx, lam, w_out):
    proj = (h @ w_in).astype(jnp.float32)
    w = HG_WIDTH
    q = proj[..., 0:w]
    f = proj[..., w:2 * w]
    iv = proj[..., 2 * w:3 * w]
    g_a = proj[..., 3 * w:4 * w]
    x_b = proj[..., 4 * w:4 * w + LRU_WIDTH]
    g_b = proj[..., 4 * w + LRU_WIDTH:]
    o_a = rmsnorm(hgrn2(q, f, iv, lb), a_norm_w) * jax.nn.silu(g_a)
    o_b = rglru(causal_conv(x_b, conv_w, conv_b), wa, ba, wx, bx, lam) * jax.nn.silu(g_b)
    mix = jnp.concatenate([o_a, o_b], axis=-1).astype(h.dtype)
    return mix @ w_out


def odd_layer(h, w_in, conv_w, conv_b, dt_bias, a_log, d_skip, norm_w, w_out):
    bsz, s, _ = h.shape
    proj = (h @ w_in).astype(jnp.float32)
    z = proj[..., 0:SSD_INNER]
    xbc = proj[..., SSD_INNER:SSD_INNER + SSD_CONV_DIM]
    dt = proj[..., SSD_INNER + SSD_CONV_DIM:]
    xbc = jax.nn.silu(causal_conv(xbc, conv_w, conv_b))
    gk = SSD_GROUPS * SSD_STATE
    xs = xbc[..., 0:SSD_INNER].reshape(bsz, s, SSD_HEADS, SSD_HEADDIM)
    bm = xbc[..., SSD_INNER:SSD_INNER + gk].reshape(bsz, s, SSD_GROUPS, SSD_STATE)
    cm = xbc[..., SSD_INNER + gk:].reshape(bsz, s, SSD_GROUPS, SSD_STATE)
    dt = jax.nn.softplus(dt + dt_bias.astype(jnp.float32))
    y = ssd(xs, dt, a_log, bm, cm, d_skip.astype(jnp.float32))
    y = rmsnorm(y * jax.nn.silu(z), norm_w).astype(h.dtype)
    return y @ w_out


def setup_inputs(seed: int = 0) -> dict:
    key = jax.random.key(seed)
    ks = jax.random.split(key, 24)
    f32 = jnp.float32

    def nrm(k, shape, scale):
        return jax.random.normal(k, shape, f32) * scale

    x = jax.random.normal(ks[0], (BATCH, SEQ, D_MODEL), f32)
    norm_w = 1.0 + nrm(ks[1], (DEPTH, D_MODEL), 0.01)
    final_norm_w = 1.0 + nrm(ks[2], (D_MODEL,), 0.01)
    e_w_in = nrm(ks[3], (N_EVEN, D_MODEL, EVEN_IN), D_MODEL ** -0.5)
    lb_logits = nrm(ks[4], (DEPTH + 1, HG_WIDTH), 0.1)
    e_a_norm_w = 1.0 + nrm(ks[5], (N_EVEN, HG_WIDTH), 0.01)
    e_conv_w = nrm(ks[6], (N_EVEN, CONV_W, LRU_WIDTH), CONV_W ** -0.5)
    e_conv_b = nrm(ks[7], (N_EVEN, LRU_WIDTH), 0.01)
    e_wa = nrm(ks[8], (N_EVEN, LRU_BLOCKS, LRU_BLOCK, LRU_BLOCK), LRU_BLOCK ** -0.5)
    e_ba = nrm(ks[9], (N_EVEN, LRU_WIDTH), 0.01)
    e_wx = nrm(ks[10], (N_EVEN, LRU_BLOCKS, LRU_BLOCK, LRU_BLOCK), LRU_BLOCK ** -0.5)
    e_bx = nrm(ks[11], (N_EVEN, LRU_WIDTH), 0.01)
    a_pow = jax.random.uniform(ks[12], (N_EVEN, LRU_WIDTH), f32, 0.9, 0.999)
    a0 = a_pow ** (1.0 / LRU_C)
    e_lambda = jnp.log(a0) - jnp.log1p(-a0)
    e_w_out = nrm(ks[13], (N_EVEN, EVEN_MIX, D_MODEL), EVEN_MIX ** -0.5)
    o_w_in = nrm(ks[14], (N_ODD, D_MODEL, ODD_IN), D_MODEL ** -0.5)
    o_conv_w = nrm(ks[15], (N_ODD, CONV_W, SSD_CONV_DIM), CONV_W ** -0.5)
    o_conv_b = nrm(ks[16], (N_ODD, SSD_CONV_DIM), 0.01)
    dt0 = jnp.exp(jax.random.uniform(ks[17], (N_ODD, SSD_HEADS), f32, np.log(1e-3), np.log(1e-1)))
    o_dt_bias = dt0 + jnp.log(-jnp.expm1(-dt0))
    o_a_log = jnp.log(jax.random.uniform(ks[18], (N_ODD, SSD_HEADS), f32, 1.0, 16.0))
    o_d = 1.0 + nrm(ks[19], (N_ODD, SSD_HEADS), 0.1)
    o_norm_w = 1.0 + nrm(ks[20], (N_ODD, SSD_INNER), 0.01)
    o_w_out = nrm(ks[21], (N_ODD, SSD_INNER, D_MODEL), SSD_INNER ** -0.5)
    return {"x": x, "norm_w": norm_w, "e_w_in": e_w_in, "lb_logits": lb_logits,
            "e_a_norm_w": e_a_norm_w, "e_conv_w": e_conv_w, "e_conv_b": e_conv_b,
            "e_wa": e_wa, "e_ba": e_ba, "e_wx": e_wx, "e_bx": e_bx, "e_lambda": e_lambda,
            "e_w_out": e_w_out, "o_w_in": o_w_in, "o_conv_w": o_conv_w, "o_conv_b": o_conv_b,
            "o_dt_bias": o_dt_bias, "o_a_log": o_a_log, "o_d": o_d, "o_norm_w": o_norm_w,
            "o_w_out": o_w_out, "final_norm_w": final_norm_w}


def reference(x, norm_w, e_w_in, lb_logits, e_a_norm_w, e_conv_w, e_conv_b, e_wa, e_ba,
              e_wx, e_bx, e_lambda, e_w_out, o_w_in, o_conv_w, o_conv_b, o_dt_bias,
              o_a_log, o_d, o_norm_w, o_w_out, final_norm_w):
    lb_all = jnp.cumsum(jax.nn.softmax(lb_logits.astype(jnp.float32), axis=0), axis=0)
    h = x
    for l in range(DEPTH):
        hn = rmsnorm(h, norm_w[l]).astype(x.dtype)
        j = l // 2
        if l % 2 == 0:
            out = even_layer(hn, e_w_in[j], lb_all[l], e_a_norm_w[j], e_conv_w[j], e_conv_b[j],
                             e_wa[j], e_ba[j], e_wx[j], e_bx[j], e_lambda[j], e_w_out[j])
        else:
            out = odd_layer(hn, o_w_in[j], o_conv_w[j], o_conv_b[j], o_dt_bias[j], o_a_log[j],
                            o_d[j], o_norm_w[j], o_w_out[j])
        h = h + out.astype(x.dtype)
    return rmsnorm(h, final_norm_w).astype(x.dtype)
```

```cpp
#include <hip/hip_runtime.h>
#include <cstdio>
#include <cstdint>

#ifndef MODE_MULTI
#define MODE_MULTI 0
#endif
#ifndef NAIVE_MIX0
#define NAIVE_MIX0 0
#endif
#ifndef NAIVE_MIX1
#define NAIVE_MIX1 0
#endif

#ifndef PROBE_REP
#define PROBE_REP 0
#endif

#ifndef PROBE_VAR
#define PROBE_VAR 0
#endif
#define GAS __attribute__((address_space(1)))
#define LAS __attribute__((address_space(3)))
#define DI __device__ __forceinline__
typedef unsigned short bf16;
typedef unsigned u32x4 __attribute__((ext_vector_type(4)));
typedef unsigned u32x2 __attribute__((ext_vector_type(2)));
typedef float f32x4 __attribute__((ext_vector_type(4)));
typedef float f32x2 __attribute__((ext_vector_type(2)));
typedef short bf16x8 __attribute__((ext_vector_type(8)));
typedef __bf16 bf16v2 __attribute__((ext_vector_type(2)));
typedef unsigned char uchar;

constexpr int SEQ = 8192, M = 16384, D = 4096;
constexpr int N1 = 24576, K2 = 8192, N3 = 18560, N3P = 18688, N3DT = 18432, K4 = 8192;
constexpr int NCH = SEQ / 64;
constexpr int C_Q = 0, C_F = 4096, C_I = 8192, C_GA = 12288, C_XB = 16384, C_GB = 20480;
constexpr int C_Z = 0, C_X = 8192, C_B = 16384, C_C = 17408, C_DT = 18432;
constexpr float EPS = 1e-6f;
constexpr float LOG2E = 1.4426950408889634f;

constexpr size_t MiB = 1u << 20;
constexpr size_t WS_CTL = 0, CTL_ZERO_BYTES = 1 * MiB;
constexpr size_t WS_W1 = 1 * MiB;
constexpr size_t WS_W2 = 193 * MiB;
constexpr size_t WS_W3 = 257 * MiB;
constexpr size_t WS_W4 = 403 * MiB;
constexpr size_t WS_HN = 467 * MiB;
constexpr size_t WS_PROJ = 595 * MiB;
constexpr size_t WS_END = 1432 * MiB;
constexpr int CW_TMO = 0, CW_CODE = 1;
constexpr int CW_BAR = 4096;
constexpr int CW_SSQA = 16384, CW_SSQH1 = 32768, CW_SSQY = 49152, CW_SSQH2 = 65536;
constexpr int CW_DUMMY = 81920;
constexpr int CW_PANEL = 98304;
static_assert((CW_PANEL + 2 * 64 * 64) * 4 <= (int)CTL_ZERO_BYTES, "ctl");
constexpr size_t WS_PREP = 1179 * MiB;
constexpr size_t WS_PG = 1363 * MiB, WS_GL = 1427 * MiB;
constexpr size_t WS_DUMMY1 = 1280 * MiB;

constexpr int RING_BYTES = 131072;
constexpr int LDS_BYTES = 147456;
constexpr int LDSCTL_OFF = LDS_BYTES - 512, MISC_OFF = LDSCTL_OFF + 320;

DI float bflo(unsigned w) { return __uint_as_float(w << 16); }
DI float bfhi(unsigned w) { return __uint_as_float(w & 0xffff0000u); }
DI float bf2f(unsigned h) { return __uint_as_float(h << 16); }
DI unsigned pk2(float lo, float hi) { f32x2 v = {lo, hi}; bf16v2 b = __builtin_convertvector(v, bf16v2); return __builtin_bit_cast(unsigned, b); }
DI float fexp2(float x) { return __builtin_amdgcn_exp2f(x); }
DI float flog2(float x) { return __builtin_amdgcn_logf(x); }
DI float frcp(float x) { return __builtin_amdgcn_rcpf(x); }
DI float fsigmoid(float x) { return frcp(1.0f + fexp2(-LOG2E * x)); }
DI float fsilu(float x) { return x * fsigmoid(x); }
#define LDS_BAR() do { asm volatile("s_waitcnt lgkmcnt(0)" ::: "memory"); __builtin_amdgcn_s_barrier(); asm volatile("" ::: "memory"); } while (0)
#define VM_WAIT() asm volatile("s_waitcnt vmcnt(0)" ::: "memory")
DI float fq_sum(float x) {
    auto r = __builtin_amdgcn_permlane16_swap(__float_as_uint(x), __float_as_uint(x), false, false); x = __uint_as_float(r[0]) + __uint_as_float(r[1]);
    auto q = __builtin_amdgcn_permlane32_swap(__float_as_uint(x), __float_as_uint(x), false, false); return __uint_as_float(q[0]) + __uint_as_float(q[1]);
}
DI float wave_sum(float v) {
#pragma unroll
    for (int o = 1; o < 64; o <<= 1) v += __shfl_xor(v, o);
    return v;
}
#define XB_TMO      128
#define XB_XCNT(j)  (256  + 64 * (j))
#define XB_XSUB(j)  (1280 + 64 * (j))
#define XB_XGEN(j)  (2304 + 64 * (j))
#define XB_TOP      3328
#define XB_TOPGEN   3392
#define XCD_BAR_WORDS 3456
#define XB_SPIN_CAP (1u << 18)

__device__ __forceinline__ unsigned xb_ld(unsigned* p)              { return __hip_atomic_load(p, __ATOMIC_RELAXED, __HIP_MEMORY_SCOPE_AGENT); }
__device__ __forceinline__ unsigned xb_add(unsigned* p, unsigned v) { return __hip_atomic_fetch_add(p, v, __ATOMIC_RELAXED, __HIP_MEMORY_SCOPE_AGENT); }
__device__ __forceinline__ unsigned xb_xcc_id() { return (unsigned)__builtin_amdgcn_s_getreg((3 << 11) | 20) & 0xFu; }
#define XB_SPIN(cond, bar) do { unsigned _sp = 0; while (cond) { __builtin_amdgcn_s_sleep(1); \
    if ((++_sp & 255u) == 0u) { if (xb_ld(&(bar)[XB_TMO])) break; if (_sp > XB_SPIN_CAP) { atomicAdd(&(bar)[XB_TMO], 1u); break; } } } } while (0)

struct XcdBarrier {
    unsigned* bar; unsigned x;
    volatile LAS unsigned* st;
};

__device__ __forceinline__ XcdBarrier xcd_barrier_post(unsigned* bar, volatile LAS unsigned* st) {
    XcdBarrier b; b.bar = bar; b.x = xb_xcc_id(); b.st = st;
    if (threadIdx.x == 0) (void)xb_add(&bar[XB_XCNT(b.x)], 1u);
    return b;
}
__device__ __forceinline__ void xcd_barrier_complete(unsigned* bar, unsigned x, unsigned& nloc, unsigned& nx) {
    const unsigned G = gridDim.x * gridDim.y * gridDim.z;
    unsigned sum, cnt, mine, sp = 0u;
    for (;;) {
        sum = 0u; cnt = 0u; mine = 0u;
#pragma unroll
        for (unsigned j = 0; j < 16; ++j) { const unsigned c = xb_ld(&bar[XB_XCNT(j)]); sum += c; cnt += (c > 0u) ? 1u : 0u; mine = (j == x) ? c : mine; }
        if (sum == G) break;
        __builtin_amdgcn_s_sleep(1);
        if ((++sp & 255u) == 0u) { if (xb_ld(&bar[XB_TMO])) break; if (sp > XB_SPIN_CAP) { atomicAdd(&bar[XB_TMO], 1u); break; } }
    }
    nloc = mine > 0u ? mine : 1u; nx = cnt > 0u ? cnt : 1u;
}

__device__ __forceinline__ void xcd_barrier(const XcdBarrier& b) {
    asm volatile("s_waitcnt vmcnt(0)" ::: "memory");
    __syncthreads();
    if (threadIdx.x == 0) {
        unsigned* bar = b.bar;
        __builtin_amdgcn_s_waitcnt(0);
        unsigned nloc = b.st[0], nx = b.st[1];
        if (nloc == 0u) { xcd_barrier_complete(bar, b.x, nloc, nx); b.st[0] = nloc; b.st[1] = nx; }
        const unsigned old = xb_add(&bar[XB_XSUB(b.x)], 1u);
        const unsigned gen = old / nloc;
        if (old + 1u == (gen + 1u) * nloc) {
            __builtin_amdgcn_fence(__ATOMIC_RELEASE, "agent");
            asm volatile("s_waitcnt vmcnt(0)" ::: "memory");
            const unsigned og = xb_add(&bar[XB_TOP], 1u);
            const unsigned tg = og / nx;
            if (og + 1u == (tg + 1u) * nx) xb_add(&bar[XB_TOPGEN], 1u);
            else XB_SPIN(xb_ld(&bar[XB_TOPGEN]) == tg, bar);
            __builtin_amdgcn_fence(__ATOMIC_ACQUIRE, "agent");
            xb_add(&bar[XB_XGEN(b.x)], 1u);
            asm volatile("s_waitcnt vmcnt(0)" ::: "memory");
        } else {
            XB_SPIN(xb_ld(&bar[XB_XGEN(b.x)]) == gen, bar);
            __builtin_amdgcn_fence(__ATOMIC_ACQUIRE, "agent");
            asm volatile("s_waitcnt vmcnt(0)" ::: "memory");
        }
    }
    __syncthreads();
}
namespace pg8 {
#define PG8_LAS __attribute__((address_space(3)))
typedef unsigned short bf16_t;
typedef short bf16x8 __attribute__((ext_vector_type(8)));
typedef float f32x4 __attribute__((ext_vector_type(4)));
typedef unsigned u32x4 __attribute__((ext_vector_type(4)));
constexpr int BM = 256, BK = 64, HALF = 128, HTB = HALF * BK * 2  , STAGE_BYTES = 8 * HTB, NXCD = 8, WGM = 8;

__host__ __device__ __forceinline__ int lds_byte(int r, int c) { const int st = (r >> 4) * 2 + (c >> 5), rr = r & 15, cc = c & 31, ob = rr * 64 + cc * 2; return st * 1024 + (ob ^ (((ob >> 9) & 1) << 5)); }
__host__ __device__ __forceinline__ void stage_rc(int b, int& R, int& C) { const int st = b / 1024, sb = b % 1024, swz = sb ^ (((sb >> 9) & 1) << 5); R = (st >> 1) * 16 + swz / 64; C = (st & 1) * 32 + (swz % 64) / 2; }
__host__ __device__ __forceinline__ int perm32(int rho) { const int n = rho >> 4, i = rho & 15; return 8 * (i >> 2) + 4 * n + (i & 3); }

struct Unit { int pm, pn, kq; };
struct Gemm { const bf16_t* A; const bf16_t* Bt; int M, N, K, lda, ldb, kj_t; long kj_bytes; long kq_bytes; };

struct StaticOrder {
    int nM, nN, nwg, G, c, wgm;
    __host__ __device__ void init(int M, int N, int G_, int c_, int wgm_ = WGM) { nM = M / BM; nN = N / BM; nwg = nM * nN; G = G_; c = c_; wgm = wgm_; }
    __host__ __device__ bool next(int i, Unit& u) const {
        const long L = (long)i * G + c; if (L >= nwg) return false;
        int wgid = (int)L; { const int q = nwg / NXCD, r = nwg % NXCD, xcd = wgid % NXCD, off = wgid / NXCD; wgid = (xcd < r ? xcd * (q + 1) : r * (q + 1) + (xcd - r) * q) + off; }
        const int nig = wgm * nN, gid = wgid / nig, fm = gid * wgm, gsz = (nM - fm) < wgm ? (nM - fm) : wgm;
        u.pm = fm + ((wgid % nig) % gsz); u.pn = (wgid % nig) / gsz; u.kq = 0; return true;
    }
    __device__ __forceinline__ void a_ready(const Unit&) const {}
    __device__ __forceinline__ void done(const Unit&) const {}
};


struct KSplitOrder {
    int nM, G, c;
    __host__ __device__ void init(int M, int G_, int c_) { nM = M / BM; G = G_; c = c_; }
    __host__ __device__ bool next(int i, Unit& u) const { const int L = i * G + c; if (L >= 4 * nM) return false; u.pm = L >> 2; u.pn = 0; u.kq = L & 3; return true; }
    __device__ __forceinline__ void a_ready(const Unit&) const {}
    __device__ __forceinline__ void done(const Unit&) const {}
};
DI unsigned cvt_pk_bf16(float lo, float hi) { f32x2 v = {lo, hi}; bf16v2 b = __builtin_convertvector(v, bf16v2); return __builtin_bit_cast(unsigned, b); }

struct EpiBf16 {
    static constexpr bool PERM = true, AFTER_DRAIN = false, MIDK = false;
    bf16_t* O; int ldc; const float* ssq;
    DI void midk(f32x4 (&)[2][2][4][2], const Unit&, int, int) const {}
    DI void operator()(const f32x4 (&acc)[2][2][4][2], const Unit& u, int wr, int wc, int fr, int fq) const {
        const int row0 = u.pm * BM + wr * 64 + fr; const int col0 = u.pn * BM + wc * 32 + 8 * fq;
        float rs[2][4];
#pragma unroll
        for (int ai = 0; ai < 2; ++ai)
#pragma unroll
            for (int m = 0; m < 4; ++m) rs[ai][m] = ssq ? __builtin_amdgcn_rsqf(ssq[row0 + ai * HALF + m * 16] * (1.0f / 4096.0f) + 1e-6f) : 1.0f;
#pragma unroll
        for (int ai = 0; ai < 2; ++ai)
#pragma unroll
            for (int m = 0; m < 4; ++m) { bf16_t* rowp = O + (size_t)(row0 + ai * HALF + m * 16) * ldc + col0; const float s = rs[ai][m];
#pragma unroll
                for (int bj = 0; bj < 2; ++bj) { const f32x4 v0 = acc[ai][bj][m][0] * s, v1 = acc[ai][bj][m][1] * s;
                    u32x4 w; w.x = cvt_pk_bf16(v0[0], v0[1]); w.y = cvt_pk_bf16(v0[2], v0[3]); w.z = cvt_pk_bf16(v1[0], v1[1]); w.w = cvt_pk_bf16(v1[2], v1[3]);
                    *(u32x4*)(rowp + bj * HALF) = w; } }
    }
};

struct EpiRes {
    static constexpr bool PERM = false, AFTER_DRAIN = false, MIDK = true;
    const float* base; float* out; bf16_t* hn; const float* nw; const float* ssq_mid; const float* ssq_epi; float* ssq_out;
    DI void midk(f32x4 (&acc)[2][2][4][2], const Unit& u, int wr, int fr) const {
        if (!ssq_mid) return;
        const int row0 = u.pm * BM + wr * 64 + fr;
#pragma unroll
        for (int ai = 0; ai < 2; ++ai)
#pragma unroll
            for (int m = 0; m < 4; ++m) { const float s = __builtin_amdgcn_rsqf(ssq_mid[row0 + ai * HALF + m * 16] * (1.0f / 4096.0f) + 1e-6f);
#pragma unroll
                for (int bj = 0; bj < 2; ++bj)
#pragma unroll
                    for (int n = 0; n < 2; ++n) acc[ai][bj][m][n] *= s; }
    }
    DI void operator()(const f32x4 (&acc)[2][2][4][2], const Unit& u, int wr, int wc, int fr, int fq) const {
        const int row0 = u.pm * BM + wr * 64 + fr, col0 = u.pn * BM + wc * 32 + 4 * fq;
        f32x4 nwv[2][2];
#pragma unroll
        for (int bj = 0; bj < 2; ++bj)
#pragma unroll
            for (int n = 0; n < 2; ++n) nwv[bj][n] = hn ? *(const f32x4*)(nw + col0 + bj * HALF + n * 16) : (f32x4){0.f, 0.f, 0.f, 0.f};
        f32x4 nxt[2][2];
#pragma unroll
        for (int bj = 0; bj < 2; ++bj)
#pragma unroll
            for (int n = 0; n < 2; ++n) nxt[bj][n] = *(const f32x4*)(base + (size_t)row0 * 4096 + col0 + bj * HALF + n * 16);
#pragma unroll
        for (int g = 0; g < 8; ++g) { const int ai = g >> 2, m = g & 3; const int row = row0 + ai * HALF + m * 16; const size_t off = (size_t)row * 4096 + col0;
            f32x4 cur[2][2];
#pragma unroll
            for (int bj = 0; bj < 2; ++bj)
#pragma unroll
                for (int n = 0; n < 2; ++n) cur[bj][n] = nxt[bj][n];
            if (g + 1 < 8) { const size_t offn = (size_t)(row0 + ((g + 1) >> 2) * HALF + ((g + 1) & 3) * 16) * 4096 + col0;
#pragma unroll
                for (int bj = 0; bj < 2; ++bj)
#pragma unroll
                    for (int n = 0; n < 2; ++n) nxt[bj][n] = *(const f32x4*)(base + offn + bj * HALF + n * 16); }
            const float s = ssq_epi ? __builtin_amdgcn_rsqf(ssq_epi[row] * (1.0f / 8192.0f) + 1e-6f) : 1.0f;
            float ss = 0.f;
#pragma unroll
            for (int bj = 0; bj < 2; ++bj)
#pragma unroll
                for (int n = 0; n < 2; ++n) { const f32x4 v = cur[bj][n] + acc[ai][bj][m][n] * s;
                    *(f32x4*)(out + off + bj * HALF + n * 16) = v; ss += (v[0] * v[0] + v[1] * v[1]) + (v[2] * v[2] + v[3] * v[3]);
                    if (hn) { const f32x4 w = nwv[bj][n]; u32x2 p; p.x = cvt_pk_bf16(v[0] * w[0], v[1] * w[1]); p.y = cvt_pk_bf16(v[2] * w[2], v[3] * w[3]);
                        *(u32x2*)(hn + off + bj * HALF + n * 16) = p; } }
            ss = fq_sum(ss);
            if (fq == 0) unsafeAtomicAdd(ssq_out + row, ss);
            asm volatile("" ::: "memory"); }
    }
};

struct EpiRes16 {
    static constexpr bool PERM = true, AFTER_DRAIN = false, MIDK = true;
    const float* base32; const bf16_t* base16; bf16_t* O; const float* ssq_mid; const float* ssq_epi; float* ssq_out;
    DI void midk(f32x4 (&acc)[2][2][4][2], const Unit& u, int wr, int fr) const {
        if (!ssq_mid) return;
        const int row0 = u.pm * BM + wr * 64 + fr;
#pragma unroll
        for (int ai = 0; ai < 2; ++ai)
#pragma unroll
            for (int m = 0; m < 4; ++m) { const float s = __builtin_amdgcn_rsqf(ssq_mid[row0 + ai * HALF + m * 16] * (1.0f / 4096.0f) + 1e-6f);
#pragma unroll
                for (int bj = 0; bj < 2; ++bj)
#pragma unroll
                    for (int n = 0; n < 2; ++n) acc[ai][bj][m][n] *= s; }
    }
    DI void operator()(const f32x4 (&acc)[2][2][4][2], const Unit& u, int wr, int wc, int fr, int fq) const {
        const int row0 = u.pm * BM + wr * 64 + fr, col0 = u.pn * BM + wc * 32 + 8 * fq;
        f32x4 nx32[2][2]; u32x4 nx16[2];
        if (base32) {
#pragma unroll
            for (int bj = 0; bj < 2; ++bj)
#pragma unroll
                for (int n = 0; n < 2; ++n) nx32[bj][n] = *(const f32x4*)(base32 + (size_t)row0 * 4096 + col0 + bj * HALF + 4 * n);
        } else {
#pragma unroll
            for (int bj = 0; bj < 2; ++bj) nx16[bj] = *(const u32x4*)(base16 + (size_t)row0 * 4096 + col0 + bj * HALF);
        }
#pragma unroll
        for (int g = 0; g < 8; ++g) { const int ai = g >> 2, m = g & 3; const int row = row0 + ai * HALF + m * 16; const size_t off = (size_t)row * 4096 + col0;
            f32x4 cur[2][2];
            if (base32) {
#pragma unroll
                for (int bj = 0; bj < 2; ++bj)
#pragma unroll
                    for (int n = 0; n < 2; ++n) cur[bj][n] = nx32[bj][n];
            } else {
#pragma unroll
                for (int bj = 0; bj < 2; ++bj) { const u32x4 w = nx16[bj]; cur[bj][0] = (f32x4){bflo(w.x), bfhi(w.x), bflo(w.y), bfhi(w.y)}; cur[bj][1] = (f32x4){bflo(w.z), bfhi(w.z), bflo(w.w), bfhi(w.w)}; }
            }
            if (g + 1 < 8) { const size_t offn = (size_t)(row0 + ((g + 1) >> 2) * HALF + ((g + 1) & 3) * 16) * 4096 + col0;
                if (base32) {
#pragma unroll
                    for (int bj = 0; bj < 2; ++bj)
#pragma unroll
                        for (int n = 0; n < 2; ++n) nx32[bj][n] = *(const f32x4*)(base32 + offn + bj * HALF + 4 * n);
                } else {
#pragma unroll
                    for (int bj = 0; bj < 2; ++bj) nx16[bj] = *(const u32x4*)(base16 + offn + bj * HALF);
                } }
            const float s = ssq_epi ? __builtin_amdgcn_rsqf(ssq_epi[row] * (1.0f / 8192.0f) + 1e-6f) : 1.0f;
            float ss = 0.f;
#pragma unroll
            for (int bj = 0; bj < 2; ++bj) { const f32x4 v0 = cur[bj][0] + acc[ai][bj][m][0] * s, v1 = cur[bj][1] + acc[ai][bj][m][1] * s;
                ss += ((v0[0] * v0[0] + v0[1] * v0[1]) + (v0[2] * v0[2] + v0[3] * v0[3])) + ((v1[0] * v1[0] + v1[1] * v1[1]) + (v1[2] * v1[2] + v1[3] * v1[3]));
                u32x4 w; w.x = cvt_pk_bf16(v0[0], v0[1]); w.y = cvt_pk_bf16(v0[2], v0[3]); w.z = cvt_pk_bf16(v1[0], v1[1]); w.w = cvt_pk_bf16(v1[2], v1[3]);
                *(u32x4*)(O + off + bj * HALF) = w; }
            ss = fq_sum(ss);
            if (fq == 0) unsafeAtomicAdd(ssq_out + row, ss);
            asm volatile("" ::: "memory"); }
    }
};

struct EpiDtPart {
    static constexpr bool PERM = false, AFTER_DRAIN = false, MIDK = false;
    float* part; const float* ssq;
    DI void midk(f32x4 (&)[2][2][4][2], const Unit&, int, int) const {}
    DI void operator()(const f32x4 (&acc)[2][2][4][2], const Unit& u, int wr, int wc, int fr, int fq) const {
        const int row0 = u.pm * BM + wr * 64 + fr, col0 = wc * 32 + 4 * fq; float* P = part + (size_t)u.kq * 16384 * 128;
#pragma unroll
        for (int ai = 0; ai < 2; ++ai)
#pragma unroll
            for (int m = 0; m < 4; ++m) { const int row = row0 + ai * HALF + m * 16; const float s = __builtin_amdgcn_rsqf(ssq[row] * (1.0f / 4096.0f) + 1e-6f);
#pragma unroll
                for (int n = 0; n < 2; ++n) *(f32x4*)(P + (size_t)row * 128 + col0 + 16 * n) = acc[ai][0][m][n] * s; }
    }
};

struct EpiFinal {
    static constexpr bool PERM = true, AFTER_DRAIN = false, MIDK = false;
    const bf16_t* base16; float* out; const float* fw; const float* ssq_epi; float* ssq_out; unsigned* cnt; unsigned* tmo;
    DI void midk(f32x4 (&)[2][2][4][2], const Unit&, int, int) const {}
    DI void operator()(f32x4 (&acc)[2][2][4][2], const Unit& u, int wr, int wc, int fr, int fq) const {
        const int row0 = u.pm * BM + wr * 64 + fr, col0 = u.pn * BM + wc * 32 + 8 * fq;
        u32x4 q16[2][2];
#define EF_LOAD(slot_, g_) do { const size_t o_ = (size_t)(row0 + ((g_) >> 2) * HALF + ((g_) & 3) * 16) * 4096 + col0; \
            _Pragma("unroll") for (int bj = 0; bj < 2; ++bj) q16[slot_][bj] = *(const u32x4*)(base16 + o_ + bj * HALF); } while (0)
        EF_LOAD(0, 0); EF_LOAD(1, 1);
#pragma unroll
        for (int g = 0; g < 8; ++g) { const int ai = g >> 2, m = g & 3; const int row = row0 + ai * HALF + m * 16;
            f32x4 cur[2][2];
#pragma unroll
            for (int bj = 0; bj < 2; ++bj) { const u32x4 w = q16[g & 1][bj]; cur[bj][0] = (f32x4){bflo(w.x), bfhi(w.x), bflo(w.y), bfhi(w.y)}; cur[bj][1] = (f32x4){bflo(w.z), bfhi(w.z), bflo(w.w), bfhi(w.w)}; }
            if (g + 2 < 8) EF_LOAD(g & 1, g + 2);
            const float s = __builtin_amdgcn_rsqf(ssq_epi[row] * (1.0f / 8192.0f) + 1e-6f);
            float ss = 0.f;
#pragma unroll
            for (int bj = 0; bj < 2; ++bj) { const f32x4 v0 = cur[bj][0] + acc[ai][bj][m][0] * s, v1 = cur[bj][1] + acc[ai][bj][m][1] * s;
                ss += ((v0[0] * v0[0] + v0[1] * v0[1]) + (v0[2] * v0[2] + v0[3] * v0[3])) + ((v1[0] * v1[0] + v1[1] * v1[1]) + (v1[2] * v1[2] + v1[3] * v1[3]));
                acc[ai][bj][m][0] = v0; acc[ai][bj][m][1] = v1; }
            ss = fq_sum(ss);
            if (fq == 0) unsafeAtomicAdd(ssq_out + row, ss); }
#undef EF_LOAD
        asm volatile("s_waitcnt vmcnt(0)" ::: "memory");
        unsigned* c = cnt + 64 * u.pm;
        if (fr == 0 && fq == 0) __hip_atomic_fetch_add(c, 1u, __ATOMIC_RELAXED, __HIP_MEMORY_SCOPE_AGENT);
        { unsigned sp = 0;
          while ((unsigned)__builtin_amdgcn_readfirstlane(__hip_atomic_load(c, __ATOMIC_RELAXED, __HIP_MEMORY_SCOPE_AGENT)) < 128u) {
              __builtin_amdgcn_s_sleep(2);
              if (++sp > (1u << 19)) { if (fr == 0 && fq == 0) __hip_atomic_store(tmo, 0x900u | (unsigned)(u.pm & 0xff), __ATOMIC_RELAXED, __HIP_MEMORY_SCOPE_AGENT); break; } } }
        f32x4 fwv[2][2];
#pragma unroll
        for (int bj = 0; bj < 2; ++bj)
#pragma unroll
            for (int n = 0; n < 2; ++n) fwv[bj][n] = *(const f32x4*)(fw + col0 + bj * HALF + 4 * n);
#pragma unroll
        for (int g = 0; g < 8; ++g) { const int ai = g >> 2, m = g & 3; const int row = row0 + ai * HALF + m * 16;
            const float tot = __hip_atomic_load(ssq_out + row, __ATOMIC_RELAXED, __HIP_MEMORY_SCOPE_AGENT);
            const float rs = __builtin_amdgcn_rsqf(tot * (1.0f / 4096.0f) + 1e-6f);
#pragma unroll
            for (int bj = 0; bj < 2; ++bj)
#pragma unroll
                for (int n = 0; n < 2; ++n) *(f32x4*)(out + (size_t)row * 4096 + col0 + bj * HALF + 4 * n) = acc[ai][bj][m][n] * rs * fwv[bj][n]; }
    }
};
template <class Epi, class Sched, bool ALIGN_EPI = false, bool SP2 = false>
__device__ __forceinline__ void gemm_phase(PG8_LAS unsigned char* lds, const Gemm g, const Sched& S, const Epi& E) {
    const int tid = threadIdx.x, wid = __builtin_amdgcn_readfirstlane(tid >> 6), lane = tid & 63, wr = wid >> 2, wc = wid & 3, fr = lane & 15, fq = lane >> 4;
    const int K = g.K, nt = K / BK;
    unsigned voffA[2], voffB[2];
#pragma unroll
    for (int i = 0; i < 2; ++i) { int R, C; stage_rc(tid * 16 + i * 8192, R, C); const int Rb = Epi::PERM ? ((R & ~31) + perm32(R & 31)) : R;
        voffA[i] = (unsigned)(R * g.lda + C) * 2u; voffB[i] = (unsigned)(Rb * g.ldb + C) * 2u; }
    const size_t kstep = (size_t)(BK * 2);
    const size_t hstepA = (size_t)HALF * g.lda * 2, hstepB = (size_t)HALF * g.ldb * 2;
    const size_t tstepA = 2 * hstepA, tstepB = 2 * hstepB;
    const unsigned ldsw = (unsigned)wid * 1024u;
    const int aoff = lds_byte(wr * 64 + fr, fq * 8), boff = lds_byte(wc * 32 + fr, fq * 8);
#define PG8_SA(b, h) (((b) * 2 + (h)) * HTB)
#define PG8_SB(b, h) ((4 + (b) * 2 + (h)) * HTB)
#define PG8_STAGE(bufoff, gbase, voff) do { _Pragma("unroll") for (int _i = 0; _i < 2; ++_i) \
        __builtin_amdgcn_global_load_lds((const unsigned*)((const char*)(gbase) + (voff)[_i]), (PG8_LAS unsigned*)(lds + (bufoff) + ldsw + _i * 8192), 16, 0, 0); } while (0)
#define PG8_LDA(dst, b, h) do { _Pragma("unroll") for (int m = 0; m < 4; ++m) _Pragma("unroll") for (int k = 0; k < 2; ++k) dst[m][k] = *(const PG8_LAS bf16x8*)(lds + PG8_SA(b, h) + aoff + m * 2048 + k * 1024); } while (0)
#define PG8_LDB(dst, b, h) do { _Pragma("unroll") for (int n = 0; n < 2; ++n) _Pragma("unroll") for (int k = 0; k < 2; ++k) dst[n][k] = *(const PG8_LAS bf16x8*)(lds + PG8_SB(b, h) + boff + n * 2048 + k * 1024); } while (0)
#define PG8_MMA(ai, bj, At, Bt) do { __builtin_amdgcn_s_setprio(1); _Pragma("unroll") for (int m = 0; m < 4; ++m) _Pragma("unroll") for (int n = 0; n < 2; ++n) _Pragma("unroll") for (int k = 0; k < 2; ++k) \
        acc[ai][bj][m][n] = __builtin_amdgcn_mfma_f32_16x16x32_bf16(Bt[n][k], At[m][k], acc[ai][bj][m][n], 0, 0, 0); __builtin_amdgcn_s_setprio(0); } while (0)
#define PG8_WAIT_V(n) asm volatile("s_waitcnt vmcnt(" #n ")" ::: "memory")
#define PG8_WAIT_L(n) asm volatile("s_waitcnt lgkmcnt(" #n ")" ::: "memory")
#define PG8_BAR __builtin_amdgcn_s_barrier()
#define PG8_SCHED __builtin_amdgcn_sched_barrier(0)
    Unit cur, nxt; int ui = 0;
    if (!S.next(0, cur)) return;
    f32x4 acc[2][2][4][2];
#pragma unroll
    for (int a = 0; a < 2; ++a)
#pragma unroll
        for (int b = 0; b < 2; ++b)
#pragma unroll
            for (int m = 0; m < 4; ++m)
#pragma unroll
                for (int n = 0; n < 2; ++n) acc[a][b][m][n] = (f32x4){0.f, 0.f, 0.f, 0.f};
    bf16x8 At[4][2], B0[2][2], B1[2][2];
    const char* cA = (const char*)g.A + (size_t)cur.pm * tstepA + cur.kq * g.kq_bytes; const char* cB = (const char*)g.Bt + (size_t)cur.pn * tstepB + cur.kq * g.kq_bytes;
    S.a_ready(cur);
    if constexpr (SP2) {
        PG8_STAGE(PG8_SB(0, 0), cB, voffB); PG8_STAGE(PG8_SB(0, 1), cB + hstepB, voffB); PG8_STAGE(PG8_SA(0, 0), cA, voffA); PG8_STAGE(PG8_SA(0, 1), cA + hstepA, voffA);
        if (wr == 1) PG8_BAR;
        PG8_WAIT_V(2); PG8_BAR;
        PG8_STAGE(PG8_SB(1, 0), cB + kstep, voffB); PG8_STAGE(PG8_SA(1, 0), cA + kstep, voffA); PG8_STAGE(PG8_SB(1, 1), cB + hstepB + kstep, voffB);
        PG8_WAIT_V(6); PG8_BAR;
    } else {
        PG8_STAGE(PG8_SB(0, 0), cB, voffB); PG8_STAGE(PG8_SA(0, 0), cA, voffA); PG8_STAGE(PG8_SB(0, 1), cB + hstepB, voffB); PG8_STAGE(PG8_SA(0, 1), cA + hstepA, voffA);
        if (wr == 1) PG8_BAR;
        PG8_WAIT_V(4); PG8_BAR;
        PG8_STAGE(PG8_SB(1, 0), cB + kstep, voffB); PG8_STAGE(PG8_SA(1, 0), cA + kstep, voffA); PG8_STAGE(PG8_SB(1, 1), cB + hstepB + kstep, voffB);
        PG8_WAIT_V(6); PG8_BAR;
    }
    for (;;) {
        const bool has_next = S.next(ui + 1, nxt);
        const char* nA = has_next ? (const char*)g.A + (size_t)nxt.pm * tstepA + nxt.kq * g.kq_bytes : cA; const char* nB = has_next ? (const char*)g.Bt + (size_t)nxt.pn * tstepB + nxt.kq * g.kq_bytes : cB;
        for (int t = 0; t < nt; t += 2) {
            const bool last = (t == nt - 2);
            const char* a1 = cA + (size_t)(t + 1) * kstep + (t >= g.kj_t ? g.kj_bytes : 0);
            const char* a2 = last ? nA : cA + (size_t)(t + 2) * kstep + (t + 2 >= g.kj_t ? g.kj_bytes : 0); const char* b2 = last ? nB : cB + (size_t)(t + 2) * kstep;
            const char* a3 = a2 + kstep; const char* b3 = b2 + kstep;
            if (last && has_next) S.a_ready(nxt);
            if constexpr (Epi::MIDK) { if (t == g.kj_t) E.midk(acc, cur, wr, fr); }
            if constexpr (SP2) {
            PG8_LDB(B0, 0, 0); PG8_LDB(B1, 0, 1); PG8_SCHED; PG8_LDA(At, 0, 0); PG8_STAGE(PG8_SA(1, 1), a1 + hstepA, voffA);
            PG8_WAIT_V(8); PG8_WAIT_L(0); PG8_BAR; PG8_MMA(0, 0, At, B0); PG8_MMA(0, 1, At, B1); PG8_BAR; PG8_SCHED;
            PG8_LDA(At, 0, 1); PG8_STAGE(PG8_SB(0, 0), b2, voffB); PG8_STAGE(PG8_SB(0, 1), b2 + hstepB, voffB); PG8_STAGE(PG8_SA(0, 0), a2, voffA);
            PG8_WAIT_V(8); PG8_WAIT_L(0); PG8_BAR; PG8_MMA(1, 0, At, B0); PG8_MMA(1, 1, At, B1); PG8_BAR; PG8_SCHED;
            PG8_LDB(B0, 1, 0); PG8_LDB(B1, 1, 1); PG8_SCHED; PG8_LDA(At, 1, 0); PG8_STAGE(PG8_SA(0, 1), a2 + hstepA, voffA);
            PG8_WAIT_V(8); PG8_WAIT_L(0); PG8_BAR; PG8_MMA(0, 0, At, B0); PG8_MMA(0, 1, At, B1); PG8_BAR; PG8_SCHED;
            PG8_LDA(At, 1, 1); PG8_STAGE(PG8_SB(1, 0), b3, voffB); PG8_STAGE(PG8_SB(1, 1), b3 + hstepB, voffB); PG8_STAGE(PG8_SA(1, 0), a3, voffA);
            PG8_WAIT_V(8); PG8_WAIT_L(0); PG8_BAR; PG8_MMA(1, 0, At, B0); PG8_MMA(1, 1, At, B1); PG8_BAR; PG8_SCHED;
            } else {
            PG8_LDB(B0, 0, 0); PG8_SCHED; PG8_LDA(At, 0, 0); PG8_STAGE(PG8_SA(1, 1), a1 + hstepA, voffA);
            PG8_WAIT_L(8); PG8_BAR; PG8_WAIT_L(0); PG8_MMA(0, 0, At, B0); PG8_BAR; PG8_SCHED;
            PG8_LDB(B1, 0, 1); PG8_STAGE(PG8_SB(0, 0), b2, voffB);
            PG8_BAR; PG8_WAIT_L(0); PG8_MMA(0, 1, At, B1); PG8_BAR;
            PG8_LDA(At, 0, 1); PG8_STAGE(PG8_SA(0, 0), a2, voffA);
            PG8_BAR; PG8_WAIT_L(0); PG8_MMA(1, 0, At, B0); PG8_BAR; PG8_SCHED;
            PG8_STAGE(PG8_SB(0, 1), b2 + hstepB, voffB);
            PG8_WAIT_V(6); PG8_BAR; PG8_MMA(1, 1, At, B1); PG8_BAR;
            PG8_LDB(B0, 1, 0); PG8_SCHED; PG8_LDA(At, 1, 0); PG8_STAGE(PG8_SA(0, 1), a2 + hstepA, voffA);
            PG8_WAIT_L(8); PG8_BAR; PG8_WAIT_L(0); PG8_MMA(0, 0, At, B0); PG8_BAR; PG8_SCHED;
            PG8_LDB(B1, 1, 1); PG8_STAGE(PG8_SB(1, 0), b3, voffB);
            PG8_BAR; PG8_WAIT_L(0); PG8_MMA(0, 1, At, B1); PG8_BAR;
            PG8_LDA(At, 1, 1); PG8_STAGE(PG8_SA(1, 0), a3, voffA);
            PG8_BAR; PG8_WAIT_L(0); PG8_MMA(1, 0, At, B0); PG8_BAR; PG8_SCHED;
            PG8_STAGE(PG8_SB(1, 1), b3 + hstepB, voffB);
            PG8_WAIT_V(6); PG8_BAR; PG8_MMA(1, 1, At, B1); PG8_BAR;
            }
        }
        if constexpr (ALIGN_EPI) { if (wr == 0) PG8_BAR; }
        if constexpr (!Epi::AFTER_DRAIN) { E(acc, cur, wr, wc, fr, fq); S.done(cur); }
        if (!has_next) break;
#pragma unroll
        for (int a = 0; a < 2; ++a)
#pragma unroll
            for (int b = 0; b < 2; ++b)
#pragma unroll
                for (int m = 0; m < 4; ++m)
#pragma unroll
                    for (int n = 0; n < 2; ++n) acc[a][b][m][n] = (f32x4){0.f, 0.f, 0.f, 0.f};
        cur = nxt; cA = nA; cB = nB; ++ui;
        if constexpr (ALIGN_EPI) { if (wr == 1) PG8_BAR; }
    }
    PG8_WAIT_V(0);
    if constexpr (!ALIGN_EPI) { if (wr == 0) PG8_BAR; }
    PG8_BAR;
    if constexpr (Epi::AFTER_DRAIN) { E.fused(acc, cur, wr, wc, fr, fq, lds, wid, lane); S.done(cur); }
#undef PG8_SA
#undef PG8_SB
#undef PG8_STAGE
#undef PG8_LDA
#undef PG8_LDB
#undef PG8_MMA
#undef PG8_WAIT_V
#undef PG8_WAIT_L
#undef PG8_BAR
#undef PG8_SCHED
}
}
struct Frame {
    LAS uchar* lds;
    volatile LAS unsigned* MISC;
    unsigned* ctl;
    int tid, lane, wave;
    int vcu, G;
};

constexpr int TSTR = 144;
DI void p0_transpose_item(const float* W, int K, int N, bf16* WT, LAS uchar* scr, int item, int lane, const float* kscale = nullptr) {
    const int nblk = N / 64, kb = item / nblk, nb = item % nblk, k0 = 64 * kb, n0 = 64 * nb;
    const int q = lane >> 4, c16 = lane & 15;
    f32x4 v[16];
#pragma unroll
    for (int i = 0; i < 16; ++i) v[i] = *(const f32x4*)(W + (size_t)(k0 + 16 * q + i) * N + n0 + 4 * c16);
    if (kscale) {
#pragma unroll
        for (int i = 0; i < 16; ++i) v[i] = v[i] * kscale[k0 + 16 * q + i]; }
#pragma unroll
    for (int j = 0; j < 4; ++j) { u32x4 lo, hi;
        lo.x = pk2(v[0][j], v[1][j]); lo.y = pk2(v[2][j], v[3][j]); lo.z = pk2(v[4][j], v[5][j]); lo.w = pk2(v[6][j], v[7][j]);
        hi.x = pk2(v[8][j], v[9][j]); hi.y = pk2(v[10][j], v[11][j]); hi.z = pk2(v[12][j], v[13][j]); hi.w = pk2(v[14][j], v[15][j]);
        LAS uchar* p = scr + (4 * c16 + j) * TSTR + q * 32; *(LAS u32x4*)p = lo; *(LAS u32x4*)(p + 16) = hi; }
    asm volatile("s_waitcnt lgkmcnt(0)" ::: "memory");
    const int c = lane & 7, nr = lane >> 3;
#pragma unroll
    for (int r = 0; r < 8; ++r) { const int n = nr + 8 * r;
        *(u32x4*)(WT + (size_t)(n0 + n) * K + k0 + 8 * c) = *(const LAS u32x4*)(scr + n * TSTR + c * 16); }
    asm volatile("s_waitcnt lgkmcnt(0)" ::: "memory");
}
struct CvJob { const float* e_w_out; const float* o_w_in; const float* o_w_out; const float* kscale3; const float* kscale4; bf16 *W2, *W3, *W4; };
constexpr int CV_I2 = (K2 / 64) * (D / 64), CV_I3 = (D / 64) * (N3 / 64), CV_I4 = (K4 / 64) * (D / 64), CV_NIT = CV_I2 + CV_I3 + CV_I4;
DI void cv_decode(const CvJob& j, int idx, const float*& W, int& K, int& N, bf16*& WT, const float*& ks, int& item) {
    if (idx < CV_I2) { W = j.e_w_out; K = K2; N = D; WT = j.W2; ks = nullptr; item = idx; }
    else if (idx < CV_I2 + CV_I3) { W = j.o_w_in; K = D; N = N3; WT = j.W3; ks = j.kscale3; item = idx - CV_I2; }
    else { W = j.o_w_out; K = K4; N = D; WT = j.W4; ks = j.kscale4; item = idx - CV_I2 - CV_I3; }
}
DI void cv_issue(const CvJob& j, int idx, int lane, f32x4 (&v)[16]) {
    const float* W; int K, N, item; bf16* WT; const float* ks; cv_decode(j, idx, W, K, N, WT, ks, item);
    const int nblk = N / 64, kb = item / nblk, nb = item % nblk, k0 = 64 * kb, n0 = 64 * nb, q = lane >> 4, c16 = lane & 15;
#pragma unroll
    for (int i = 0; i < 16; ++i) v[i] = *(const f32x4*)(W + (size_t)(k0 + 16 * q + i) * N + n0 + 4 * c16);
}
DI void cv_finish(const CvJob& j, int idx, int lane, const f32x4 (&vin)[16], LAS uchar* scr) {
    const float* W; int K, N, item; bf16* WT; const float* ks; cv_decode(j, idx, W, K, N, WT, ks, item);
    const int nblk = N / 64, kb = item / nblk, nb = item % nblk, k0 = 64 * kb, n0 = 64 * nb, q = lane >> 4, c16 = lane & 15;
    f32x4 v[16], kv[4];
    if (ks) {
#pragma unroll
        for (int i = 0; i < 4; ++i) kv[i] = *(const f32x4*)(ks + k0 + 16 * q + 4 * i); }
    else {
#pragma unroll
        for (int i = 0; i < 4; ++i) kv[i] = (f32x4){1.f, 1.f, 1.f, 1.f}; }
#pragma unroll
    for (int i = 0; i < 16; ++i) v[i] = vin[i] * kv[i >> 2][i & 3];
#pragma unroll
    for (int jj = 0; jj < 4; ++jj) { u32x4 lo, hi;
        lo.x = pk2(v[0][jj], v[1][jj]); lo.y = pk2(v[2][jj], v[3][jj]); lo.z = pk2(v[4][jj], v[5][jj]); lo.w = pk2(v[6][jj], v[7][jj]);
        hi.x = pk2(v[8][jj], v[9][jj]); hi.y = pk2(v[10][jj], v[11][jj]); hi.z = pk2(v[12][jj], v[13][jj]); hi.w = pk2(v[14][jj], v[15][jj]);
        LAS uchar* p = scr + (4 * c16 + jj) * TSTR + q * 32; *(LAS u32x4*)p = lo; *(LAS u32x4*)(p + 16) = hi; }
    asm volatile("s_waitcnt lgkmcnt(0)" ::: "memory");
    const int c = lane & 7, nr = lane >> 3;
#pragma unroll
    for (int r = 0; r < 8; ++r) { const int n = nr + 8 * r;
        *(u32x4*)(WT + (size_t)(n0 + n) * K + k0 + 8 * c) = *(const LAS u32x4*)(scr + n * TSTR + c * 16); }
    asm volatile("s_waitcnt lgkmcnt(0)" ::: "memory");
}
DI void rms_row_to_bf16(const float* xrow, const float* w, bf16* orow, int lane) {
    const f32x4* xr = (const f32x4*)xrow + lane; const f32x4* wr = (const f32x4*)w + lane;
    f32x4 v[16]; float s = 0.f;
#pragma unroll
    for (int j = 0; j < 16; ++j) { v[j] = xr[64 * j]; s += (v[j].x * v[j].x + v[j].y * v[j].y) + (v[j].z * v[j].z + v[j].w * v[j].w); }
    const float rstd = __builtin_amdgcn_rsqf(wave_sum(s) * (1.f / 4096.f) + EPS);
    u32x2* o8 = (u32x2*)orow + lane;
#pragma unroll
    for (int j = 0; j < 16; ++j) { const f32x4 ww = wr[64 * j]; u32x2 p; p.x = pk2(v[j].x * rstd * ww.x, v[j].y * rstd * ww.y); p.y = pk2(v[j].z * rstd * ww.z, v[j].w * rstd * ww.w); o8[64 * j] = p; }
}
struct P0Args { const float* x; const float* norm_w; const float* e_w_in; const float* e_w_out; const float* o_w_in; const float* o_w_out; bf16 *W1, *W2, *W3, *W4, *HN; };
DI void p0_prologue(Frame& F, const P0Args& a) {
    LAS uchar* scr = F.lds + F.wave * 16384;
    const int gw = F.vcu * 8 + F.wave, NGW = F.G * 8;
    constexpr int I1 = (D / 64) * (N1 / 64);
    for (int it = gw; it < I1; it += NGW) p0_transpose_item(a.e_w_in, D, N1, a.W1, scr, it, F.lane);
    { u32x4* z = (u32x4*)(a.W3 + (size_t)N3 * D); const int nz = (N3P - N3) * D / 8; const u32x4 zero = {0u, 0u, 0u, 0u};
      for (int i = gw * 64 + F.lane; i < nz; i += NGW * 64) z[i] = zero; }
    for (int m = gw; m < M; m += NGW) rms_row_to_bf16(a.x + (size_t)m * D, a.norm_w, a.HN + (size_t)m * D, F.lane);
}
DI void p7_final(Frame& F, const bf16* in, float* out, const float* ssq, const float* fw) {
    const int gw = F.vcu * 8 + F.wave, NGW = F.G * 8;
    for (int m = gw; m < M; m += NGW) {
        const float rstd = __builtin_amdgcn_rsqf(ssq[m] * (1.f / 4096.f) + EPS);
        const u32x4* xr = (const u32x4*)(in + (size_t)m * D) + F.lane; f32x4* orow = (f32x4*)(out + (size_t)m * D) + 2 * F.lane; const f32x4* wr = (const f32x4*)fw + 2 * F.lane;
#pragma unroll
        for (int j = 0; j < 8; ++j) { const u32x4 w = xr[64 * j]; const f32x4 w0 = wr[128 * j], w1 = wr[128 * j + 1];
            orow[128 * j] = (f32x4){bflo(w.x), bfhi(w.x), bflo(w.y), bfhi(w.y)} * rstd * w0;
            orow[128 * j + 1] = (f32x4){bflo(w.z), bfhi(w.z), bflo(w.w), bfhi(w.w)} * rstd * w1; }
    }
}
template <int KSTEPS> DI f32x4 mma_tile(f32x4 acc, const LAS uchar* P, int sp, int p0, const LAS uchar* Q, int sq, int q0, int fr, int fq) {
    bf16x8 a[KSTEPS], b[KSTEPS];
#pragma unroll
    for (int ks = 0; ks < KSTEPS; ++ks) { a[ks] = *(const LAS bf16x8*)(P + (p0 + fr) * sp + ks * 64 + fq * 16); b[ks] = *(const LAS bf16x8*)(Q + (q0 + fr) * sq + ks * 64 + fq * 16); }
#pragma unroll
    for (int ks = 0; ks < KSTEPS; ++ks) acc = __builtin_amdgcn_mfma_f32_16x16x32_bf16(a[ks], b[ks], acc, 0, 0, 0);
    return acc;
}
constexpr int S128 = 288, S64 = 160;

struct Mix0Args { bf16* proj; const float* lb_logits; const float* a_norm_w; const float* conv_w; const float* conv_b; const float* wa; const float* ba; const float* wx; const float* bx; const float* lam; float* ssq_a; bf16* outp; int out_ld, oa_col, ob_col;
                  bf16* Pg; bf16* KSTg; float* GLg; int dummy; CvJob cv; };

DI void hgrn2_prep_all(Frame& F, const Mix0Args& a) {
    const int tid = F.tid, w = F.wave, lane = F.lane, fr = lane & 15, fq = lane >> 4;
    constexpr int PIMG = 2 * 64 * S128 + 128 * S64 + 4096;
    const int c2 = tid & 63, rg = tid >> 6;
    unsigned qr[8], fr_[8];
#define HP_LOAD(U_) do { const int h_ = (U_) & 31, n_ = ((U_) >> 5) & 127, b_ = (U_) >> 12; const size_t r_ = (size_t)b_ * SEQ + (size_t)n_ * 64 + 8 * rg; \
        _Pragma("unroll") for (int i = 0; i < 8; ++i) { qr[i] = *(const unsigned*)(a.proj + C_Q + h_ * 128 + 2 * c2 + (r_ + i) * N1); fr_[i] = *(const unsigned*)(a.proj + C_F + h_ * 128 + 2 * c2 + (r_ + i) * N1); } } while (0)
    if (F.vcu < 8192) HP_LOAD(F.vcu);
    float lb[2] = {0.f, 0.f}, oml[2] = {1.f, 1.f}; int h_prev = -1;
    int par = 0;
    for (int U = F.vcu; U < 8192; U += F.G, par ^= 1) {
    const int h = U & 31, n = (U >> 5) & 127, b = U >> 12;
    LAS uchar* QIN = F.lds + par * PIMG; LAS uchar* KIN = QIN + 64 * S128; LAS uchar* KST = KIN + 64 * S128; LAS float* TOT = (LAS float*)(KST + 128 * S64);
    if (h != h_prev) {
#pragma unroll
        for (int j = 0; j < 2; ++j) { const int col = h * 128 + 2 * c2 + j; const float l0 = a.lb_logits[col], l1 = a.lb_logits[4096 + col], l2 = a.lb_logits[8192 + col];
            const float mx = fmaxf(l0, fmaxf(l1, l2)); const float e0 = __expf(l0 - mx), e1 = __expf(l1 - mx), e2 = __expf(l2 - mx); lb[j] = e0 / (e0 + e1 + e2); oml[j] = 1.0f - lb[j]; }
        h_prev = h; }
    const size_t row0 = (size_t)b * SEQ + (size_t)n * 64;
    bf16* qcol = a.proj + C_Q + h * 128 + 2 * c2;
    unsigned qc[8], fc[8];
#pragma unroll
    for (int i = 0; i < 8; ++i) { qc[i] = qr[i]; fc[i] = fr_[i]; }
    if (U + F.G < 8192) HP_LOAD(U + F.G);
    float cum[2] = {0.f, 0.f}, cumv[8][2], kkv[8][2];
#pragma unroll
    for (int i = 0; i < 8; ++i)
#pragma unroll
        for (int j = 0; j < 2; ++j) { const float z = j ? bfhi(fc[i]) : bflo(fc[i]); const float e = fexp2(-LOG2E * z), sg = frcp(1.0f + e);
            const float fg = lb[j] + oml[j] * sg; cum[j] += flog2(fg); cumv[i][j] = cum[j]; kkv[i][j] = oml[j] * (1.0f - sg); }
    *(LAS f32x2*)(TOT + rg * 128 + 2 * c2) = (f32x2){cum[0], cum[1]};
    LDS_BAR();
    float off[2] = {0.f, 0.f}, ref[2] = {0.f, 0.f}, bl[2] = {0.f, 0.f};
#pragma unroll
    for (int g = 0; g < 8; ++g) { const f32x2 t = *(const LAS f32x2*)(TOT + g * 128 + 2 * c2);
        if (g < rg) { off[0] += t.x; off[1] += t.y; } if (g < 4) { ref[0] += t.x; ref[1] += t.y; } bl[0] += t.x; bl[1] += t.y; }
    float eref[2], ebl[2];
#pragma unroll
    for (int j = 0; j < 2; ++j) { eref[j] = fexp2(ref[j]); ebl[j] = fexp2(bl[j] - ref[j]); }
    const size_t T = ((size_t)(b * 32 + h)) * 128 + n;
    if (rg == 0) *(f32x2*)(a.GLg + T * 128 + 2 * c2) = (f32x2){fexp2(bl[0]), fexp2(bl[1])};
    float ksv[2][8];
#pragma unroll
    for (int i = 0; i < 8; ++i) { float qi[2], ki[2], qo[2];
#pragma unroll
        for (int j = 0; j < 2; ++j) { const float q = j ? bfhi(qc[i]) : bflo(qc[i]); const float qs = fsilu(q);
            const float e1 = fexp2(off[j] + cumv[i][j] - ref[j]), e2 = frcp(e1);
            qi[j] = qs * e1; ki[j] = kkv[i][j] * e2; qo[j] = qi[j] * eref[j]; ksv[j][i] = ki[j] * ebl[j]; }
        const int l = 8 * rg + i;
        *(LAS unsigned*)(QIN + l * S128 + c2 * 4) = pk2(qi[0], qi[1]);
        *(LAS unsigned*)(KIN + l * S128 + c2 * 4) = pk2(ki[0], ki[1]);
        if (!a.dummy) *(unsigned*)(qcol + (row0 + l) * N1) = pk2(qo[0], qo[1]); }
#pragma unroll
    for (int j = 0; j < 2; ++j) { u32x4 p; p.x = pk2(ksv[j][0], ksv[j][1]); p.y = pk2(ksv[j][2], ksv[j][3]); p.z = pk2(ksv[j][4], ksv[j][5]); p.w = pk2(ksv[j][6], ksv[j][7]);
        *(LAS u32x4*)(KST + (2 * c2 + j) * S64 + rg * 16) = p; }
    LDS_BAR();
#pragma unroll
    for (int i = 0; i < 2; ++i) { const int c = tid + 512 * i; *(u32x4*)(a.KSTg + T * 8192 + (size_t)c * 8) = *(const LAS u32x4*)(KST + (c >> 3) * S64 + (c & 7) * 16); }
    { const int l0_ = 16 * (w & 3);
#pragma unroll
      for (int t = 0; t < 2; ++t) { const int s0 = 16 * ((w >> 2) * 2 + t);
          f32x4 sc = (f32x4){0.f, 0.f, 0.f, 0.f};
          if (s0 <= l0_ + 15) sc = mma_tile<4>(sc, KIN, S128, s0, QIN, S128, l0_, fr, fq);
          const int l = l0_ + fr, s = s0 + 4 * fq;
          u32x2 p; p.x = pk2(s <= l ? sc[0] : 0.f, s + 1 <= l ? sc[1] : 0.f); p.y = pk2(s + 2 <= l ? sc[2] : 0.f, s + 3 <= l ? sc[3] : 0.f);
          *(u32x2*)(a.Pg + T * 4096 + (size_t)l * 64 + s) = p; } }
    }
#undef HP_LOAD
    LDS_BAR();
}

DI void hgrn2_scan_unit(Frame& F, const Mix0Args& a, int u) {
    const int tid = F.tid, w = F.wave, lane = F.lane, fr = lane & 15, fq = lane >> 4;
    const int b = u >> 7, h = (u >> 2) & 31, vs = u & 3;
    constexpr int O_PM = 0, O_KST = O_PM + 64 * S64, O_QOUT = O_KST + 128 * S64, O_VT = O_QOUT + 64 * S128, O_GL = O_VT + 32 * S64, IMG = O_GL + 512;
    LAS uchar* IMG0 = F.lds; LAS uchar* STB0 = IMG0 + 2 * IMG;
    const int ltile = w & 3, jtile = w >> 2, l0_ = 16 * ltile, v0_ = 16 * jtile;
    const f32x4 anw = *(const f32x4*)(a.a_norm_w + h * 128 + vs * 32 + v0_ + 4 * fq);
    const int vv = tid & 31, lg = tid >> 5;
    for (int i = tid; i < 32 * S128 / 16; i += 512) ((LAS u32x4*)STB0)[i] = (u32x4){0u, 0u, 0u, 0u};
    f32x4 st[2] = {(f32x4){0.f, 0.f, 0.f, 0.f}, (f32x4){0.f, 0.f, 0.f, 0.f}};
    const size_t rowbase = (size_t)b * SEQ;
    const bf16* qocol = a.proj + C_Q + h * 128;
    const bf16* vcol = a.proj + C_I + h * 128 + vs * 32 + vv;
    const bf16* gacol = a.proj + C_GA + h * 128 + vs * 32 + v0_ + 4 * fq;
    bf16* oacol = a.outp + a.oa_col + h * 128 + vs * 32 + v0_ + 4 * fq;
    const size_t Tb = ((size_t)(b * 32 + h)) * 128;
    u32x4 pr, kr[2], qr[2]; unsigned vr[4]; u32x2 gar; f32x4 glr;
#define HS_LOAD(n_) do { const long r0_ = (long)rowbase + (long)(n_) * 64; const size_t T_ = Tb + (n_); \
        pr = *(const u32x4*)(a.Pg + T_ * 4096 + (size_t)tid * 8); \
        _Pragma("unroll") for (int i = 0; i < 2; ++i) { const int c_ = tid + 512 * i; kr[i] = *(const u32x4*)(a.KSTg + T_ * 8192 + (size_t)c_ * 8); \
            qr[i] = *(const u32x4*)(qocol + (size_t)(r0_ + (c_ >> 4)) * N1 + (c_ & 15) * 8); } \
        _Pragma("unroll") for (int i = 0; i < 4; ++i) vr[i] = *(const unsigned short*)(vcol + (size_t)(r0_ + 4 * lg + i) * N1); \
        gar = *(const u32x2*)(gacol + (size_t)(r0_ + l0_ + fr) * N1); \
        glr = *(const f32x4*)(a.GLg + T_ * 128 + (tid & 31) * 4); } while (0)
#define HS_STAGE(img_) do { LAS uchar* I_ = (img_); \
        *(LAS u32x4*)(I_ + O_PM + (tid >> 3) * S64 + (tid & 7) * 16) = pr; \
        _Pragma("unroll") for (int i = 0; i < 2; ++i) { const int c = tid + 512 * i; \
            *(LAS u32x4*)(I_ + O_KST + (c >> 3) * S64 + (c & 7) * 16) = kr[i]; \
            *(LAS u32x4*)(I_ + O_QOUT + (c >> 4) * S128 + (c & 15) * 16) = qr[i]; } \
        { u32x2 p_; p_.x = vr[0] | (vr[1] << 16); p_.y = vr[2] | (vr[3] << 16); *(LAS u32x2*)(I_ + O_VT + vv * S64 + lg * 8) = p_; } \
        if (tid < 32) *(LAS f32x4*)(I_ + O_GL + tid * 16) = glr; } while (0)
    HS_LOAD(0);
    HS_STAGE(IMG0);
    u32x2 ga_cur = gar;
    HS_LOAD(1);
    LDS_BAR();
    u32x2 p_d = {0u, 0u}; float ss_d = 0.f;
    for (int n = 0; n < NCH; ++n) {
        const size_t row0 = rowbase + (size_t)n * 64;
        LAS uchar* Ic = IMG0 + (n & 1) * IMG; LAS uchar* In = IMG0 + ((n + 1) & 1) * IMG;
        LAS uchar* STBc = STB0 + (n & 1) * 32 * S128; LAS uchar* STBn = STB0 + ((n + 1) & 1) * 32 * S128;
        const u32x2 ga_next = gar;
        if (n + 1 < NCH) HS_STAGE(In);
        asm volatile("" : "+v"(pr), "+v"(kr[0]), "+v"(kr[1]), "+v"(qr[0]), "+v"(qr[1]), "+v"(vr[0]), "+v"(vr[1]), "+v"(vr[2]), "+v"(vr[3]), "+v"(gar), "+v"(glr) :: "memory");
        if (n > 0) { if (fq == 0) unsafeAtomicAdd(a.ssq_a + row0 - 64 + l0_ + fr, ss_d); *(u32x2*)(oacol + (row0 - 64 + l0_ + fr) * a.out_ld) = p_d; }
        if (n + 2 < NCH) HS_LOAD(n + 2);
        { bf16x8 qf[4], sf[4], pf[2], kf[2], v2[2][2]; f32x4 g4;
#pragma unroll
          for (int ks = 0; ks < 4; ++ks) { qf[ks] = *(const LAS bf16x8*)(Ic + O_QOUT + (l0_ + fr) * S128 + ks * 64 + fq * 16); sf[ks] = *(const LAS bf16x8*)(STBc + (v0_ + fr) * S128 + ks * 64 + fq * 16); }
#pragma unroll
          for (int ks = 0; ks < 2; ++ks) { pf[ks] = *(const LAS bf16x8*)(Ic + O_PM + (l0_ + fr) * S64 + ks * 64 + fq * 16); kf[ks] = *(const LAS bf16x8*)(Ic + O_KST + (16 * w + fr) * S64 + ks * 64 + fq * 16);
#pragma unroll
              for (int vt = 0; vt < 2; ++vt) v2[vt][ks] = *(const LAS bf16x8*)(Ic + O_VT + (16 * vt + fr) * S64 + ks * 64 + fq * 16); }
          g4 = *(const LAS f32x4*)(Ic + O_GL + (16 * w + 4 * fq) * 4);
          f32x4 oacc = (f32x4){0.f, 0.f, 0.f, 0.f};
#pragma unroll
          for (int ks = 0; ks < 4; ++ks) oacc = __builtin_amdgcn_mfma_f32_16x16x32_bf16(sf[ks], qf[ks], oacc, 0, 0, 0);
#pragma unroll
          for (int ks = 0; ks < 2; ++ks) oacc = __builtin_amdgcn_mfma_f32_16x16x32_bf16(jtile ? v2[1][ks] : v2[0][ks], pf[ks], oacc, 0, 0, 0);
#pragma unroll
          for (int vt = 0; vt < 2; ++vt) { st[vt] = st[vt] * g4;
#pragma unroll
              for (int ks = 0; ks < 2; ++ks) st[vt] = __builtin_amdgcn_mfma_f32_16x16x32_bf16(kf[ks], v2[vt][ks], st[vt], 0, 0, 0);
              u32x2 p; p.x = pk2(st[vt][0], st[vt][1]); p.y = pk2(st[vt][2], st[vt][3]);
              *(LAS u32x2*)(STBn + (16 * vt + fr) * S128 + (16 * w + 4 * fq) * 2) = p; }
          float ss = (oacc[0] * oacc[0] + oacc[1] * oacc[1]) + (oacc[2] * oacc[2] + oacc[3] * oacc[3]);
          ss_d = fq_sum(ss);
          const float g0 = bflo(ga_cur.x), g1 = bfhi(ga_cur.x), g2 = bflo(ga_cur.y), g3 = bfhi(ga_cur.y);
          p_d.x = pk2(oacc[0] * anw[0] * fsilu(g0), oacc[1] * anw[1] * fsilu(g1)); p_d.y = pk2(oacc[2] * anw[2] * fsilu(g2), oacc[3] * anw[3] * fsilu(g3)); }
        ga_cur = ga_next;
        LDS_BAR();
    }
    { const size_t rl = rowbase + (size_t)(NCH - 1) * 64 + l0_ + fr; if (fq == 0) unsafeAtomicAdd(a.ssq_a + rl, ss_d); *(u32x2*)(oacol + rl * a.out_ld) = p_d; }
#undef HS_LOAD
#undef HS_STAGE
}

DI void rglru_scan_unit(Frame& F, const Mix0Args& a, int u) {
    const int tid = F.tid, w = F.wave, lane = F.lane, fr = lane & 15, fq = lane >> 4;
    const int b = u >> 7, nb = (u >> 2) & 31, qq = u & 3, cb = nb * 128;
    LAS uchar* XC0 = F.lds; LAS uchar* WAT = XC0 + 2 * 64 * S128; LAS uchar* WXT = WAT + 32 * S128;
    LAS float* SEG0 = (LAS float*)(WXT + 32 * S128); LAS float* HPREV = SEG0 + 2 * 1024;
    LAS uchar* CVS = F.lds + 65536 + w * 9216;
    const int gw = F.vcu * 8 + w, NGW = F.G * 8; const bool cv_on = (u == F.vcu);
    f32x4 cvv[16];
#pragma unroll
    for (int i = 0; i < 16; ++i) cvv[i] = (f32x4){0.f, 0.f, 0.f, 0.f};
    { const int j = tid & 31, kg = tid >> 5; float wv[8], xv[8];
#pragma unroll
      for (int i = 0; i < 8; ++i) { const size_t o = ((size_t)(nb * 128 + 8 * kg + i)) * 128 + qq * 32 + j; wv[i] = a.wa[o]; xv[i] = a.wx[o]; }
      u32x4 p; p.x = pk2(wv[0], wv[1]); p.y = pk2(wv[2], wv[3]); p.z = pk2(wv[4], wv[5]); p.w = pk2(wv[6], wv[7]); *(LAS u32x4*)(WAT + j * S128 + kg * 16) = p;
      p.x = pk2(xv[0], xv[1]); p.y = pk2(xv[2], xv[3]); p.z = pk2(xv[4], xv[5]); p.w = pk2(xv[6], xv[7]); *(LAS u32x4*)(WXT + j * S128 + kg * 16) = p; }
    if (tid < 64) HPREV[tid] = 0.f;
    const int c2 = tid & 63, rg = tid >> 6;
    float cw[4][2], cbs[2];
#pragma unroll
    for (int j = 0; j < 2; ++j) { const int ch = cb + 2 * c2 + j; cbs[j] = a.conv_b[ch];
#pragma unroll
        for (int k = 0; k < 4; ++k) cw[k][j] = a.conv_w[k * 4096 + ch]; }
    const int ltile = w & 3, jtile = w >> 2, l0_ = 16 * ltile, jj = 16 * jtile + fr, co = cb + qq * 32 + jj;
    const float bav = a.ba[co], bxv = a.bx[co], sp8l2 = 8.0f * LOG2E * log1pf(__expf(-a.lam[co]));
    const size_t rowbase = (size_t)b * SEQ;
    const bf16* xcol = a.proj + C_XB + cb + 2 * c2;
    const bf16* gbcol = a.proj + C_GB + co; bf16* obcol = a.outp + a.ob_col + co;
    unsigned xr[11], gbr[4];
#define RG_LOAD(n_) do { const long r0_ = (long)rowbase + (long)(n_) * 64; \
        _Pragma("unroll") for (int i = 0; i < 11; ++i) xr[i] = ((n_) == 0 && 8 * rg - 3 + i < 0) ? 0u : *(const unsigned*)(xcol + (size_t)(r0_ + 8 * rg - 3 + i) * N1); \
        _Pragma("unroll") for (int i = 0; i < 4; ++i) gbr[i] = *(const unsigned short*)(gbcol + (size_t)(r0_ + l0_ + 4 * fq + i) * N1); } while (0)
#define RG_STAGE(xc_) do { LAS uchar* X_ = (xc_); \
        _Pragma("unroll") for (int i = 0; i < 8; ++i) { f32x2 s2 = (f32x2){cbs[0], cbs[1]}; \
            _Pragma("unroll") for (int k = 0; k < 4; ++k) s2 += (f32x2){cw[k][0], cw[k][1]} * (f32x2){bflo(xr[i + k]), bfhi(xr[i + k])}; \
            *(LAS unsigned*)(X_ + (8 * rg + i) * S128 + c2 * 4) = pk2(s2.x, s2.y); } } while (0)
    RG_LOAD(0);
    RG_STAGE(XC0);
    unsigned gb_cur[4];
#pragma unroll
    for (int i = 0; i < 4; ++i) gb_cur[i] = gbr[i];
    RG_LOAD(1);
    LDS_BAR();
    for (int n = 0; n < NCH; ++n) {
        const size_t row0 = rowbase + (size_t)n * 64;
        LAS uchar* XCc = XC0 + (n & 1) * 64 * S128; LAS uchar* XCn = XC0 + ((n + 1) & 1) * 64 * S128;
        LAS float* SEGA = SEG0 + (n & 1) * 1024; LAS float* SEGH = SEGA + 512;
        unsigned gb_next[4];
#pragma unroll
        for (int i = 0; i < 4; ++i) gb_next[i] = gbr[i];
        if (n + 1 < NCH) RG_STAGE(XCn);
        if (n + 2 < NCH) RG_LOAD(n + 2);
        if (cv_on && (n & 3) == 0) { const int idx = (n >> 2) * NGW + gw; if (idx < CV_NIT) cv_issue(a.cv, idx, lane, cvv); }
        const f32x4 zero4 = (f32x4){0.f, 0.f, 0.f, 0.f};
        float av[4], uv[4]; float Aseg = 1.f, Hseg = 0.f;
        { bf16x8 xf[4], waf[4], wxf[4]; unsigned xcr[4];
#pragma unroll
          for (int ks = 0; ks < 4; ++ks) { xf[ks] = *(const LAS bf16x8*)(XCc + (l0_ + fr) * S128 + ks * 64 + fq * 16);
              waf[ks] = *(const LAS bf16x8*)(WAT + (16 * jtile + fr) * S128 + ks * 64 + fq * 16); wxf[ks] = *(const LAS bf16x8*)(WXT + (16 * jtile + fr) * S128 + ks * 64 + fq * 16); }
#pragma unroll
          for (int r = 0; r < 4; ++r) xcr[r] = *(const LAS unsigned short*)(XCc + (l0_ + 4 * fq + r) * S128 + (qq * 32 + jj) * 2);
          f32x4 R = zero4, I = zero4;
#pragma unroll
          for (int ks = 0; ks < 4; ++ks) { R = __builtin_amdgcn_mfma_f32_16x16x32_bf16(xf[ks], waf[ks], R, 0, 0, 0); I = __builtin_amdgcn_mfma_f32_16x16x32_bf16(xf[ks], wxf[ks], I, 0, 0, 0); }
#pragma unroll
          for (int r = 0; r < 4; ++r) {
              const float rr = fsigmoid(R[r] + bav), ig = fsigmoid(I[r] + bxv);
              const float aa = fexp2(-sp8l2 * rr); const float om = __builtin_fmaf(-aa, aa, 1.0f);
              av[r] = aa; uv[r] = __builtin_sqrtf(om) * (ig * bf2f(xcr[r]));
              Hseg = aa * Hseg + uv[r]; Aseg *= aa; } }
        const int sgi = ltile * 4 + fq;
        SEGA[sgi * 32 + jj] = Aseg; SEGH[sgi * 32 + jj] = Hseg;
        LDS_BAR();
        float carry = HPREV[(n & 1) * 32 + jj]; float sa[15], sh[15];
#pragma unroll
        for (int s = 0; s < 15; ++s) { sa[s] = SEGA[s * 32 + jj]; sh[s] = SEGH[s * 32 + jj]; }
#pragma unroll
        for (int s = 0; s < 15; ++s) carry = (s < sgi) ? sa[s] * carry + sh[s] : carry;
#pragma unroll
        for (int r = 0; r < 4; ++r) { carry = av[r] * carry + uv[r];
            const float o = carry * fsilu(bf2f(gb_cur[r]));
            obcol[(row0 + l0_ + 4 * fq + r) * a.out_ld] = (bf16)(pk2(o, 0.f) & 0xffffu); }
        if (sgi == 15) HPREV[((n + 1) & 1) * 32 + jj] = carry;
#pragma unroll
        for (int i = 0; i < 4; ++i) gb_cur[i] = gb_next[i];
        if (cv_on && (n & 3) == 2) { const int idx = (n >> 2) * NGW + gw; if (idx < CV_NIT) cv_finish(a.cv, idx, lane, cvv, CVS); }
    }
    if (cv_on) for (int sl = NCH / 4; sl * NGW + gw < CV_NIT; ++sl) { cv_issue(a.cv, sl * NGW + gw, lane, cvv); cv_finish(a.cv, sl * NGW + gw, lane, cvv, CVS); }
#undef RG_LOAD
#undef RG_STAGE
    LDS_BAR();
}
struct Mix1Args { bf16* proj; const float* conv_w; const float* conv_b; const float* dt_bias; const float* a_log; const float* d_skip; const float* norm_w; float* ssq_y; bf16* outp; int out_ld, o_col;
                  bf16* Cg; bf16* BTg; bf16* CBg; float* TABg; int var; const float* dtp; };
constexpr int SX = 144;

DI void ssd_prep_unit(Frame& F, const Mix1Args& a, int U) {
    const int tid = F.tid, w = F.wave, lane = F.lane, fr = lane & 15, fq = lane >> 4;
    const int g = U & 7, n = (U >> 3) & 127, b = U >> 10;
    LAS uchar* CC = F.lds; LAS uchar* BC = CC + 64 * S128; LAS uchar* BT = BC + 64 * S128;
    const int c2 = tid & 63, rg = tid >> 6;
    float bw[4][2], bb[2], cw[4][2], cbs[2];
#pragma unroll
    for (int j = 0; j < 2; ++j) { const int chb = 8192 + g * 128 + 2 * c2 + j, chc = 9216 + g * 128 + 2 * c2 + j;
        bb[j] = a.conv_b[chb]; cbs[j] = a.conv_b[chc];
#pragma unroll
        for (int k = 0; k < 4; ++k) { bw[k][j] = a.conv_w[k * 10240 + chb]; cw[k][j] = a.conv_w[k * 10240 + chc]; } }
    const long r0 = (long)b * SEQ + (long)n * 64 + 8 * rg - 3;
    const bf16* bcol = a.proj + C_B + g * 128 + 2 * c2;
    const bf16* ccol = a.proj + C_C + g * 128 + 2 * c2;
    unsigned bc[11], cc[11];
#pragma unroll
    for (int i = 0; i < 11; ++i) { const bool zz = (n == 0 && 8 * rg - 3 + i < 0);
        bc[i] = zz ? 0u : *(const unsigned*)(bcol + (size_t)(r0 + i) * N3P); cc[i] = zz ? 0u : *(const unsigned*)(ccol + (size_t)(r0 + i) * N3P); }
    { float bt[2][8];
#pragma unroll
      for (int i = 0; i < 8; ++i) { float vb[2], vc[2];
#pragma unroll
          for (int j = 0; j < 2; ++j) { float sb = bb[j], sc = cbs[j];
#pragma unroll
              for (int k = 0; k < 4; ++k) { sb += bw[k][j] * (j ? bfhi(bc[i + k]) : bflo(bc[i + k])); sc += cw[k][j] * (j ? bfhi(cc[i + k]) : bflo(cc[i + k])); }
              vb[j] = fsilu(sb); vc[j] = fsilu(sc); bt[j][i] = vb[j]; }
          *(LAS unsigned*)(BC + (8 * rg + i) * S128 + c2 * 4) = pk2(vb[0], vb[1]);
          *(LAS unsigned*)(CC + (8 * rg + i) * S128 + c2 * 4) = pk2(vc[0], vc[1]); }
#pragma unroll
      for (int j = 0; j < 2; ++j) { u32x4 p; p.x = pk2(bt[j][0], bt[j][1]); p.y = pk2(bt[j][2], bt[j][3]); p.z = pk2(bt[j][4], bt[j][5]); p.w = pk2(bt[j][6], bt[j][7]);
          *(LAS u32x4*)(BT + (2 * c2 + j) * S64 + rg * 16) = p; } }
    LDS_BAR();
    const size_t T = ((size_t)(b * 128 + n)) * 8 + g;
#pragma unroll
    for (int i = 0; i < 2; ++i) { const int c = tid + 512 * i, ln = c & 63;
        *(u32x4*)(a.Cg + T * 8192 + (size_t)c * 8) = *(const LAS u32x4*)(CC + (16 * (c >> 8) + (ln & 15)) * S128 + ((c >> 6) & 3) * 64 + (ln >> 4) * 16);
        *(u32x4*)(a.BTg + T * 8192 + (size_t)c * 8) = *(const LAS u32x4*)(BT + (16 * (c >> 7) + (ln & 15)) * S64 + ((c >> 6) & 1) * 64 + (ln >> 4) * 16); }
    { const int l0_ = 16 * (w & 3);
#pragma unroll
      for (int t = 0; t < 2; ++t) { const int m0 = 16 * ((w >> 2) * 2 + t);
          const f32x4 cbv = mma_tile<4>((f32x4){0.f, 0.f, 0.f, 0.f}, BC, S128, m0, CC, S128, l0_, fr, fq);
          u32x2 p; p.x = pk2(cbv[0], cbv[1]); p.y = pk2(cbv[2], cbv[3]);
          *(u32x2*)(a.CBg + T * 4096 + (size_t)(l0_ + fr) * 64 + m0 + 4 * fq) = p; } }
#pragma unroll
    for (int t = 0; t < 2; ++t) { const int h = 16 * g + 2 * w + t;
        const size_t di = ((size_t)b * SEQ + (size_t)n * 64 + lane) * 128 + h; const size_t dq = (size_t)16384 * 128;
        const float xx = ((a.dtp[di] + a.dtp[di + dq]) + (a.dtp[di + 2 * dq] + a.dtp[di + 3 * dq])) + a.dt_bias[h];
        const float dtv = xx > 20.f ? xx : log1pf(__expf(xx)); float cs = dtv * (-__expf(a.a_log[h]) * LOG2E);
#pragma unroll
        for (int o = 1; o < 64; o <<= 1) { const float tt = __shfl_up(cs, o); if (lane >= o) cs += tt; }
        float* tp = a.TABg + (((size_t)(b * 128 + n)) * 128 + h) * 128; tp[lane] = cs; tp[64 + lane] = dtv; }
    LDS_BAR();
}

struct SsdSt { u32x4 cb; unsigned x[7]; float tb[2]; };
struct SsdOp { bf16x8 cf[4], bf[2]; u32x2 z[2]; };
DI void ssd_unit(Frame& F, const Mix1Args& a, int u) {
    const int tid = F.tid, w = F.wave, lane = F.lane, fr = lane & 15, fq = lane >> 4;
    const int b = u >> 7, h = u & 127, g = h >> 4;
    constexpr int O_XDT = 0, O_XDS = 64 * S64, O_MM = 2 * 64 * S64, IMG = 3 * 64 * S64;
    LAS uchar* IMG0 = F.lds; LAS uchar* SB0 = IMG0 + 2 * IMG; LAS float* TAB = (LAS float*)(SB0 + 2 * 64 * S128) + w * 128;
    const int c2x = tid & 31, rg4 = tid >> 5;
    float xw[4][2], xb[2];
#pragma unroll
    for (int j = 0; j < 2; ++j) { const int chx = h * 64 + 2 * c2x + j; xb[j] = a.conv_b[chx];
#pragma unroll
        for (int k = 0; k < 4; ++k) xw[k][j] = a.conv_w[k * 10240 + chx]; }
    const float Dh = a.d_skip[h];
    const int ltile = w & 3, l0_ = 16 * ltile, ph = (w >> 2) * 2;
    const size_t rowbase = (size_t)b * SEQ;
    const unsigned vo16 = (unsigned)tid * 16u, vot = (unsigned)lane * 4u;
    const unsigned voc = (unsigned)((ltile * 256 + lane) * 16), vob = (unsigned)((w * 128 + lane) * 16);
    unsigned vox[7];
#pragma unroll
    for (int i = 0; i < 7; ++i) vox[i] = (unsigned)((4 * rg4 + i) * N3P + C_X + h * 64 + 2 * c2x) * 2u;
    const unsigned voz = (unsigned)((l0_ + fr) * N3P + C_Z + h * 64 + 16 * ph + 4 * fq) * 2u;
    const unsigned voo = (unsigned)((l0_ + fr) * a.out_ld + a.o_col + h * 64 + 16 * ph + 4 * fq) * 2u, vos = (unsigned)(l0_ + fr) * 4u;
    const char* const pC = (const char*)a.Cg; const char* const pB = (const char*)a.BTg; const char* const pCB = (const char*)a.CBg;
    const char* const pP = (const char*)a.proj; const char* const pT = (const char*)a.TABg; char* const pO = (char*)a.outp; char* const pS = (char*)a.ssq_y;
    for (int i = tid; i < 64 * S128 / 16; i += 512) ((LAS u32x4*)SB0)[i] = (u32x4){0u, 0u, 0u, 0u};
    f32x4 st[4];
#pragma unroll
    for (int t = 0; t < 4; ++t) st[t] = (f32x4){0.f, 0.f, 0.f, 0.f};
    auto load_st = [&](int n_, SsdSt& r) __attribute__((always_inline)) {
        const size_t T_ = ((size_t)(b * 128 + n_)) * 8 + g; const long r0_ = (long)rowbase + (long)n_ * 64;
        const char* uCB = pCB + T_ * 8192; const char* uX = pP + (r0_ - 3) * (long)(N3P * 2); const char* uT = pT + (((size_t)(b * 128 + n_)) * 128 + h) * 512;
        r.cb = *(const u32x4*)(uCB + vo16);
#pragma unroll
        for (int i = 0; i < 7; ++i) r.x[i] = (n_ == 0 && 4 * rg4 - 3 + i < 0) ? 0u : *(const unsigned*)(uX + vox[i]);
        r.tb[0] = *(const float*)(uT + vot); r.tb[1] = *(const float*)(uT + 256 + vot); };
    auto load_op = [&](int n_, SsdOp& r) __attribute__((always_inline)) {
        const size_t T_ = ((size_t)(b * 128 + n_)) * 8 + g; const long r0_ = (long)rowbase + (long)n_ * 64;
        const char* uC = pC + T_ * 16384; const char* uB = pB + T_ * 16384; const char* uZ = pP + r0_ * (long)(N3P * 2);
#pragma unroll
        for (int ks = 0; ks < 4; ++ks) r.cf[ks] = *(const bf16x8*)(uC + ks * 1024 + voc);
#pragma unroll
        for (int ks = 0; ks < 2; ++ks) r.bf[ks] = *(const bf16x8*)(uB + ks * 1024 + vob);
#pragma unroll
        for (int t = 0; t < 2; ++t) r.z[t] = *(const u32x2*)(uZ + 32 * t + voz); };
    u32x2 p_d[2] = {(u32x2){0u, 0u}, (u32x2){0u, 0u}}; float ss_d = 0.f;
    auto put = [&](int n_) __attribute__((always_inline)) {
        const size_t r0_ = rowbase + (size_t)n_ * 64; char* uO = pO + r0_ * (size_t)(a.out_ld * 2); char* uS = pS + r0_ * 4;
#pragma unroll
        for (int t = 0; t < 2; ++t) *(u32x2*)(uO + 32 * t + voo) = p_d[t];
        if (fq == 0) unsafeAtomicAdd((float*)(uS + vos), ss_d); };
    float el_c = 0.f, dec_c = 0.f;
    auto stage = [&](const SsdSt& c, LAS uchar* I) __attribute__((always_inline)) {
        TAB[lane] = c.tb[0]; TAB[64 + lane] = c.tb[1];
        asm volatile("s_waitcnt lgkmcnt(0)" ::: "memory");
        const float cs_last = TAB[63];
        { const int l = tid >> 3, m8 = (tid & 7) * 8; u32x4 p = (u32x4){0u, 0u, 0u, 0u}; const u32x4 cbc = c.cb;
          if (m8 <= l) { const float csl = TAB[l]; const float dsk = Dh * frcp(fmaxf(TAB[64 + l], 1e-20f)); const f32x4 ca = *(const LAS f32x4*)(TAB + m8), cb4 = *(const LAS f32x4*)(TAB + m8 + 4);
              float mv[8];
#pragma unroll
              for (int j = 0; j < 8; ++j) { const unsigned wv = j < 2 ? cbc.x : j < 4 ? cbc.y : j < 6 ? cbc.z : cbc.w; const float cbv = (j & 1) ? bfhi(wv) : bflo(wv);
                  const float csm = j < 4 ? ca[j & 3] : cb4[j & 3];
                  mv[j] = (m8 + j <= l) ? cbv * fexp2(fminf(csl - csm, 0.f)) : 0.f; if (m8 + j == l) mv[j] += dsk; }
              p.x = pk2(mv[0], mv[1]); p.y = pk2(mv[2], mv[3]); p.z = pk2(mv[4], mv[5]); p.w = pk2(mv[6], mv[7]); }
          *(LAS u32x4*)(I + O_MM + l * S64 + m8 * 2) = p; }
        { f32x2 xv[7];
#pragma unroll
          for (int i = 0; i < 7; ++i) xv[i] = (f32x2){bflo(c.x[i]), bfhi(c.x[i])};
          float xd[2][4], xs_[2][4];
#pragma unroll
          for (int i = 0; i < 4; ++i) { const int l = 4 * rg4 + i; const float dl = TAB[64 + l], sl = fexp2(cs_last - TAB[l]);
              f32x2 s2 = (f32x2){xb[0], xb[1]};
#pragma unroll
              for (int k = 0; k < 4; ++k) s2 += (f32x2){xw[k][0], xw[k][1]} * xv[i + k];
              xd[0][i] = fsilu(s2.x) * dl; xd[1][i] = fsilu(s2.y) * dl; xs_[0][i] = xd[0][i] * sl; xs_[1][i] = xd[1][i] * sl; }
#pragma unroll
          for (int j = 0; j < 2; ++j) { u32x2 p; p.x = pk2(xd[j][0], xd[j][1]); p.y = pk2(xd[j][2], xd[j][3]); *(LAS u32x2*)(I + O_XDT + (2 * c2x + j) * S64 + rg4 * 8) = p;
              p.x = pk2(xs_[j][0], xs_[j][1]); p.y = pk2(xs_[j][2], xs_[j][3]); *(LAS u32x2*)(I + O_XDS + (2 * c2x + j) * S64 + rg4 * 8) = p; } }
        el_c = fexp2(TAB[l0_ + fr]); dec_c = fexp2(cs_last); };
    auto compute = [&](int n, const SsdOp& o, LAS uchar* I, float el, float dec) __attribute__((always_inline)) {
        LAS uchar* SBc = SB0 + (n & 1) * 64 * S128; LAS uchar* SBn = SB0 + ((n + 1) & 1) * 64 * S128;
        f32x4 yacc[2];
        { bf16x8 sf[2][4], mf[2], xf[2][2];
#pragma unroll
          for (int ks = 0; ks < 4; ++ks) {
#pragma unroll
              for (int t = 0; t < 2; ++t) sf[t][ks] = *(const LAS bf16x8*)(SBc + (16 * (ph + t) + fr) * S128 + ks * 64 + fq * 16); }
#pragma unroll
          for (int ks = 0; ks < 2; ++ks) { mf[ks] = *(const LAS bf16x8*)(I + O_MM + (l0_ + fr) * S64 + ks * 64 + fq * 16);
#pragma unroll
              for (int t = 0; t < 2; ++t) xf[t][ks] = *(const LAS bf16x8*)(I + O_XDT + (16 * (ph + t) + fr) * S64 + ks * 64 + fq * 16); }
#pragma unroll
          for (int t = 0; t < 2; ++t) { f32x4 acc = (f32x4){0.f, 0.f, 0.f, 0.f};
#pragma unroll
              for (int ks = 0; ks < 4; ++ks) acc = __builtin_amdgcn_mfma_f32_16x16x32_bf16(sf[t][ks], o.cf[ks], acc, 0, 0, 0);
              acc = acc * el;
#pragma unroll
              for (int ks = 0; ks < 2; ++ks) acc = __builtin_amdgcn_mfma_f32_16x16x32_bf16(xf[t][ks], mf[ks], acc, 0, 0, 0);
              yacc[t] = acc; } }
        { bf16x8 xs2[4][2];
#pragma unroll
          for (int ks = 0; ks < 2; ++ks) {
#pragma unroll
              for (int t = 0; t < 4; ++t) xs2[t][ks] = *(const LAS bf16x8*)(I + O_XDS + (16 * t + fr) * S64 + ks * 64 + fq * 16); }
#pragma unroll
          for (int t = 0; t < 4; ++t) { st[t] = st[t] * dec;
#pragma unroll
              for (int ks = 0; ks < 2; ++ks) st[t] = __builtin_amdgcn_mfma_f32_16x16x32_bf16(o.bf[ks], xs2[t][ks], st[t], 0, 0, 0);
              u32x2 p; p.x = pk2(st[t][0], st[t][1]); p.y = pk2(st[t][2], st[t][3]); *(LAS u32x2*)(SBn + (16 * t + fr) * S128 + (16 * w + 4 * fq) * 2) = p; } }
        { float ss = 0.f;
#pragma unroll
          for (int t = 0; t < 2; ++t) {
              const float z0 = bflo(o.z[t].x), z1 = bfhi(o.z[t].x), z2 = bflo(o.z[t].y), z3 = bfhi(o.z[t].y);
              const float y0 = yacc[t][0] * fsilu(z0), y1 = yacc[t][1] * fsilu(z1), y2 = yacc[t][2] * fsilu(z2), y3 = yacc[t][3] * fsilu(z3);
              ss += (y0 * y0 + y1 * y1) + (y2 * y2 + y3 * y3);
              p_d[t].x = pk2(y0, y1); p_d[t].y = pk2(y2, y3); }
          ss_d = fq_sum(ss); } };
    auto step = [&](int n, SsdSt& sa, SsdSt& sb, SsdOp& oa, SsdOp& ob) __attribute__((always_inline)) {
        asm volatile("" : "+v"(sa.cb), "+v"(sa.x[0]), "+v"(sa.x[1]), "+v"(sa.x[2]), "+v"(sa.x[3]), "+v"(sa.x[4]), "+v"(sa.x[5]), "+v"(sa.x[6]), "+v"(sa.tb[0]), "+v"(sa.tb[1]) :: "memory");
        asm volatile("" : "+v"(oa.cf[0]), "+v"(oa.cf[1]), "+v"(oa.cf[2]), "+v"(oa.cf[3]), "+v"(oa.bf[0]), "+v"(oa.bf[1]), "+v"(oa.z[0]), "+v"(oa.z[1]) :: "memory");
        if (n > 0) put(n - 1);
        if (n + 2 < NCH) load_st(n + 2, sb);
        if (n + 1 < NCH) load_op(n + 1, ob);
        const float el = el_c, dec = dec_c;
        if (n + 1 < NCH) stage(sa, IMG0 + ((n + 1) & 1) * IMG);
        compute(n, oa, IMG0 + (n & 1) * IMG, el, dec);
        LDS_BAR(); };
    SsdSt s0, s1; SsdOp o0, o1;
    load_st(0, s0); load_op(0, o0);
    stage(s0, IMG0);
    load_st(1, s1);
    LDS_BAR();
    for (int n = 0; n < NCH; n += 2) { step(n, s1, s0, o0, o1); step(n + 1, s0, s1, o1, o0); }
    put(NCH - 1);
}
#if MODE_MULTI && (NAIVE_MIX0 || NAIVE_MIX1)
__global__ void __launch_bounds__(256) naive_hgrn2(Mix0Args a) {
    __shared__ float red[8][32];
    const int u = blockIdx.x, tid = threadIdx.x, b = u >> 7, h = (u >> 2) & 31, vs = u & 3, v = tid & 31, dg = tid >> 5;
    float S[16], lb[16];
#pragma unroll
    for (int i = 0; i < 16; ++i) { S[i] = 0.f; const int col = h * 128 + dg * 16 + i; const float l0 = a.lb_logits[col], l1 = a.lb_logits[4096 + col], l2 = a.lb_logits[8192 + col];
        const float mx = fmaxf(l0, fmaxf(l1, l2)); const float e0 = expf(l0 - mx), e1 = expf(l1 - mx), e2 = expf(l2 - mx); lb[i] = e0 / (e0 + e1 + e2); }
    const float anw = a.a_norm_w[h * 128 + vs * 32 + v];
    for (int t = 0; t < SEQ; ++t) {
        bf16* row = a.proj + ((size_t)b * SEQ + t) * N1;
        const float vv = bf2f(row[C_I + h * 128 + vs * 32 + v]);
        float part = 0.f;
#pragma unroll
        for (int i = 0; i < 16; ++i) { const int d = h * 128 + dg * 16 + i; const float q = bf2f(row[C_Q + d]), z = bf2f(row[C_F + d]);
            const float sg = 1.0f / (1.0f + expf(-z)); const float fg = lb[i] + (1.0f - lb[i]) * sg; const float kk = (1.0f - lb[i]) * (1.0f - sg);
            S[i] = fg * S[i] + kk * vv; part += (q / (1.0f + expf(-q))) * S[i]; }
        red[dg][v] = part;
        __syncthreads();
        if (dg == 0) { float o = 0.f;
#pragma unroll
            for (int g = 0; g < 8; ++g) o += red[g][v];
            float ss = o * o;
#pragma unroll
            for (int off = 1; off < 32; off <<= 1) ss += __shfl_xor(ss, off);
            if (v == 0) unsafeAtomicAdd(a.ssq_a + (size_t)b * SEQ + t, ss);
            const float ga = bf2f(row[C_GA + h * 128 + vs * 32 + v]);
            row[C_I + h * 128 + vs * 32 + v] = (bf16)(pk2(o * anw * (ga / (1.0f + expf(-ga))), 0.f) & 0xffffu); }
        __syncthreads();
    }
}
__global__ void __launch_bounds__(256) naive_rglru(Mix0Args a) {
    __shared__ float xcs[128]; __shared__ float redr[8][32]; __shared__ float redi[8][32];
    const int u = blockIdx.x, tid = threadIdx.x, b = u >> 7, nb = (u >> 2) & 31, qq = u & 3, j = tid & 31, kg = tid >> 5, cb = nb * 128, co = cb + qq * 32 + j;
    float wa[16], wx[16];
#pragma unroll
    for (int i = 0; i < 16; ++i) { const size_t o = ((size_t)(nb * 128 + kg * 16 + i)) * 128 + qq * 32 + j; wa[i] = a.wa[o]; wx[i] = a.wx[o]; }
    const float bav = a.ba[co], bxv = a.bx[co], sp = log1pf(expf(-a.lam[co]));
    float hst = 0.f;
    for (int t = 0; t < SEQ; ++t) {
        const size_t rowi = (size_t)b * SEQ + t;
        if (tid < 128) { const int ch = cb + tid; float s = a.conv_b[ch];
#pragma unroll
            for (int k = 0; k < 4; ++k) { const int tt = t - 3 + k; if (tt >= 0) s += a.conv_w[k * 4096 + ch] * bf2f(a.proj[((size_t)b * SEQ + tt) * N1 + C_XB + ch]); }
            xcs[tid] = s; }
        __syncthreads();
        float pr = 0.f, pi = 0.f;
#pragma unroll
        for (int i = 0; i < 16; ++i) { const float x = xcs[kg * 16 + i]; pr += x * wa[i]; pi += x * wx[i]; }
        redr[kg][j] = pr; redi[kg][j] = pi;
        __syncthreads();
        if (kg == 0) { float R = bav, I = bxv;
#pragma unroll
            for (int g = 0; g < 8; ++g) { R += redr[g][j]; I += redi[g][j]; }
            const float r = 1.0f / (1.0f + expf(-R)), ig = 1.0f / (1.0f + expf(-I));
            const float la = -8.0f * r * sp; const float aa = expf(la); const float uu = sqrtf(-expm1f(2.0f * la)) * (ig * xcs[qq * 32 + j]);
            hst = aa * hst + uu;
            bf16* gp = a.proj + rowi * N1 + C_GB + co; const float gb = bf2f(*gp);
            *gp = (bf16)(pk2(hst * (gb / (1.0f + expf(-gb))), 0.f) & 0xffffu); }
        __syncthreads();
    }
}
__global__ void __launch_bounds__(256) naive_ssd(Mix1Args a) {
    __shared__ float xs[64]; __shared__ float red[4][32];
    const int u = blockIdx.x, tid = threadIdx.x, b = u >> 7, h = u & 127, g = h >> 4, k = tid & 127, pg = tid >> 7, wv = tid >> 6, lane = tid & 63;
    float S[32];
#pragma unroll
    for (int i = 0; i < 32; ++i) S[i] = 0.f;
    const float A = -expf(a.a_log[h]), dtb = a.dt_bias[h], Dh = a.d_skip[h];
    const int chb = 8192 + g * 128 + k, chc = 9216 + g * 128 + k;
    for (int t = 0; t < SEQ; ++t) {
        const size_t rowi = (size_t)b * SEQ + t;
        float sb = a.conv_b[chb], sc = a.conv_b[chc];
#pragma unroll
        for (int kk = 0; kk < 4; ++kk) { const int tt = t - 3 + kk; if (tt >= 0) { const bf16* r = a.proj + ((size_t)b * SEQ + tt) * N3P + C_X;
            sb += a.conv_w[kk * 10240 + chb] * bf2f(r[chb]); sc += a.conv_w[kk * 10240 + chc] * bf2f(r[chc]); } }
        const float Bv = sb / (1.0f + expf(-sb)), Cv = sc / (1.0f + expf(-sc));
        if (tid < 64) { const int chx = h * 64 + tid; float s = a.conv_b[chx];
#pragma unroll
            for (int kk = 0; kk < 4; ++kk) { const int tt = t - 3 + kk; if (tt >= 0) s += a.conv_w[kk * 10240 + chx] * bf2f(a.proj[((size_t)b * SEQ + tt) * N3P + C_X + chx]); }
            xs[tid] = s / (1.0f + expf(-s)); }
        const float xx = bf2f(a.proj[rowi * N3P + C_DT + h]) + dtb; const float dt = xx > 20.f ? xx : log1pf(expf(xx)); const float da = expf(dt * A);
        __syncthreads();
#pragma unroll
        for (int i = 0; i < 32; ++i) { S[i] = S[i] * da + dt * xs[pg * 32 + i] * Bv; float y = Cv * S[i];
#pragma unroll
            for (int off = 1; off < 64; off <<= 1) y += __shfl_xor(y, off);
            if (lane == 0) red[wv][i] = y; }
        __syncthreads();
        if (tid < 64) { const int p = tid; const float y = red[(p >> 5) * 2][p & 31] + red[(p >> 5) * 2 + 1][p & 31] + Dh * xs[p];
            bf16* zp = a.proj + rowi * N3P + C_Z + h * 64 + p; const float z = bf2f(*zp); const float yy = y * (z / (1.0f + expf(-z)));
            float ss = yy * yy;
#pragma unroll
            for (int off = 1; off < 64; off <<= 1) ss += __shfl_xor(ss, off);
            if (p == 0) unsafeAtomicAdd(a.ssq_y + rowi, ss);
            *zp = (bf16)(pk2(yy, 0.f) & 0xffffu); }
        __syncthreads();
    }
}
#endif
struct Args { const float* in[22]; float* out; unsigned char* ws; int ph_lo, ph_hi, dummy, pad; };
constexpr int NPHASE = 10;
__global__ void __launch_bounds__(512, 2) fwd(Args args) {
    extern __shared__ __attribute__((aligned(16))) unsigned char lds[];
    Frame F;
    F.lds = (LAS uchar*)lds;
    F.MISC = (volatile LAS unsigned*)(F.lds + MISC_OFF);
    F.tid = threadIdx.x; F.lane = F.tid & 63; F.wave = __builtin_amdgcn_readfirstlane(F.tid >> 6);
    F.G = gridDim.x; { const int bx = blockIdx.x; F.vcu = (F.G % 8 == 0) ? (bx % 8) * (F.G / 8) + bx / 8 : bx; }
    unsigned char* ws = args.ws;
    F.ctl = (unsigned*)(ws + WS_CTL);
    for (int u = F.tid; u < (LDS_BYTES - LDSCTL_OFF) / 4; u += 512) ((LAS unsigned*)(F.lds + LDSCTL_OFF))[u] = 0u;
    __syncthreads();
    const int lo = args.ph_lo, hi = args.ph_hi;
    XcdBarrier bar; bar.bar = F.ctl + CW_BAR; bar.x = 0; bar.st = nullptr;
    if (hi - lo > 1) bar = xcd_barrier_post(F.ctl + CW_BAR, F.MISC + 8);
#define IN(k) (lo <= (k) && (k) < hi)
#define BOTH(k) (IN(k) && IN((k) + 1))
    const float* x = args.in[0]; const float* norm_w = args.in[1];
    bf16* W1 = (bf16*)(ws + WS_W1); bf16* W2 = (bf16*)(ws + WS_W2); bf16* W3 = (bf16*)(ws + WS_W3); bf16* W4 = (bf16*)(ws + WS_W4);
    bf16* HN = (bf16*)(ws + WS_HN); bf16* PROJ = (bf16*)(ws + WS_PROJ);
    float* ssq_a = (float*)(F.ctl + CW_SSQA); float* ssq_h1 = (float*)(F.ctl + CW_SSQH1); float* ssq_y = (float*)(F.ctl + CW_SSQY); float* ssq_h2 = (float*)(F.ctl + CW_SSQH2);
    constexpr int NOJ = 1 << 30;
    const bool dmy = args.dummy != 0; float* ssq_dmy = (float*)(F.ctl + CW_DUMMY);

    if (IN(0)) { const P0Args pa{x, norm_w, args.in[2], args.in[12], args.in[13], args.in[20], W1, W2, W3, W4, HN};
        p0_prologue(F, pa); if (BOTH(0)) xcd_barrier(bar); }
    if (IN(1)) { pg8::Gemm g{HN, W1, M, N1, D, D, D, NOJ, 0, 0}; pg8::StaticOrder S; S.init(M, N1, F.G, (int)blockIdx.x);
        pg8::EpiBf16 E{PROJ, N1, nullptr};
        pg8::gemm_phase<pg8::EpiBf16, pg8::StaticOrder, true, true>(F.lds, g, S, E);
        if (BOTH(1)) xcd_barrier(bar); }
    if (IN(2) || IN(3)) { const Mix0Args ma{PROJ, args.in[3], args.in[4], args.in[5], args.in[6], args.in[7], args.in[8], args.in[9], args.in[10], args.in[11], dmy ? ssq_dmy : ssq_a,
            PROJ, N1, dmy ? C_F : C_I, dmy ? C_F : C_GB, (bf16*)(ws + WS_PG), (bf16*)(ws + WS_HN), (float*)(ws + WS_GL), dmy ? 1 : 0,
            CvJob{args.in[12], args.in[13], args.in[20], norm_w + D, args.in[19], W2, W3, W4}};
        if (IN(2)) { hgrn2_prep_all(F, ma); if (BOTH(2)) xcd_barrier(bar); }
        if (IN(3)) { for (int u = F.vcu; u < 256; u += F.G) hgrn2_scan_unit(F, ma, u);
                     for (int u = F.vcu; u < 256; u += F.G) rglru_scan_unit(F, ma, u); if (BOTH(3)) xcd_barrier(bar); } }
    if (IN(4)) { pg8::Gemm g{PROJ + C_I, W2, M, D, K2, N1, K2, 64, (long)(C_GB - C_I - 4096) * 2, 0}; pg8::StaticOrder S; S.init(M, D, F.G, (int)blockIdx.x, 4);
        pg8::EpiRes16 E{x, nullptr, HN, ssq_a, nullptr, dmy ? ssq_dmy : ssq_h1};
        pg8::gemm_phase<pg8::EpiRes16, pg8::StaticOrder, true, true>(F.lds, g, S, E);
        if (BOTH(4)) xcd_barrier(bar); }
    if (IN(5)) { { pg8::Gemm g{HN, W3, M, N3DT, D, D, D, NOJ, 0, 0}; pg8::StaticOrder S; S.init(M, N3DT, F.G, (int)blockIdx.x);
          pg8::EpiBf16 E{PROJ, N3P, ssq_h1};
          pg8::gemm_phase<pg8::EpiBf16, pg8::StaticOrder, true, true>(F.lds, g, S, E); }
        { pg8::Gemm g{HN, W3 + (size_t)N3DT * D, M, 256, 1024, D, D, NOJ, 0, 2048}; pg8::KSplitOrder S; S.init(M, F.G, (int)blockIdx.x);
          pg8::EpiDtPart E{(float*)(ws + WS_W1), ssq_h1};
          pg8::gemm_phase<pg8::EpiDtPart, pg8::KSplitOrder, true, true>(F.lds, g, S, E); }
        if (BOTH(5)) xcd_barrier(bar); }
    if (IN(6) || IN(7)) { const Mix1Args ma{PROJ, args.in[14], args.in[15], args.in[16], args.in[17], args.in[18], args.in[19], dmy ? ssq_dmy : ssq_y, dmy ? (bf16*)(ws + WS_DUMMY1) : PROJ, dmy ? 8192 : N3P, dmy ? 0 : C_Z,
            (bf16*)(ws + WS_PREP), (bf16*)(ws + WS_PREP + 32 * MiB), (bf16*)(ws + WS_PREP + 64 * MiB), (float*)(ws + WS_PREP + 80 * MiB), dmy ? (args.dummy >> 4) : 0, (const float*)(ws + WS_W1)};
        if (IN(6)) { for (int U = F.vcu; U < 2048; U += F.G) ssd_prep_unit(F, ma, U); if (BOTH(6)) xcd_barrier(bar); }
        if (IN(7)) { for (int u = F.vcu; u < 256; u += F.G) ssd_unit(F, ma, u); if (BOTH(7)) xcd_barrier(bar); } }
    const bool fuse_fin = (F.G == 256);
    if (IN(8)) { pg8::Gemm g{PROJ + C_Z, W4, M, D, K4, N3P, K4, NOJ, 0, 0};
        if (fuse_fin) { pg8::StaticOrder S; S.init(M, D, F.G, (int)blockIdx.x, 2);
            pg8::EpiFinal E{HN, dmy ? (float*)(ws + WS_DUMMY1) : args.out, args.in[21], ssq_y, dmy ? ssq_dmy : ssq_h2, F.ctl + CW_PANEL + (dmy ? 64 * 64 : 0), F.ctl + CW_CODE};
            pg8::gemm_phase<pg8::EpiFinal, pg8::StaticOrder, true, true>(F.lds, g, S, E); }
        else { pg8::StaticOrder S; S.init(M, D, F.G, (int)blockIdx.x, 4);
            pg8::EpiRes16 E{nullptr, HN, dmy ? (bf16*)(ws + WS_DUMMY1) : HN, nullptr, ssq_y, dmy ? ssq_dmy : ssq_h2};
            pg8::gemm_phase<pg8::EpiRes16, pg8::StaticOrder, true, true>(F.lds, g, S, E);
            if (BOTH(8)) xcd_barrier(bar); } }
    if (IN(9) && !fuse_fin) p7_final(F, HN, dmy ? (float*)(ws + WS_DUMMY1) : args.out, ssq_h2, args.in[21]);
#undef IN
#undef BOTH
}

extern "C" void kernel_launch(void* const* d_in, const int* in_sizes, int n_in, void* d_out, int out_size, void* d_ws, size_t ws_size, hipStream_t stream) {
    static int grid = 0;
    if (grid == 0) {
        if (n_in != 22 || out_size != M * D || ws_size < WS_END) { fprintf(stderr, "kernel_launch: unexpected problem (n_in %d out %d ws %zu)\n", n_in, out_size, ws_size); grid = -1; return; }
        int dev = 0, cus = 0, per_cu = 0;
        if (hipGetDevice(&dev) != hipSuccess || hipDeviceGetAttribute(&cus, hipDeviceAttributeMultiprocessorCount, dev) != hipSuccess) { grid = -1; return; }
        if (hipFuncSetAttribute((const void*)fwd, hipFuncAttributeMaxDynamicSharedMemorySize, LDS_BYTES) != hipSuccess) { fprintf(stderr, "kernel_launch: hipFuncSetAttribute failed\n"); grid = -1; return; }
        if (hipOccupancyMaxActiveBlocksPerMultiprocessor(&per_cu, (const void*)fwd, 512, LDS_BYTES) != hipSuccess || per_cu < 1) fprintf(stderr, "kernel_launch: occupancy query reports %d\n", per_cu);
        (void)hipGetLastError();
        grid = cus;
    }
    if (grid < 0) return;
    (void)hipMemsetAsync((char*)d_ws + WS_CTL, 0, CTL_ZERO_BYTES, stream);
    Args a{};
    for (int i = 0; i < 22; ++i) a.in[i] = (const float*)d_in[i];
    a.out = (float*)d_out; a.ws = (unsigned char*)d_ws;
#if MODE_MULTI
    for (int ph = 0; ph < NPHASE; ++ph) {
        a.ph_lo = ph; a.ph_hi = ph + 1;
#if NAIVE_MIX0
        if (ph == 2) continue;
        if (ph == 3) { const Mix0Args ma{(bf16*)((char*)d_ws + WS_PROJ), a.in[3], a.in[4], a.in[5], a.in[6], a.in[7], a.in[8], a.in[9], a.in[10], a.in[11], (float*)((char*)d_ws + WS_CTL) + CW_SSQA, (bf16*)((char*)d_ws + WS_PROJ), N1, C_I, C_GB, nullptr, nullptr, nullptr, 0, CvJob{}};
            hipLaunchKernelGGL(naive_hgrn2, dim3(256), dim3(256), 0, stream, ma); hipLaunchKernelGGL(naive_rglru, dim3(256), dim3(256), 0, stream, ma); continue; }
#endif
#if NAIVE_MIX1
        if (ph == 6) continue;
        if (ph == 7) { const Mix1Args ma{(bf16*)((char*)d_ws + WS_PROJ), a.in[14], a.in[15], a.in[16], a.in[17], a.in[18], a.in[19], (float*)((char*)d_ws + WS_CTL) + CW_SSQY, (bf16*)((char*)d_ws + WS_PROJ), N3P, C_Z, nullptr, nullptr, nullptr, nullptr, 0, nullptr};
            hipLaunchKernelGGL(naive_ssd, dim3(256), dim3(256), 0, stream, ma); continue; }
#endif
        if ((PROBE_REP >> ph) & 1) { a.dummy = 1 | (PROBE_VAR << 4); hipLaunchKernelGGL(fwd, dim3(grid), dim3(512), LDS_BYTES, stream, a); a.dummy = 0; }
        hipLaunchKernelGGL(fwd, dim3(grid), dim3(512), LDS_BYTES, stream, a);
    }
#else
    a.ph_lo = 0; a.ph_hi = NPHASE;
    hipLaunchKernelGGL(fwd, dim3(grid), dim3(512), LDS_BYTES, stream, a);
#endif
}
```

```cpp
#include <hip/hip_runtime.h>
#include <cstdio>
#include <cstdint>

#ifndef MODE_MULTI
#define MODE_MULTI 0
#endif
#ifndef NAIVE_MIX0
#define NAIVE_MIX0 0
#endif
#ifndef NAIVE_MIX1
#define NAIVE_MIX1 0
#endif

#ifndef PROBE_REP
#define PROBE_REP 0
#endif

#ifndef PROBE_VAR
#define PROBE_VAR 0
#endif
#define GAS __attribute__((address_space(1)))
#define LAS __attribute__((address_space(3)))
#define DI __device__ __forceinline__
typedef unsigned short bf16;
typedef unsigned u32x4 __attribute__((ext_vector_type(4)));
typedef unsigned u32x2 __attribute__((ext_vector_type(2)));
typedef float f32x4 __attribute__((ext_vector_type(4)));
typedef float f32x2 __attribute__((ext_vector_type(2)));
typedef short bf16x8 __attribute__((ext_vector_type(8)));
typedef __bf16 bf16v2 __attribute__((ext_vector_type(2)));
typedef unsigned char uchar;

constexpr int SEQ = 8192, M = 16384, D = 4096;
constexpr int N1 = 24576, K2 = 8192, N3 = 18560, N3P = 18688, N3DT = 18432, K4 = 8192;
constexpr int NCH = SEQ / 64;
constexpr int C_Q = 0, C_F = 4096, C_I = 8192, C_GA = 12288, C_XB = 16384, C_GB = 20480;
constexpr int C_Z = 0, C_X = 8192, C_B = 16384, C_C = 17408, C_DT = 18432;
constexpr float EPS = 1e-6f;
constexpr float LOG2E = 1.4426950408889634f;

constexpr size_t MiB = 1u << 20;
constexpr size_t WS_CTL = 0, CTL_ZERO_BYTES = 1 * MiB;
constexpr size_t WS_W1 = 1 * MiB;
constexpr size_t WS_W2 = 193 * MiB;
constexpr size_t WS_W3 = 257 * MiB;
constexpr size_t WS_W4 = 403 * MiB;
constexpr size_t WS_HN = 467 * MiB;
constexpr size_t WS_PROJ = 595 * MiB;
constexpr size_t WS_END = 1432 * MiB;
constexpr int CW_TMO = 0, CW_CODE = 1;
constexpr int CW_BAR = 4096;
constexpr int CW_SSQA = 16384, CW_SSQH1 = 32768, CW_SSQY = 49152, CW_SSQH2 = 65536;
constexpr int CW_DUMMY = 81920;
constexpr int CW_PANEL = 98304;
static_assert((CW_PANEL + 2 * 64 * 64) * 4 <= (int)CTL_ZERO_BYTES, "ctl");
constexpr size_t WS_PREP = 1179 * MiB;
constexpr size_t WS_PG = 1363 * MiB, WS_GL = 1427 * MiB;
constexpr size_t WS_DUMMY1 = 1280 * MiB;

constexpr int RING_BYTES = 131072;
constexpr int LDS_BYTES = 147456;
constexpr int LDSCTL_OFF = LDS_BYTES - 512, MISC_OFF = LDSCTL_OFF + 320;

DI float bflo(unsigned w) { return __uint_as_float(w << 16); }
DI float bfhi(unsigned w) { return __uint_as_float(w & 0xffff0000u); }
DI float bf2f(unsigned h) { return __uint_as_float(h << 16); }
DI unsigned pk2(float lo, float hi) { f32x2 v = {lo, hi}; bf16v2 b = __builtin_convertvector(v, bf16v2); return __builtin_bit_cast(unsigned, b); }
DI float fexp2(float x) { return __builtin_amdgcn_exp2f(x); }
DI float flog2(float x) { return __builtin_amdgcn_logf(x); }
DI float frcp(float x) { return __builtin_amdgcn_rcpf(x); }
DI float fsigmoid(float x) { return frcp(1.0f + fexp2(-LOG2E * x)); }
DI float fsilu(float x) { return x * fsigmoid(x); }
#define LDS_BAR() do { asm volatile("s_waitcnt lgkmcnt(0)" ::: "memory"); __builtin_amdgcn_s_barrier(); asm volatile("" ::: "memory"); } while (0)
#define VM_WAIT() asm volatile("s_waitcnt vmcnt(0)" ::: "memory")
DI float fq_sum(float x) {
    auto r = __builtin_amdgcn_permlane16_swap(__float_as_uint(x), __float_as_uint(x), false, false); x = __uint_as_float(r[0]) + __uint_as_float(r[1]);
    auto q = __builtin_amdgcn_permlane32_swap(__float_as_uint(x), __float_as_uint(x), false, false); return __uint_as_float(q[0]) + __uint_as_float(q[1]);
}
DI float wave_sum(float v) {
#pragma unroll
    for (int o = 1; o < 64; o <<= 1) v += __shfl_xor(v, o);
    return v;
}
#define XB_TMO      128
#define XB_XCNT(j)  (256  + 64 * (j))
#define XB_XSUB(j)  (1280 + 64 * (j))
#define XB_XGEN(j)  (2304 + 64 * (j))
#define XB_TOP      3328
#define XB_TOPGEN   3392
#define XCD_BAR_WORDS 3456
#define XB_SPIN_CAP (1u << 18)

__device__ __forceinline__ unsigned xb_ld(unsigned* p)              { return __hip_atomic_load(p, __ATOMIC_RELAXED, __HIP_MEMORY_SCOPE_AGENT); }
__device__ __forceinline__ unsigned xb_add(unsigned* p, unsigned v) { return __hip_atomic_fetch_add(p, v, __ATOMIC_RELAXED, __HIP_MEMORY_SCOPE_AGENT); }
__device__ __forceinline__ unsigned xb_xcc_id() { return (unsigned)__builtin_amdgcn_s_getreg((3 << 11) | 20) & 0xFu; }
#define XB_SPIN(cond, bar) do { unsigned _sp = 0; while (cond) { __builtin_amdgcn_s_sleep(1); \
    if ((++_sp & 255u) == 0u) { if (xb_ld(&(bar)[XB_TMO])) break; if (_sp > XB_SPIN_CAP) { atomicAdd(&(bar)[XB_TMO], 1u); break; } } } } while (0)

struct XcdBarrier {
    unsigned* bar; unsigned x;
    volatile LAS unsigned* st;
};

__device__ __forceinline__ XcdBarrier xcd_barrier_post(unsigned* bar, volatile LAS unsigned* st) {
    XcdBarrier b; b.bar = bar; b.x = xb_xcc_id(); b.st = st;
    if (threadIdx.x == 0) (void)xb_add(&bar[XB_XCNT(b.x)], 1u);
    return b;
}
__device__ __forceinline__ void xcd_barrier_complete(unsigned* bar, unsigned x, unsigned& nloc, unsigned& nx) {
    const unsigned G = gridDim.x * gridDim.y * gridDim.z;
    unsigned sum, cnt, mine, sp = 0u;
    for (;;) {
        sum = 0u; cnt = 0u; mine = 0u;
#pragma unroll
        for (unsigned j = 0; j < 16; ++j) { const unsigned c = xb_ld(&bar[XB_XCNT(j)]); sum += c; cnt += (c > 0u) ? 1u : 0u; mine = (j == x) ? c : mine; }
        if (sum == G) break;
        __builtin_amdgcn_s_sleep(1);
        if ((++sp & 255u) == 0u) { if (xb_ld(&bar[XB_TMO])) break; if (sp > XB_SPIN_CAP) { atomicAdd(&bar[XB_TMO], 1u); break; } }
    }
    nloc = mine > 0u ? mine : 1u; nx = cnt > 0u ? cnt : 1u;
}

__device__ __forceinline__ void xcd_barrier(const XcdBarrier& b) {
    asm volatile("s_waitcnt vmcnt(0)" ::: "memory");
    __syncthreads();
    if (threadIdx.x == 0) {
        unsigned* bar = b.bar;
        __builtin_amdgcn_s_waitcnt(0);
        unsigned nloc = b.st[0], nx = b.st[1];
        if (nloc == 0u) { xcd_barrier_complete(bar, b.x, nloc, nx); b.st[0] = nloc; b.st[1] = nx; }
        const unsigned old = xb_add(&bar[XB_XSUB(b.x)], 1u);
        const unsigned gen = old / nloc;
        if (old + 1u == (gen + 1u) * nloc) {
            __builtin_amdgcn_fence(__ATOMIC_RELEASE, "agent");
            asm volatile("s_waitcnt vmcnt(0)" ::: "memory");
            const unsigned og = xb_add(&bar[XB_TOP], 1u);
            const unsigned tg = og / nx;
            if (og + 1u == (tg + 1u) * nx) xb_add(&bar[XB_TOPGEN], 1u);
            else XB_SPIN(xb_ld(&bar[XB_TOPGEN]) == tg, bar);
            __builtin_amdgcn_fence(__ATOMIC_ACQUIRE, "agent");
            xb_add(&bar[XB_XGEN(b.x)], 1u);
            asm volatile("s_waitcnt vmcnt(0)" ::: "memory");
        } else {
            XB_SPIN(xb_ld(&bar[XB_XGEN(b.x)]) == gen, bar);
            __builtin_amdgcn_fence(__ATOMIC_ACQUIRE, "agent");
            asm volatile("s_waitcnt vmcnt(0)" ::: "memory");
        }
    }
    __syncthreads();
}
namespace pg8 {
#define PG8_LAS __attribute__((address_space(3)))
typedef unsigned short bf16_t;
typedef short bf16x8 __attribute__((ext_vector_type(8)));
typedef float f32x4 __attribute__((ext_vector_type(4)));
typedef unsigned u32x4 __attribute__((ext_vector_type(4)));
constexpr int BM = 256, BK = 64, HALF = 128, HTB = HALF * BK * 2  , STAGE_BYTES = 8 * HTB, NXCD = 8, WGM = 8;

__host__ __device__ __forceinline__ int lds_byte(int r, int c) { const int st = (r >> 4) * 2 + (c >> 5), rr = r & 15, cc = c & 31, ob = rr * 64 + cc * 2; return st * 1024 + (ob ^ (((ob >> 9) & 1) << 5)); }
__host__ __device__ __forceinline__ void stage_rc(int b, int& R, int& C) { const int st = b / 1024, sb = b % 1024, swz = sb ^ (((sb >> 9) & 1) << 5); R = (st >> 1) * 16 + swz / 64; C = (st & 1) * 32 + (swz % 64) / 2; }
__host__ __device__ __forceinline__ int perm32(int rho) { const int n = rho >> 4, i = rho & 15; return 8 * (i >> 2) + 4 * n + (i & 3); }

struct Unit { int pm, pn, kq; };
struct Gemm { const bf16_t* A; const bf16_t* Bt; int M, N, K, lda, ldb, kj_t; long kj_bytes; long kq_bytes; };

struct StaticOrder {
    int nM, nN, nwg, G, c, wgm;
    __host__ __device__ void init(int M, int N, int G_, int c_, int wgm_ = WGM) { nM = M / BM; nN = N / BM; nwg = nM * nN; G = G_; c = c_; wgm = wgm_; }
    __host__ __device__ bool next(int i, Unit& u) const {
        const long L = (long)i * G + c; if (L >= nwg) return false;
        int wgid = (int)L; { const int q = nwg / NXCD, r = nwg % NXCD, xcd = wgid % NXCD, off = wgid / NXCD; wgid = (xcd < r ? xcd * (q + 1) : r * (q + 1) + (xcd - r) * q) + off; }
        const int nig = wgm * nN, gid = wgid / nig, fm = gid * wgm, gsz = (nM - fm) < wgm ? (nM - fm) : wgm;
        u.pm = fm + ((wgid % nig) % gsz); u.pn = (wgid % nig) / gsz; u.kq = 0; return true;
    }
    __device__ __forceinline__ void a_ready(const Unit&) const {}
    __device__ __forceinline__ void done(const Unit&) const {}
};


struct KSplitOrder {
    int nM, G, c;
    __host__ __device__ void init(int M, int G_, int c_) { nM = M / BM; G = G_; c = c_; }
    __host__ __device__ bool next(int i, Unit& u) const { const int L = i * G + c; if (L >= 4 * nM) return false; u.pm = L >> 2; u.pn = 0; u.kq = L & 3; return true; }
    __device__ __forceinline__ void a_ready(const Unit&) const {}
    __device__ __forceinline__ void done(const Unit&) const {}
};
DI unsigned cvt_pk_bf16(float lo, float hi) { f32x2 v = {lo, hi}; bf16v2 b = __builtin_convertvector(v, bf16v2); return __builtin_bit_cast(unsigned, b); }

struct EpiBf16 {
    static constexpr bool PERM = true, AFTER_DRAIN = false, MIDK = false;
    bf16_t* O; int ldc; const float* ssq;
    DI void midk(f32x4 (&)[2][2][4][2], const Unit&, int, int) const {}
    DI void operator()(const f32x4 (&acc)[2][2][4][2], const Unit& u, int wr, int wc, int fr, int fq) const {
        const int row0 = u.pm * BM + wr * 64 + fr; const int col0 = u.pn * BM + wc * 32 + 8 * fq;
        float rs[2][4];
#pragma unroll
        for (int ai = 0; ai < 2; ++ai)
#pragma unroll
            for (int m = 0; m < 4; ++m) rs[ai][m] = ssq ? __builtin_amdgcn_rsqf(ssq[row0 + ai * HALF + m * 16] * (1.0f / 4096.0f) + 1e-6f) : 1.0f;
#pragma unroll
        for (int ai = 0; ai < 2; ++ai)
#pragma unroll
            for (int m = 0; m < 4; ++m) { bf16_t* rowp = O + (size_t)(row0 + ai * HALF + m * 16) * ldc + col0; const float s = rs[ai][m];
#pragma unroll
                for (int bj = 0; bj < 2; ++bj) { const f32x4 v0 = acc[ai][bj][m][0] * s, v1 = acc[ai][bj][m][1] * s;
                    u32x4 w; w.x = cvt_pk_bf16(v0[0], v0[1]); w.y = cvt_pk_bf16(v0[2], v0[3]); w.z = cvt_pk_bf16(v1[0], v1[1]); w.w = cvt_pk_bf16(v1[2], v1[3]);
                    *(u32x4*)(rowp + bj * HALF) = w; } }
    }
};

struct EpiRes {
    static constexpr bool PERM = false, AFTER_DRAIN = false, MIDK = true;
    const float* base; float* out; bf16_t* hn; const float* nw; const float* ssq_mid; const float* ssq_epi; float* ssq_out;
    DI void midk(f32x4 (&acc)[2][2][4][2], const Unit& u, int wr, int fr) const {
        if (!ssq_mid) return;
        const int row0 = u.pm * BM + wr * 64 + fr;
#pragma unroll
        for (int ai = 0; ai < 2; ++ai)
#pragma unroll
            for (int m = 0; m < 4; ++m) { const float s = __builtin_amdgcn_rsqf(ssq_mid[row0 + ai * HALF + m * 16] * (1.0f / 4096.0f) + 1e-6f);
#pragma unroll
                for (int bj = 0; bj < 2; ++bj)
#pragma unroll
                    for (int n = 0; n < 2; ++n) acc[ai][bj][m][n] *= s; }
    }
    DI void operator()(const f32x4 (&acc)[2][2][4][2], const Unit& u, int wr, int wc, int fr, int fq) const {
        const int row0 = u.pm * BM + wr * 64 + fr, col0 = u.pn * BM + wc * 32 + 4 * fq;
        f32x4 nwv[2][2];
#pragma unroll
        for (int bj = 0; bj < 2; ++bj)
#pragma unroll
            for (int n = 0; n < 2; ++n) nwv[bj][n] = hn ? *(const f32x4*)(nw + col0 + bj * HALF + n * 16) : (f32x4){0.f, 0.f, 0.f, 0.f};
        f32x4 nxt[2][2];
#pragma unroll
        for (int bj = 0; bj < 2; ++bj)
#pragma unroll
            for (int n = 0; n < 2; ++n) nxt[bj][n] = *(const f32x4*)(base + (size_t)row0 * 4096 + col0 + bj * HALF + n * 16);
#pragma unroll
        for (int g = 0; g < 8; ++g) { const int ai = g >> 2, m = g & 3; const int row = row0 + ai * HALF + m * 16; const size_t off = (size_t)row * 4096 + col0;
            f32x4 cur[2][2];
#pragma unroll
            for (int bj = 0; bj < 2; ++bj)
#pragma unroll
                for (int n = 0; n < 2; ++n) cur[bj][n] = nxt[bj][n];
            if (g + 1 < 8) { const size_t offn = (size_t)(row0 + ((g + 1) >> 2) * HALF + ((g + 1) & 3) * 16) * 4096 + col0;
#pragma unroll
                for (int bj = 0; bj < 2; ++bj)
#pragma unroll
                    for (int n = 0; n < 2; ++n) nxt[bj][n] = *(const f32x4*)(base + offn + bj * HALF + n * 16); }
            const float s = ssq_epi ? __builtin_amdgcn_rsqf(ssq_epi[row] * (1.0f / 8192.0f) + 1e-6f) : 1.0f;
            float ss = 0.f;
#pragma unroll
            for (int bj = 0; bj < 2; ++bj)
#pragma unroll
                for (int n = 0; n < 2; ++n) { const f32x4 v = cur[bj][n] + acc[ai][bj][m][n] * s;
                    *(f32x4*)(out + off + bj * HALF + n * 16) = v; ss += (v[0] * v[0] + v[1] * v[1]) + (v[2] * v[2] + v[3] * v[3]);
                    if (hn) { const f32x4 w = nwv[bj][n]; u32x2 p; p.x = cvt_pk_bf16(v[0] * w[0], v[1] * w[1]); p.y = cvt_pk_bf16(v[2] * w[2], v[3] * w[3]);
                        *(u32x2*)(hn + off + bj * HALF + n * 16) = p; } }
            ss = fq_sum(ss);
            if (fq == 0) unsafeAtomicAdd(ssq_out + row, ss);
            asm volatile("" ::: "memory"); }
    }
};

struct EpiRes16 {
    static constexpr bool PERM = true, AFTER_DRAIN = false, MIDK = true;
    const float* base32; const bf16_t* base16; bf16_t* O; const float* ssq_mid; const float* ssq_epi; float* ssq_out;
    DI void midk(f32x4 (&acc)[2][2][4][2], const Unit& u, int wr, int fr) const {
        if (!ssq_mid) return;
        const int row0 = u.pm * BM + wr * 64 + fr;
#pragma unroll
        for (int ai = 0; ai < 2; ++ai)
#pragma unroll
            for (int m = 0; m < 4; ++m) { const float s = __builtin_amdgcn_rsqf(ssq_mid[row0 + ai * HALF + m * 16] * (1.0f / 4096.0f) + 1e-6f);
#pragma unroll
                for (int bj = 0; bj < 2; ++bj)
#pragma unroll
                    for (int n = 0; n < 2; ++n) acc[ai][bj][m][n] *= s; }
    }
    DI void operator()(const f32x4 (&acc)[2][2][4][2], const Unit& u, int wr, int wc, int fr, int fq) const {
        const int row0 = u.pm * BM + wr * 64 + fr, col0 = u.pn * BM + wc * 32 + 8 * fq;
        f32x4 nx32[2][2]; u32x4 nx16[2];
        if (base32) {
#pragma unroll
            for (int bj = 0; bj < 2; ++bj)
#pragma unroll
                for (int n = 0; n < 2; ++n) nx32[bj][n] = *(const f32x4*)(base32 + (size_t)row0 * 4096 + col0 + bj * HALF + 4 * n);
        } else {
#pragma unroll
            for (int bj = 0; bj < 2; ++bj) nx16[bj] = *(const u32x4*)(base16 + (size_t)row0 * 4096 + col0 + bj * HALF);
        }
#pragma unroll
        for (int g = 0; g < 8; ++g) { const int ai = g >> 2, m = g & 3; const int row = row0 + ai * HALF + m * 16; const size_t off = (size_t)row * 4096 + col0;
            f32x4 cur[2][2];
            if (base32) {
#pragma unroll
                for (int bj = 0; bj < 2; ++bj)
#pragma unroll
                    for (int n = 0; n < 2; ++n) cur[bj][n] = nx32[bj][n];
            } else {
#pragma unroll
                for (int bj = 0; bj < 2; ++bj) { const u32x4 w = nx16[bj]; cur[bj][0] = (f32x4){bflo(w.x), bfhi(w.x), bflo(w.y), bfhi(w.y)}; cur[bj][1] = (f32x4){bflo(w.z), bfhi(w.z), bflo(w.w), bfhi(w.w)}; }
            }
            if (g + 1 < 8) { const size_t offn = (size_t)(row0 + ((g + 1) >> 2) * HALF + ((g + 1) & 3) * 16) * 4096 + col0;
                if (base32) {
#pragma unroll
                    for (int bj = 0; bj < 2; ++bj)
#pragma unroll
                        for (int n = 0; n < 2; ++n) nx32[bj][n] = *(const f32x4*)(base32 + offn + bj * HALF + 4 * n);
                } else {
#pragma unroll
                    for (int bj = 0; bj < 2; ++bj) nx16[bj] = *(const u32x4*)(base16 + offn + bj * HALF);
                } }
            const float s = ssq_epi ? __builtin_amdgcn_rsqf(ssq_epi[row] * (1.0f / 8192.0f) + 1e-6f) : 1.0f;
            float ss = 0.f;
#pragma unroll
            for (int bj = 0; bj < 2; ++bj) { const f32x4 v0 = cur[bj][0] + acc[ai][bj][m][0] * s, v1 = cur[bj][1] + acc[ai][bj][m][1] * s;
                ss += ((v0[0] * v0[0] + v0[1] * v0[1]) + (v0[2] * v0[2] + v0[3] * v0[3])) + ((v1[0] * v1[0] + v1[1] * v1[1]) + (v1[2] * v1[2] + v1[3] * v1[3]));
                u32x4 w; w.x = cvt_pk_bf16(v0[0], v0[1]); w.y = cvt_pk_bf16(v0[2], v0[3]); w.z = cvt_pk_bf16(v1[0], v1[1]); w.w = cvt_pk_bf16(v1[2], v1[3]);
                *(u32x4*)(O + off + bj * HALF) = w; }
            ss = fq_sum(ss);
            if (fq == 0) unsafeAtomicAdd(ssq_out + row, ss);
            asm volatile("" ::: "memory"); }
    }
};

struct EpiDtPart {
    static constexpr bool PERM = false, AFTER_DRAIN = false, MIDK = false;
    float* part; const float* ssq;
    DI void midk(f32x4 (&)[2][2][4][2], const Unit&, int, int) const {}
    DI void operator()(const f32x4 (&acc)[2][2][4][2], const Unit& u, int wr, int wc, int fr, int fq) const {
        const int row0 = u.pm * BM + wr * 64 + fr, col0 = wc * 32 + 4 * fq; float* P = part + (size_t)u.kq * 16384 * 128;
#pragma unroll
        for (int ai = 0; ai < 2; ++ai)
#pragma unroll
            for (int m = 0; m < 4; ++m) { const int row = row0 + ai * HALF + m * 16; const float s = __builtin_amdgcn_rsqf(ssq[row] * (1.0f / 4096.0f) + 1e-6f);
#pragma unroll
                for (int n = 0; n < 2; ++n) *(f32x4*)(P + (size_t)row * 128 + col0 + 16 * n) = acc[ai][0][m][n] * s; }
    }
};

struct EpiFinal {
    static constexpr bool PERM = true, AFTER_DRAIN = false, MIDK = false;
    const bf16_t* base16; float* out; const float* fw; const float* ssq_epi; float* ssq_out; unsigned* cnt; unsigned* tmo;
    DI void midk(f32x4 (&)[2][2][4][2], const Unit&, int, int) const {}
    DI void operator()(f32x4 (&acc)[2][2][4][2], const Unit& u, int wr, int wc, int fr, int fq) const {
        const int row0 = u.pm * BM + wr * 64 + fr, col0 = u.pn * BM + wc * 32 + 8 * fq;
        u32x4 q16[2][2];
#define EF_LOAD(slot_, g_) do { const size_t o_ = (size_t)(row0 + ((g_) >> 2) * HALF + ((g_) & 3) * 16) * 4096 + col0; \
            _Pragma("unroll") for (int bj = 0; bj < 2; ++bj) q16[slot_][bj] = *(const u32x4*)(base16 + o_ + bj * HALF); } while (0)
        EF_LOAD(0, 0); EF_LOAD(1, 1);
#pragma unroll
        for (int g = 0; g < 8; ++g) { const int ai = g >> 2, m = g & 3; const int row = row0 + ai * HALF + m * 16;
            f32x4 cur[2][2];
#pragma unroll
            for (int bj = 0; bj < 2; ++bj) { const u32x4 w = q16[g & 1][bj]; cur[bj][0] = (f32x4){bflo(w.x), bfhi(w.x), bflo(w.y), bfhi(w.y)}; cur[bj][1] = (f32x4){bflo(w.z), bfhi(w.z), bflo(w.w), bfhi(w.w)}; }
            if (g + 2 < 8) EF_LOAD(g & 1, g + 2);
            const float s = __builtin_amdgcn_rsqf(ssq_epi[row] * (1.0f / 8192.0f) + 1e-6f);
            float ss = 0.f;
#pragma unroll
            for (int bj = 0; bj < 2; ++bj) { const f32x4 v0 = cur[bj][0] + acc[ai][bj][m][0] * s, v1 = cur[bj][1] + acc[ai][bj][m][1] * s;
                ss += ((v0[0] * v0[0] + v0[1] * v0[1]) + (v0[2] * v0[2] + v0[3] * v0[3])) + ((v1[0] * v1[0] + v1[1] * v1[1]) + (v1[2] * v1[2] + v1[3] * v1[3]));
                acc[ai][bj][m][0] = v0; acc[ai][bj][m][1] = v1; }
            ss = fq_sum(ss);
            if (fq == 0) unsafeAtomicAdd(ssq_out + row, ss); }
#undef EF_LOAD
        asm volatile("s_waitcnt vmcnt(0)" ::: "memory");
        unsigned* c = cnt + 64 * u.pm;
        if (fr == 0 && fq == 0) __hip_atomic_fetch_add(c, 1u, __ATOMIC_RELAXED, __HIP_MEMORY_SCOPE_AGENT);
        { unsigned sp = 0;
          while ((unsigned)__builtin_amdgcn_readfirstlane(__hip_atomic_load(c, __ATOMIC_RELAXED, __HIP_MEMORY_SCOPE_AGENT)) < 128u) {
              __builtin_amdgcn_s_sleep(2);
              if (++sp > (1u << 19)) { if (fr == 0 && fq == 0) __hip_atomic_store(tmo, 0x900u | (unsigned)(u.pm & 0xff), __ATOMIC_RELAXED, __HIP_MEMORY_SCOPE_AGENT); break; } } }
        f32x4 fwv[2][2];
#pragma unroll
        for (int bj = 0; bj < 2; ++bj)
#pragma unroll
            for (int n = 0; n < 2; ++n) fwv[bj][n] = *(const f32x4*)(fw + col0 + bj * HALF + 4 * n);
#pragma unroll
        for (int g = 0; g < 8; ++g) { const int ai = g >> 2, m = g & 3; const int row = row0 + ai * HALF + m * 16;
            const float tot = __hip_atomic_load(ssq_out + row, __ATOMIC_RELAXED, __HIP_MEMORY_SCOPE_AGENT);
            const float rs = __builtin_amdgcn_rsqf(tot * (1.0f / 4096.0f) + 1e-6f);
#pragma unroll
            for (int bj = 0; bj < 2; ++bj)
#pragma unroll
                for (int n = 0; n < 2; ++n) *(f32x4*)(out + (size_t)row * 4096 + col0 + bj * HALF + 4 * n) = acc[ai][bj][m][n] * rs * fwv[bj][n]; }
    }
};
template <class Epi, class Sched, bool ALIGN_EPI = false, bool SP2 = false>
__device__ __forceinline__ void gemm_phase(PG8_LAS unsigned char* lds, const Gemm g, const Sched& S, const Epi& E) {
    const int tid = threadIdx.x, wid = __builtin_amdgcn_readfirstlane(tid >> 6), lane = tid & 63, wr = wid >> 2, wc = wid & 3, fr = lane & 15, fq = lane >> 4;
    const int K = g.K, nt = K / BK;
    unsigned voffA[2], voffB[2];
#pragma unroll
    for (int i = 0; i < 2; ++i) { int R, C; stage_rc(tid * 16 + i * 8192, R, C); const int Rb = Epi::PERM ? ((R & ~31) + perm32(R & 31)) : R;
        voffA[i] = (unsigned)(R * g.lda + C) * 2u; voffB[i] = (unsigned)(Rb * g.ldb + C) * 2u; }
    const size_t kstep = (size_t)(BK * 2);
    const size_t hstepA = (size_t)HALF * g.lda * 2, hstepB = (size_t)HALF * g.ldb * 2;
    const size_t tstepA = 2 * hstepA, tstepB = 2 * hstepB;
    const unsigned ldsw = (unsigned)wid * 1024u;
    const int aoff = lds_byte(wr * 64 + fr, fq * 8), boff = lds_byte(wc * 32 + fr, fq * 8);
#define PG8_SA(b, h) (((b) * 2 + (h)) * HTB)
#define PG8_SB(b, h) ((4 + (b) * 2 + (h)) * HTB)
#define PG8_STAGE(bufoff, gbase, voff) do { _Pragma("unroll") for (int _i = 0; _i < 2; ++_i) \
        __builtin_amdgcn_global_load_lds((const unsigned*)((const char*)(gbase) + (voff)[_i]), (PG8_LAS unsigned*)(lds + (bufoff) + ldsw + _i * 8192), 16, 0, 0); } while (0)
#define PG8_LDA(dst, b, h) do { _Pragma("unroll") for (int m = 0; m < 4; ++m) _Pragma("unroll") for (int k = 0; k < 2; ++k) dst[m][k] = *(const PG8_LAS bf16x8*)(lds + PG8_SA(b, h) + aoff + m * 2048 + k * 1024); } while (0)
#define PG8_LDB(dst, b, h) do { _Pragma("unroll") for (int n = 0; n < 2; ++n) _Pragma("unroll") for (int k = 0; k < 2; ++k) dst[n][k] = *(const PG8_LAS bf16x8*)(lds + PG8_SB(b, h) + boff + n * 2048 + k * 1024); } while (0)
#define PG8_MMA(ai, bj, At, Bt) do { __builtin_amdgcn_s_setprio(1); _Pragma("unroll") for (int m = 0; m < 4; ++m) _Pragma("unroll") for (int n = 0; n < 2; ++n) _Pragma("unroll") for (int k = 0; k < 2; ++k) \
        acc[ai][bj][m][n] = __builtin_amdgcn_mfma_f32_16x16x32_bf16(Bt[n][k], At[m][k], acc[ai][bj][m][n], 0, 0, 0); __builtin_amdgcn_s_setprio(0); } while (0)
#define PG8_WAIT_V(n) asm volatile("s_waitcnt vmcnt(" #n ")" ::: "memory")
#define PG8_WAIT_L(n) asm volatile("s_waitcnt lgkmcnt(" #n ")" ::: "memory")
#define PG8_BAR __builtin_amdgcn_s_barrier()
#define PG8_SCHED __builtin_amdgcn_sched_barrier(0)
    Unit cur, nxt; int ui = 0;
    if (!S.next(0, cur)) return;
    f32x4 acc[2][2][4][2];
#pragma unroll
    for (int a = 0; a < 2; ++a)
#pragma unroll
        for (int b = 0; b < 2; ++b)
#pragma unroll
            for (int m = 0; m < 4; ++m)
#pragma unroll
                for (int n = 0; n < 2; ++n) acc[a][b][m][n] = (f32x4){0.f, 0.f, 0.f, 0.f};
    bf16x8 At[4][2], B0[2][2], B1[2][2];
    const char* cA = (const char*)g.A + (size_t)cur.pm * tstepA + cur.kq * g.kq_bytes; const char* cB = (const char*)g.Bt + (size_t)cur.pn * tstepB + cur.kq * g.kq_bytes;
    S.a_ready(cur);
    if constexpr (SP2) {
        PG8_STAGE(PG8_SB(0, 0), cB, voffB); PG8_STAGE(PG8_SB(0, 1), cB + hstepB, voffB); PG8_STAGE(PG8_SA(0, 0), cA, voffA); PG8_STAGE(PG8_SA(0, 1), cA + hstepA, voffA);
        if (wr == 1) PG8_BAR;
        PG8_WAIT_V(2); PG8_BAR;
        PG8_STAGE(PG8_SB(1, 0), cB + kstep, voffB); PG8_STAGE(PG8_SA(1, 0), cA + kstep, voffA); PG8_STAGE(PG8_SB(1, 1), cB + hstepB + kstep, voffB);
        PG8_WAIT_V(6); PG8_BAR;
    } else {
        PG8_STAGE(PG8_SB(0, 0), cB, voffB); PG8_STAGE(PG8_SA(0, 0), cA, voffA); PG8_STAGE(PG8_SB(0, 1), cB + hstepB, voffB); PG8_STAGE(PG8_SA(0, 1), cA + hstepA, voffA);
        if (wr == 1) PG8_BAR;
        PG8_WAIT_V(4); PG8_BAR;
        PG8_STAGE(PG8_SB(1, 0), cB + kstep, voffB); PG8_STAGE(PG8_SA(1, 0), cA + kstep, voffA); PG8_STAGE(PG8_SB(1, 1), cB + hstepB + kstep, voffB);
        PG8_WAIT_V(6); PG8_BAR;
    }
    for (;;) {
        const bool has_next = S.next(ui + 1, nxt);
        const char* nA = has_next ? (const char*)g.A + (size_t)nxt.pm * tstepA + nxt.kq * g.kq_bytes : cA; const char* nB = has_next ? (const char*)g.Bt + (size_t)nxt.pn * tstepB + nxt.kq * g.kq_bytes : cB;
        for (int t = 0; t < nt; t += 2) {
            const bool last = (t == nt - 2);
            const char* a1 = cA + (size_t)(t + 1) * kstep + (t >= g.kj_t ? g.kj_bytes : 0);
            const char* a2 = last ? nA : cA + (size_t)(t + 2) * kstep + (t + 2 >= g.kj_t ? g.kj_bytes : 0); const char* b2 = last ? nB : cB + (size_t)(t + 2) * kstep;
            const char* a3 = a2 + kstep; const char* b3 = b2 + kstep;
            if (last && has_next) S.a_ready(nxt);
            if constexpr (Epi::MIDK) { if (t == g.kj_t) E.midk(acc, cur, wr, fr); }
            if constexpr (SP2) {
            PG8_LDB(B0, 0, 0); PG8_LDB(B1, 0, 1); PG8_SCHED; PG8_LDA(At, 0, 0); PG8_STAGE(PG8_SA(1, 1), a1 + hstepA, voffA);
            PG8_WAIT_V(8); PG8_WAIT_L(0); PG8_BAR; PG8_MMA(0, 0, At, B0); PG8_MMA(0, 1, At, B1); PG8_BAR; PG8_SCHED;
            PG8_LDA(At, 0, 1); PG8_STAGE(PG8_SB(0, 0), b2, voffB); PG8_STAGE(PG8_SB(0, 1), b2 + hstepB, voffB); PG8_STAGE(PG8_SA(0, 0), a2, voffA);
            PG8_WAIT_V(8); PG8_WAIT_L(0); PG8_BAR; PG8_MMA(1, 0, At, B0); PG8_MMA(1, 1, At, B1); PG8_BAR; PG8_SCHED;
            PG8_LDB(B0, 1, 0); PG8_LDB(B1, 1, 1); PG8_SCHED; PG8_LDA(At, 1, 0); PG8_STAGE(PG8_SA(0, 1), a2 + hstepA, voffA);
            PG8_WAIT_V(8); PG8_WAIT_L(0); PG8_BAR; PG8_MMA(0, 0, At, B0); PG8_MMA(0, 1, At, B1); PG8_BAR; PG8_SCHED;
            PG8_LDA(At, 1, 1); PG8_STAGE(PG8_SB(1, 0), b3, voffB); PG8_STAGE(PG8_SB(1, 1), b3 + hstepB, voffB); PG8_STAGE(PG8_SA(1, 0), a3, voffA);
            PG8_WAIT_V(8); PG8_WAIT_L(0); PG8_BAR; PG8_MMA(1, 0, At, B0); PG8_MMA(1, 1, At, B1); PG8_BAR; PG8_SCHED;
            } else {
            PG8_LDB(B0, 0, 0); PG8_SCHED; PG8_LDA(At, 0, 0); PG8_STAGE(PG8_SA(1, 1), a1 + hstepA, voffA);
            PG8_WAIT_L(8); PG8_BAR; PG8_WAIT_L(0); PG8_MMA(0, 0, At, B0); PG8_BAR; PG8_SCHED;
            PG8_LDB(B1, 0, 1); PG8_STAGE(PG8_SB(0, 0), b2, voffB);
            PG8_BAR; PG8_WAIT_L(0); PG8_MMA(0, 1, At, B1); PG8_BAR;
            PG8_LDA(At, 0, 1); PG8_STAGE(PG8_SA(0, 0), a2, voffA);
            PG8_BAR; PG8_WAIT_L(0); PG8_MMA(1, 0, At, B0); PG8_BAR; PG8_SCHED;
            PG8_STAGE(PG8_SB(0, 1), b2 + hstepB, voffB);
            PG8_WAIT_V(6); PG8_BAR; PG8_MMA(1, 1, At, B1); PG8_BAR;
            PG8_LDB(B0, 1, 0); PG8_SCHED; PG8_LDA(At, 1, 0); PG8_STAGE(PG8_SA(0, 1), a2 + hstepA, voffA);
            PG8_WAIT_L(8); PG8_BAR; PG8_WAIT_L(0); PG8_MMA(0, 0, At, B0); PG8_BAR; PG8_SCHED;
            PG8_LDB(B1, 1, 1); PG8_STAGE(PG8_SB(1, 0), b3, voffB);
            PG8_BAR; PG8_WAIT_L(0); PG8_MMA(0, 1, At, B1); PG8_BAR;
            PG8_LDA(At, 1, 1); PG8_STAGE(PG8_SA(1, 0), a3, voffA);
            PG8_BAR; PG8_WAIT_L(0); PG8_MMA(1, 0, At, B0); PG8_BAR; PG8_SCHED;
            PG8_STAGE(PG8_SB(1, 1), b3 + hstepB, voffB);
            PG8_WAIT_V(6); PG8_BAR; PG8_MMA(1, 1, At, B1); PG8_BAR;
            }
        }
        if constexpr (ALIGN_EPI) { if (wr == 0) PG8_BAR; }
        if constexpr (!Epi::AFTER_DRAIN) { E(acc, cur, wr, wc, fr, fq); S.done(cur); }
        if (!has_next) break;
#pragma unroll
        for (int a = 0; a < 2; ++a)
#pragma unroll
            for (int b = 0; b < 2; ++b)
#pragma unroll
                for (int m = 0; m < 4; ++m)
#pragma unroll
                    for (int n = 0; n < 2; ++n) acc[a][b][m][n] = (f32x4){0.f, 0.f, 0.f, 0.f};
        cur = nxt; cA = nA; cB = nB; ++ui;
        if constexpr (ALIGN_EPI) { if (wr == 1) PG8_BAR; }
    }
    PG8_WAIT_V(0);
    if constexpr (!ALIGN_EPI) { if (wr == 0) PG8_BAR; }
    PG8_BAR;
    if constexpr (Epi::AFTER_DRAIN) { E.fused(acc, cur, wr, wc, fr, fq, lds, wid, lane); S.done(cur); }
#undef PG8_SA
#undef PG8_SB
#undef PG8_STAGE
#undef PG8_LDA
#undef PG8_LDB
#undef PG8_MMA
#undef PG8_WAIT_V
#undef PG8_WAIT_L
#undef PG8_BAR
#undef PG8_SCHED
}
}
struct Frame {
    LAS uchar* lds;
    volatile LAS unsigned* MISC;
    unsigned* ctl;
    int tid, lane, wave;
    int vcu, G;
};

constexpr int TSTR = 144;
DI void p0_transpose_item(const float* W, int K, int N, bf16* WT, LAS uchar* scr, int item, int lane, const float* kscale = nullptr) {
    const int nblk = N / 64, kb = item / nblk, nb = item % nblk, k0 = 64 * kb, n0 = 64 * nb;
    const int q = lane >> 4, c16 = lane & 15;
    f32x4 v[16];
#pragma unroll
    for (int i = 0; i < 16; ++i) v[i] = *(const f32x4*)(W + (size_t)(k0 + 16 * q + i) * N + n0 + 4 * c16);
    if (kscale) {
#pragma unroll
        for (int i = 0; i < 16; ++i) v[i] = v[i] * kscale[k0 + 16 * q + i]; }
#pragma unroll
    for (int j = 0; j < 4; ++j) { u32x4 lo, hi;
        lo.x = pk2(v[0][j], v[1][j]); lo.y = pk2(v[2][j], v[3][j]); lo.z = pk2(v[4][j], v[5][j]); lo.w = pk2(v[6][j], v[7][j]);
        hi.x = pk2(v[8][j], v[9][j]); hi.y = pk2(v[10][j], v[11][j]); hi.z = pk2(v[12][j], v[13][j]); hi.w = pk2(v[14][j], v[15][j]);
        LAS uchar* p = scr + (4 * c16 + j) * TSTR + q * 32; *(LAS u32x4*)p = lo; *(LAS u32x4*)(p + 16) = hi; }
    asm volatile("s_waitcnt lgkmcnt(0)" ::: "memory");
    const int c = lane & 7, nr = lane >> 3;
#pragma unroll
    for (int r = 0; r < 8; ++r) { const int n = nr + 8 * r;
        *(u32x4*)(WT + (size_t)(n0 + n) * K + k0 + 8 * c) = *(const LAS u32x4*)(scr + n * TSTR + c * 16); }
    asm volatile("s_waitcnt lgkmcnt(0)" ::: "memory");
}
struct CvJob { const float* e_w_out; const float* o_w_in; const float* o_w_out; const float* kscale3; const float* kscale4; bf16 *W2, *W3, *W4; };
constexpr int CV_I2 = (K2 / 64) * (D / 64), CV_I3 = (D / 64) * (N3 / 64), CV_I4 = (K4 / 64) * (D / 64), CV_NIT = CV_I2 + CV_I3 + CV_I4;
DI void cv_decode(const CvJob& j, int idx, const float*& W, int& K, int& N, bf16*& WT, const float*& ks, int& item) {
    if (idx < CV_I2) { W = j.e_w_out; K = K2; N = D; WT = j.W2; ks = nullptr; item = idx; }
    else if (idx < CV_I2 + CV_I3) { W = j.o_w_in; K = D; N = N3; WT = j.W3; ks = j.kscale3; item = idx - CV_I2; }
    else { W = j.o_w_out; K = K4; N = D; WT = j.W4; ks = j.kscale4; item = idx - CV_I2 - CV_I3; }
}
DI void cv_issue(const CvJob& j, int idx, int lane, f32x4 (&v)[16]) {
    const float* W; int K, N, item; bf16* WT; const float* ks; cv_decode(j, idx, W, K, N, WT, ks, item);
    const int nblk = N / 64, kb = item / nblk, nb = item % nblk, k0 = 64 * kb, n0 = 64 * nb, q = lane >> 4, c16 = lane & 15;
#pragma unroll
    for (int i = 0; i < 16; ++i) v[i] = *(const f32x4*)(W + (size_t)(k0 + 16 * q + i) * N + n0 + 4 * c16);
}
DI void cv_finish(const CvJob& j, int idx, int lane, const f32x4 (&vin)[16], LAS uchar* scr) {
    const float* W; int K, N, item; bf16* WT; const float* ks; cv_decode(j, idx, W, K, N, WT, ks, item);
    const int nblk = N / 64, kb = item / nblk, nb = item % nblk, k0 = 64 * kb, n0 = 64 * nb, q = lane >> 4, c16 = lane & 15;
    f32x4 v[16], kv[4];
    if (ks) {
#pragma unroll
        for (int i = 0; i < 4; ++i) kv[i] = *(const f32x4*)(ks + k0 + 16 * q + 4 * i); }
    else {
#pragma unroll
        for (int i = 0; i < 4; ++i) kv[i] = (f32x4){1.f, 1.f, 1.f, 1.f}; }
#pragma unroll
    for (int i = 0; i < 16; ++i) v[i] = vin[i] * kv[i >> 2][i & 3];
#pragma unroll
    for (int jj = 0; jj < 4; ++jj) { u32x4 lo, hi;
        lo.x = pk2(v[0][jj], v[1][jj]); lo.y = pk2(v[2][jj], v[3][jj]); lo.z = pk2(v[4][jj], v[5][jj]); lo.w = pk2(v[6][jj], v[7][jj]);
        hi.x = pk2(v[8][jj], v[9][jj]); hi.y = pk2(v[10][jj], v[11][jj]); hi.z = pk2(v[12][jj], v[13][jj]); hi.w = pk2(v[14][jj], v[15][jj]);
        LAS uchar* p = scr + (4 * c16 + jj) * TSTR + q * 32; *(LAS u32x4*)p = lo; *(LAS u32x4*)(p + 16) = hi; }
    asm volatile("s_waitcnt lgkmcnt(0)" ::: "memory");
    const int c = lane & 7, nr = lane >> 3;
#pragma unroll
    for (int r = 0; r < 8; ++r) { const int n = nr + 8 * r;
        *(u32x4*)(WT + (size_t)(n0 + n) * K + k0 + 8 * c) = *(const LAS u32x4*)(scr + n * TSTR + c * 16); }
    asm volatile("s_waitcnt lgkmcnt(0)" ::: "memory");
}
DI void rms_row_to_bf16(const float* xrow, const float* w, bf16* orow, int lane) {
    const f32x4* xr = (const f32x4*)xrow + lane; const f32x4* wr = (const f32x4*)w + lane;
    f32x4 v[16]; float s = 0.f;
#pragma unroll
    for (int j = 0; j < 16; ++j) { v[j] = xr[64 * j]; s += (v[j].x * v[j].x + v[j].y * v[j].y) + (v[j].z * v[j].z + v[j].w * v[j].w); }
    const float rstd = __builtin_amdgcn_rsqf(wave_sum(s) * (1.f / 4096.f) + EPS);
    u32x2* o8 = (u32x2*)orow + lane;
#pragma unroll
    for (int j = 0; j < 16; ++j) { const f32x4 ww = wr[64 * j]; u32x2 p; p.x = pk2(v[j].x * rstd * ww.x, v[j].y * rstd * ww.y); p.y = pk2(v[j].z * rstd * ww.z, v[j].w * rstd * ww.w); o8[64 * j] = p; }
}
struct P0Args { const float* x; const float* norm_w; const float* e_w_in; const float* e_w_out; const float* o_w_in; const float* o_w_out; bf16 *W1, *W2, *W3, *W4, *HN; };
DI void p0_prologue(Frame& F, const P0Args& a) {
    LAS uchar* scr = F.lds + F.wave * 16384;
    const int gw = F.vcu * 8 + F.wave, NGW = F.G * 8;
    constexpr int I1 = (D / 64) * (N1 / 64);
    for (int it = gw; it < I1; it += NGW) p0_transpose_item(a.e_w_in, D, N1, a.W1, scr, it, F.lane);
    { u32x4* z = (u32x4*)(a.W3 + (size_t)N3 * D); const int nz = (N3P - N3) * D / 8; const u32x4 zero = {0u, 0u, 0u, 0u};
      for (int i = gw * 64 + F.lane; i < nz; i += NGW * 64) z[i] = zero; }
    for (int m = gw; m < M; m += NGW) rms_row_to_bf16(a.x + (size_t)m * D, a.norm_w, a.HN + (size_t)m * D, F.lane);
}
DI void p7_final(Frame& F, const bf16* in, float* out, const float* ssq, const float* fw) {
    const int gw = F.vcu * 8 + F.wave, NGW = F.G * 8;
    for (int m = gw; m < M; m += NGW) {
        const float rstd = __builtin_amdgcn_rsqf(ssq[m] * (1.f / 4096.f) + EPS);
        const u32x4* xr = (const u32x4*)(in + (size_t)m * D) + F.lane; f32x4* orow = (f32x4*)(out + (size_t)m * D) + 2 * F.lane; const f32x4* wr = (const f32x4*)fw + 2 * F.lane;
#pragma unroll
        for (int j = 0; j < 8; ++j) { const u32x4 w = xr[64 * j]; const f32x4 w0 = wr[128 * j], w1 = wr[128 * j + 1];
            orow[128 * j] = (f32x4){bflo(w.x), bfhi(w.x), bflo(w.y), bfhi(w.y)} * rstd * w0;
            orow[128 * j + 1] = (f32x4){bflo(w.z), bfhi(w.z), bflo(w.w), bfhi(w.w)} * rstd * w1; }
    }
}
template <int KSTEPS> DI f32x4 mma_tile(f32x4 acc, const LAS uchar* P, int sp, int p0, const LAS uchar* Q, int sq, int q0, int fr, int fq) {
    bf16x8 a[KSTEPS], b[KSTEPS];
#pragma unroll
    for (int ks = 0; ks < KSTEPS; ++ks) { a[ks] = *(const LAS bf16x8*)(P + (p0 + fr) * sp + ks * 64 + fq * 16); b[ks] = *(const LAS bf16x8*)(Q + (q0 + fr) * sq + ks * 64 + fq * 16); }
#pragma unroll
    for (int ks = 0; ks < KSTEPS; ++ks) acc = __builtin_amdgcn_mfma_f32_16x16x32_bf16(a[ks], b[ks], acc, 0, 0, 0);
    return acc;
}
constexpr int S128 = 288, S64 = 160;

struct Mix0Args { bf16* proj; const float* lb_logits; const float* a_norm_w; const float* conv_w; const float* conv_b; const float* wa; const float* ba; const float* wx; const float* bx; const float* lam; float* ssq_a; bf16* outp; int out_ld, oa_col, ob_col;
                  bf16* Pg; bf16* KSTg; float* GLg; int dummy; CvJob cv; bf16* Qg; float* EREFg; };

DI void hgrn2_prep_all(Frame& F, const Mix0Args& a) {
    const int tid = F.tid, w = F.wave, lane = F.lane, fr = lane & 15, fq = lane >> 4;
    constexpr int PIMG = 2 * 64 * S128 + 128 * S64 + 4096;
    const int c2 = tid & 63, rg = tid >> 6;
    unsigned qr[8], fr_[8];
#define HP_LOAD(U_) do { const int h_ = (U_) & 31, n_ = ((U_) >> 5) & 127, b_ = (U_) >> 12; const size_t r_ = (size_t)b_ * SEQ + (size_t)n_ * 64 + 8 * rg; \
        _Pragma("unroll") for (int i = 0; i < 8; ++i) { qr[i] = *(const unsigned*)(a.proj + C_Q + h_ * 128 + 2 * c2 + (r_ + i) * N1); fr_[i] = *(const unsigned*)(a.proj + C_F + h_ * 128 + 2 * c2 + (r_ + i) * N1); } } while (0)
    if (F.vcu < 8192) HP_LOAD(F.vcu);
    float lb[2] = {0.f, 0.f}, oml[2] = {1.f, 1.f}; int h_prev = -1;
    int par = 0;
    for (int U = F.vcu; U < 8192; U += F.G, par ^= 1) {
    const int h = U & 31, n = (U >> 5) & 127, b = U >> 12;
    LAS uchar* QIN = F.lds + par * PIMG; LAS uchar* KIN = QIN + 64 * S128; LAS uchar* KST = KIN + 64 * S128; LAS float* TOT = (LAS float*)(KST + 128 * S64);
    if (h != h_prev) {
#pragma unroll
        for (int j = 0; j < 2; ++j) { const int col = h * 128 + 2 * c2 + j; const float l0 = a.lb_logits[col], l1 = a.lb_logits[4096 + col], l2 = a.lb_logits[8192 + col];
            const float mx = fmaxf(l0, fmaxf(l1, l2)); const float e0 = __expf(l0 - mx), e1 = __expf(l1 - mx), e2 = __expf(l2 - mx); lb[j] = e0 / (e0 + e1 + e2); oml[j] = 1.0f - lb[j]; }
        h_prev = h; }
    const size_t row0 = (size_t)b * SEQ + (size_t)n * 64;
    bf16* qcol = a.proj + C_Q + h * 128 + 2 * c2;
    unsigned qc[8], fc[8];
#pragma unroll
    for (int i = 0; i < 8; ++i) { qc[i] = qr[i]; fc[i] = fr_[i]; }
    if (U + F.G < 8192) HP_LOAD(U + F.G);
    float cum[2] = {0.f, 0.f}, cumv[8][2], kkv[8][2];
#pragma unroll
    for (int i = 0; i < 8; ++i)
#pragma unroll
        for (int j = 0; j < 2; ++j) { const float z = j ? bfhi(fc[i]) : bflo(fc[i]); const float e = fexp2(-LOG2E * z), sg = frcp(1.0f + e);
            const float fg = lb[j] + oml[j] * sg; cum[j] += flog2(fg); cumv[i][j] = cum[j]; kkv[i][j] = oml[j] * (1.0f - sg); }
    *(LAS f32x2*)(TOT + rg * 128 + 2 * c2) = (f32x2){cum[0], cum[1]};
    LDS_BAR();
    float off[2] = {0.f, 0.f}, ref[2] = {0.f, 0.f}, bl[2] = {0.f, 0.f};
#pragma unroll
    for (int g = 0; g < 8; ++g) { const f32x2 t = *(const LAS f32x2*)(TOT + g * 128 + 2 * c2);
        if (g < rg) { off[0] += t.x; off[1] += t.y; } if (g < 4) { ref[0] += t.x; ref[1] += t.y; } bl[0] += t.x; bl[1] += t.y; }
    float eref[2], ebl[2];
#pragma unroll
    for (int j = 0; j < 2; ++j) { eref[j] = fexp2(ref[j]); ebl[j] = fexp2(bl[j] - ref[j]); }
    const size_t T = ((size_t)(b * 32 + h)) * 128 + n;
    if (rg == 0) { *(f32x2*)(a.GLg + T * 128 + 2 * c2) = (f32x2){fexp2(bl[0]), fexp2(bl[1])}; *(f32x2*)(a.EREFg + T * 128 + 2 * c2) = (f32x2){eref[0], eref[1]}; }
    float ksv[2][8];
#pragma unroll
    for (int i = 0; i < 8; ++i) { float qi[2], ki[2];
#pragma unroll
        for (int j = 0; j < 2; ++j) { const float q = j ? bfhi(qc[i]) : bflo(qc[i]); const float qs = fsilu(q);
            const float e1 = fexp2(off[j] + cumv[i][j] - ref[j]), e2 = frcp(e1);
            qi[j] = qs * e1; ki[j] = kkv[i][j] * e2; ksv[j][i] = ki[j] * ebl[j]; }
        const int l = 8 * rg + i;
        *(LAS unsigned*)(QIN + l * S128 + c2 * 4) = pk2(qi[0], qi[1]);
        *(LAS unsigned*)(KIN + l * S128 + c2 * 4) = pk2(ki[0], ki[1]);
        }
#pragma unroll
    for (int j = 0; j < 2; ++j) { u32x4 p; p.x = pk2(ksv[j][0], ksv[j][1]); p.y = pk2(ksv[j][2], ksv[j][3]); p.z = pk2(ksv[j][4], ksv[j][5]); p.w = pk2(ksv[j][6], ksv[j][7]);
        *(LAS u32x4*)(KST + (2 * c2 + j) * S64 + rg * 16) = p; }
    LDS_BAR();
#pragma unroll
    for (int i = 0; i < 2; ++i) { const int c = tid + 512 * i, ln = c & 63;
        *(u32x4*)(a.Qg + T * 8192 + (size_t)c * 8) = *(const LAS u32x4*)(QIN + (16 * (c >> 8) + (ln & 15)) * S128 + ((c >> 6) & 3) * 64 + (ln >> 4) * 16);
        *(u32x4*)(a.KSTg + T * 8192 + (size_t)c * 8) = *(const LAS u32x4*)(KST + (16 * (c >> 7) + (ln & 15)) * S64 + ((c >> 6) & 1) * 64 + (ln >> 4) * 16); }
    { const int l0_ = 16 * (w & 3);
#pragma unroll
      for (int t = 0; t < 2; ++t) { const int s0 = 16 * ((w >> 2) * 2 + t);
          f32x4 sc = (f32x4){0.f, 0.f, 0.f, 0.f};
          if (s0 <= l0_ + 15) sc = mma_tile<4>(sc, KIN, S128, s0, QIN, S128, l0_, fr, fq);
          const int l = l0_ + fr, s = s0 + 4 * fq;
          u32x2 p; p.x = pk2(s <= l ? sc[0] : 0.f, s + 1 <= l ? sc[1] : 0.f); p.y = pk2(s + 2 <= l ? sc[2] : 0.f, s + 3 <= l ? sc[3] : 0.f);
          *(u32x2*)((char*)(a.Pg + T * 4096) + ((((w & 3) * 2 + (w >> 2)) * 64 + (2 * t + (fq >> 1)) * 16 + fr) * 16 + 8 * (fq & 1))) = p; } }
    }
#undef HP_LOAD
    LDS_BAR();
}

struct HgEa { unsigned v[4]; f32x4 er; };
struct HgOp { bf16x8 qf[4], pf[2], kf[2]; f32x4 g4; u32x2 ga; };
DI void hgrn2_scan_unit(Frame& F, const Mix0Args& a, int u) {
    const int tid = F.tid, w = F.wave, lane = F.lane, fr = lane & 15, fq = lane >> 4;
    const int b = u >> 7, h = (u >> 2) & 31, vs = u & 3;
    constexpr int VIMG = 32 * S64;
    LAS uchar* VT0 = F.lds; LAS uchar* STB0 = VT0 + 2 * VIMG;
    const int ltile = w & 3, jtile = w >> 2, l0_ = 16 * ltile, v0_ = 16 * jtile;
    const f32x4 anw = *(const f32x4*)(a.a_norm_w + h * 128 + vs * 32 + v0_ + 4 * fq);
    const int vv = tid & 31, lg = tid >> 5;
    for (int i = tid; i < 32 * S128 / 16; i += 512) ((LAS u32x4*)STB0)[i] = (u32x4){0u, 0u, 0u, 0u};
    f32x4 st[2] = {(f32x4){0.f, 0.f, 0.f, 0.f}, (f32x4){0.f, 0.f, 0.f, 0.f}};
    const size_t rowbase = (size_t)b * SEQ; const size_t Tb = ((size_t)(b * 32 + h)) * 128;
    const unsigned voq = (unsigned)((ltile * 256 + lane) * 16), vop = (unsigned)((ltile * 128 + lane) * 16), vok = (unsigned)((w * 128 + lane) * 16), vog = (unsigned)((16 * w + 4 * fq) * 4);
    unsigned vov[4];
#pragma unroll
    for (int i = 0; i < 4; ++i) vov[i] = (unsigned)((4 * lg + i) * N1 + C_I + h * 128 + vs * 32 + vv) * 2u;
    const unsigned voga = (unsigned)((l0_ + fr) * N1 + C_GA + h * 128 + vs * 32 + v0_ + 4 * fq) * 2u;
    const unsigned voo = (unsigned)((l0_ + fr) * a.out_ld + a.oa_col + h * 128 + vs * 32 + v0_ + 4 * fq) * 2u, vos = (unsigned)(l0_ + fr) * 4u;
    const char* const pQ = (const char*)a.Qg; const char* const pPm = (const char*)a.Pg; const char* const pK = (const char*)a.KSTg; const char* const pG = (const char*)a.GLg;
    const char* const pE = (const char*)a.EREFg; const char* const pP = (const char*)a.proj; char* const pO = (char*)a.outp; char* const pS = (char*)a.ssq_a;
    auto load_ea = [&](int n_, HgEa& r) __attribute__((always_inline)) {
        const char* uV = pP + (rowbase + (size_t)n_ * 64) * (size_t)(N1 * 2); const char* uE = pE + (Tb + n_) * 512;
#pragma unroll
        for (int i = 0; i < 4; ++i) r.v[i] = *(const unsigned short*)(uV + vov[i]);
        r.er = *(const f32x4*)(uE + vog); };
    auto load_op = [&](int n_, HgOp& r) __attribute__((always_inline)) {
        const size_t T_ = Tb + n_; const char* uQ = pQ + T_ * 16384; const char* uPm = pPm + T_ * 8192; const char* uK = pK + T_ * 16384; const char* uG = pG + T_ * 512;
        const char* uGa = pP + (rowbase + (size_t)n_ * 64) * (size_t)(N1 * 2);
#pragma unroll
        for (int ks = 0; ks < 4; ++ks) r.qf[ks] = *(const bf16x8*)(uQ + ks * 1024 + voq);
#pragma unroll
        for (int ks = 0; ks < 2; ++ks) { r.pf[ks] = *(const bf16x8*)(uPm + ks * 1024 + vop); r.kf[ks] = *(const bf16x8*)(uK + ks * 1024 + vok); }
        r.g4 = *(const f32x4*)(uG + vog); r.ga = *(const u32x2*)(uGa + voga); };
    u32x2 p_d = {0u, 0u}; float ss_d = 0.f;
    auto put = [&](int n_) __attribute__((always_inline)) {
        const size_t r0_ = rowbase + (size_t)n_ * 64;
        if (fq == 0) unsafeAtomicAdd((float*)(pS + r0_ * 4 + vos), ss_d);
        *(u32x2*)(pO + r0_ * (size_t)(a.out_ld * 2) + voo) = p_d; };
    auto stage = [&](const HgEa& e, LAS uchar* VT) __attribute__((always_inline)) {
        u32x2 p_; p_.x = e.v[0] | (e.v[1] << 16); p_.y = e.v[2] | (e.v[3] << 16); *(LAS u32x2*)(VT + vv * S64 + lg * 8) = p_; };
    auto compute = [&](int n, const HgOp& o, const f32x4 er_next, LAS uchar* VTc) __attribute__((always_inline)) {
        LAS uchar* STBc = STB0 + (n & 1) * 32 * S128; LAS uchar* STBn = STB0 + ((n + 1) & 1) * 32 * S128;
        bf16x8 sf[4], v2[2][2];
#pragma unroll
        for (int ks = 0; ks < 4; ++ks) sf[ks] = *(const LAS bf16x8*)(STBc + (v0_ + fr) * S128 + ks * 64 + fq * 16);
#pragma unroll
        for (int ks = 0; ks < 2; ++ks) {
#pragma unroll
            for (int vt = 0; vt < 2; ++vt) v2[vt][ks] = *(const LAS bf16x8*)(VTc + (16 * vt + fr) * S64 + ks * 64 + fq * 16); }
        f32x4 oacc = (f32x4){0.f, 0.f, 0.f, 0.f};
#pragma unroll
        for (int ks = 0; ks < 4; ++ks) oacc = __builtin_amdgcn_mfma_f32_16x16x32_bf16(sf[ks], o.qf[ks], oacc, 0, 0, 0);
#pragma unroll
        for (int ks = 0; ks < 2; ++ks) oacc = __builtin_amdgcn_mfma_f32_16x16x32_bf16(jtile ? v2[1][ks] : v2[0][ks], o.pf[ks], oacc, 0, 0, 0);
#pragma unroll
        for (int vt = 0; vt < 2; ++vt) { st[vt] = st[vt] * o.g4;
#pragma unroll
            for (int ks = 0; ks < 2; ++ks) st[vt] = __builtin_amdgcn_mfma_f32_16x16x32_bf16(o.kf[ks], v2[vt][ks], st[vt], 0, 0, 0);
            const f32x4 se = st[vt] * er_next;
            u32x2 p; p.x = pk2(se[0], se[1]); p.y = pk2(se[2], se[3]);
            *(LAS u32x2*)(STBn + (16 * vt + fr) * S128 + (16 * w + 4 * fq) * 2) = p; }
        const float ss = (oacc[0] * oacc[0] + oacc[1] * oacc[1]) + (oacc[2] * oacc[2] + oacc[3] * oacc[3]);
        ss_d = fq_sum(ss);
        const float g0 = bflo(o.ga.x), g1 = bfhi(o.ga.x), g2 = bflo(o.ga.y), g3 = bfhi(o.ga.y);
        p_d.x = pk2(oacc[0] * anw[0] * fsilu(g0), oacc[1] * anw[1] * fsilu(g1)); p_d.y = pk2(oacc[2] * anw[2] * fsilu(g2), oacc[3] * anw[3] * fsilu(g3)); };
    auto step = [&](int n, HgEa& ea, HgEa& eb, HgOp& oa, HgOp& ob) __attribute__((always_inline)) {
        asm volatile("" : "+v"(ea.v[0]), "+v"(ea.v[1]), "+v"(ea.v[2]), "+v"(ea.v[3]), "+v"(ea.er), "+v"(oa.g4), "+v"(oa.ga) :: "memory");
        asm volatile("" : "+v"(oa.qf[0]), "+v"(oa.qf[1]), "+v"(oa.qf[2]), "+v"(oa.qf[3]), "+v"(oa.pf[0]), "+v"(oa.pf[1]), "+v"(oa.kf[0]), "+v"(oa.kf[1]) :: "memory");
        if (n > 0) put(n - 1);
        if (n + 2 < NCH) load_ea(n + 2, eb);
        if (n + 1 < NCH) load_op(n + 1, ob);
        if (n + 1 < NCH) stage(ea, VT0 + ((n + 1) & 1) * VIMG);
        compute(n, oa, ea.er, VT0 + (n & 1) * VIMG);
        LDS_BAR(); };
    HgEa e0, e1; HgOp o0, o1;
    load_ea(0, e0); load_op(0, o0);
    stage(e0, VT0);
    load_ea(1, e1);
    LDS_BAR();
    for (int n = 0; n < NCH; n += 2) { step(n, e1, e0, o0, o1); step(n + 1, e0, e1, o1, o0); }
    put(NCH - 1);
}


DI void rglru_scan_unit(Frame& F, const Mix0Args& a, int u) {
    const int tid = F.tid, w = F.wave, lane = F.lane, fr = lane & 15, fq = lane >> 4;
    const int b = u >> 7, nb = (u >> 2) & 31, qq = u & 3, cb = nb * 128;
    LAS uchar* XC0 = F.lds; LAS uchar* WAT = XC0 + 2 * 64 * S128; LAS uchar* WXT = WAT + 32 * S128;
    LAS float* SEG0 = (LAS float*)(WXT + 32 * S128); LAS float* HPREV = SEG0 + 2 * 1024;
    LAS uchar* CVS = F.lds + 65536 + w * 9216;
    const int gw = F.vcu * 8 + w, NGW = F.G * 8; const bool cv_on = (u == F.vcu);
    f32x4 cvv[16];
#pragma unroll
    for (int i = 0; i < 16; ++i) cvv[i] = (f32x4){0.f, 0.f, 0.f, 0.f};
    { const int j = tid & 31, kg = tid >> 5; float wv[8], xv[8];
#pragma unroll
      for (int i = 0; i < 8; ++i) { const size_t o = ((size_t)(nb * 128 + 8 * kg + i)) * 128 + qq * 32 + j; wv[i] = a.wa[o]; xv[i] = a.wx[o]; }
      u32x4 p; p.x = pk2(wv[0], wv[1]); p.y = pk2(wv[2], wv[3]); p.z = pk2(wv[4], wv[5]); p.w = pk2(wv[6], wv[7]); *(LAS u32x4*)(WAT + j * S128 + kg * 16) = p;
      p.x = pk2(xv[0], xv[1]); p.y = pk2(xv[2], xv[3]); p.z = pk2(xv[4], xv[5]); p.w = pk2(xv[6], xv[7]); *(LAS u32x4*)(WXT + j * S128 + kg * 16) = p; }
    if (tid < 64) HPREV[tid] = 0.f;
    const int c2 = tid & 63, rg = tid >> 6;
    float cw[4][2], cbs[2];
#pragma unroll
    for (int j = 0; j < 2; ++j) { const int ch = cb + 2 * c2 + j; cbs[j] = a.conv_b[ch];
#pragma unroll
        for (int k = 0; k < 4; ++k) cw[k][j] = a.conv_w[k * 4096 + ch]; }
    const int ltile = w & 3, jtile = w >> 2, l0_ = 16 * ltile, jj = 16 * jtile + fr, co = cb + qq * 32 + jj;
    const float bav = a.ba[co], bxv = a.bx[co], sp8l2 = 8.0f * LOG2E * log1pf(__expf(-a.lam[co]));
    const size_t rowbase = (size_t)b * SEQ;
    const bf16* xcol = a.proj + C_XB + cb + 2 * c2;
    const bf16* gbcol = a.proj + C_GB + co; bf16* obcol = a.outp + a.ob_col + co;
    unsigned xr[11], gbr[4];
#define RG_LOAD(n_) do { const long r0_ = (long)rowbase + (long)(n_) * 64; \
        _Pragma("unroll") for (int i = 0; i < 11; ++i) xr[i] = ((n_) == 0 && 8 * rg - 3 + i < 0) ? 0u : *(const unsigned*)(xcol + (size_t)(r0_ + 8 * rg - 3 + i) * N1); \
        _Pragma("unroll") for (int i = 0; i < 4; ++i) gbr[i] = *(const unsigned short*)(gbcol + (size_t)(r0_ + l0_ + 4 * fq + i) * N1); } while (0)
#define RG_STAGE(xc_) do { LAS uchar* X_ = (xc_); \
        _Pragma("unroll") for (int i = 0; i < 8; ++i) { f32x2 s2 = (f32x2){cbs[0], cbs[1]}; \
            _Pragma("unroll") for (int k = 0; k < 4; ++k) s2 += (f32x2){cw[k][0], cw[k][1]} * (f32x2){bflo(xr[i + k]), bfhi(xr[i + k])}; \
            *(LAS unsigned*)(X_ + (8 * rg + i) * S128 + c2 * 4) = pk2(s2.x, s2.y); } } while (0)
    RG_LOAD(0);
    RG_STAGE(XC0);
    unsigned gb_cur[4];
#pragma unroll
    for (int i = 0; i < 4; ++i) gb_cur[i] = gbr[i];
    RG_LOAD(1);
    LDS_BAR();
    for (int n = 0; n < NCH; ++n) {
        const size_t row0 = rowbase + (size_t)n * 64;
        LAS uchar* XCc = XC0 + (n & 1) * 64 * S128; LAS uchar* XCn = XC0 + ((n + 1) & 1) * 64 * S128;
        LAS float* SEGA = SEG0 + (n & 1) * 1024; LAS float* SEGH = SEGA + 512;
        unsigned gb_next[4];
#pragma unroll
        for (int i = 0; i < 4; ++i) gb_next[i] = gbr[i];
        if (n + 1 < NCH) RG_STAGE(XCn);
        if (n + 2 < NCH) RG_LOAD(n + 2);
        if (cv_on && (n & 3) == 0) { const int idx = (n >> 2) * NGW + gw; if (idx < CV_NIT) cv_issue(a.cv, idx, lane, cvv); }
        const f32x4 zero4 = (f32x4){0.f, 0.f, 0.f, 0.f};
        float av[4], uv[4]; float Aseg = 1.f, Hseg = 0.f;
        { bf16x8 xf[4], waf[4], wxf[4]; unsigned xcr[4];
#pragma unroll
          for (int ks = 0; ks < 4; ++ks) { xf[ks] = *(const LAS bf16x8*)(XCc + (l0_ + fr) * S128 + ks * 64 + fq * 16);
              waf[ks] = *(const LAS bf16x8*)(WAT + (16 * jtile + fr) * S128 + ks * 64 + fq * 16); wxf[ks] = *(const LAS bf16x8*)(WXT + (16 * jtile + fr) * S128 + ks * 64 + fq * 16); }
#pragma unroll
          for (int r = 0; r < 4; ++r) xcr[r] = *(const LAS unsigned short*)(XCc + (l0_ + 4 * fq + r) * S128 + (qq * 32 + jj) * 2);
          f32x4 R = zero4, I = zero4;
#pragma unroll
          for (int ks = 0; ks < 4; ++ks) { R = __builtin_amdgcn_mfma_f32_16x16x32_bf16(xf[ks], waf[ks], R, 0, 0, 0); I = __builtin_amdgcn_mfma_f32_16x16x32_bf16(xf[ks], wxf[ks], I, 0, 0, 0); }
#pragma unroll
          for (int r = 0; r < 4; ++r) {
              const float rr = fsigmoid(R[r] + bav), ig = fsigmoid(I[r] + bxv);
              const float aa = fexp2(-sp8l2 * rr); const float om = __builtin_fmaf(-aa, aa, 1.0f);
              av[r] = aa; uv[r] = __builtin_sqrtf(om) * (ig * bf2f(xcr[r]));
              Hseg = aa * Hseg + uv[r]; Aseg *= aa; } }
        const int sgi = ltile * 4 + fq;
        SEGA[sgi * 32 + jj] = Aseg; SEGH[sgi * 32 + jj] = Hseg;
        LDS_BAR();
        float carry = HPREV[(n & 1) * 32 + jj]; float sa[15], sh[15];
#pragma unroll
        for (int s = 0; s < 15; ++s) { sa[s] = SEGA[s * 32 + jj]; sh[s] = SEGH[s * 32 + jj]; }
#pragma unroll
        for (int s = 0; s < 15; ++s) carry = (s < sgi) ? sa[s] * carry + sh[s] : carry;
#pragma unroll
        for (int r = 0; r < 4; ++r) { carry = av[r] * carry + uv[r];
            const float o = carry * fsilu(bf2f(gb_cur[r]));
            obcol[(row0 + l0_ + 4 * fq + r) * a.out_ld] = (bf16)(pk2(o, 0.f) & 0xffffu); }
        if (sgi == 15) HPREV[((n + 1) & 1) * 32 + jj] = carry;
#pragma unroll
        for (int i = 0; i < 4; ++i) gb_cur[i] = gb_next[i];
        if (cv_on && (n & 3) == 2) { const int idx = (n >> 2) * NGW + gw; if (idx < CV_NIT) cv_finish(a.cv, idx, lane, cvv, CVS); }
    }
    if (cv_on) for (int sl = NCH / 4; sl * NGW + gw < CV_NIT; ++sl) { cv_issue(a.cv, sl * NGW + gw, lane, cvv); cv_finish(a.cv, sl * NGW + gw, lane, cvv, CVS); }
#undef RG_LOAD
#undef RG_STAGE
    LDS_BAR();
}
struct Mix1Args { bf16* proj; const float* conv_w; const float* conv_b; const float* dt_bias; const float* a_log; const float* d_skip; const float* norm_w; float* ssq_y; bf16* outp; int out_ld, o_col;
                  bf16* Cg; bf16* BTg; bf16* CBg; float* TABg; int var; const float* dtp; };
constexpr int SX = 144;

DI void ssd_prep_unit(Frame& F, const Mix1Args& a, int U) {
    const int tid = F.tid, w = F.wave, lane = F.lane, fr = lane & 15, fq = lane >> 4;
    const int g = U & 7, n = (U >> 3) & 127, b = U >> 10;
    LAS uchar* CC = F.lds; LAS uchar* BC = CC + 64 * S128; LAS uchar* BT = BC + 64 * S128;
    const int c2 = tid & 63, rg = tid >> 6;
    float bw[4][2], bb[2], cw[4][2], cbs[2];
#pragma unroll
    for (int j = 0; j < 2; ++j) { const int chb = 8192 + g * 128 + 2 * c2 + j, chc = 9216 + g * 128 + 2 * c2 + j;
        bb[j] = a.conv_b[chb]; cbs[j] = a.conv_b[chc];
#pragma unroll
        for (int k = 0; k < 4; ++k) { bw[k][j] = a.conv_w[k * 10240 + chb]; cw[k][j] = a.conv_w[k * 10240 + chc]; } }
    const long r0 = (long)b * SEQ + (long)n * 64 + 8 * rg - 3;
    const bf16* bcol = a.proj + C_B + g * 128 + 2 * c2;
    const bf16* ccol = a.proj + C_C + g * 128 + 2 * c2;
    unsigned bc[11], cc[11];
#pragma unroll
    for (int i = 0; i < 11; ++i) { const bool zz = (n == 0 && 8 * rg - 3 + i < 0);
        bc[i] = zz ? 0u : *(const unsigned*)(bcol + (size_t)(r0 + i) * N3P); cc[i] = zz ? 0u : *(const unsigned*)(ccol + (size_t)(r0 + i) * N3P); }
    { float bt[2][8];
#pragma unroll
      for (int i = 0; i < 8; ++i) { float vb[2], vc[2];
#pragma unroll
          for (int j = 0; j < 2; ++j) { float sb = bb[j], sc = cbs[j];
#pragma unroll
              for (int k = 0; k < 4; ++k) { sb += bw[k][j] * (j ? bfhi(bc[i + k]) : bflo(bc[i + k])); sc += cw[k][j] * (j ? bfhi(cc[i + k]) : bflo(cc[i + k])); }
              vb[j] = fsilu(sb); vc[j] = fsilu(sc); bt[j][i] = vb[j]; }
          *(LAS unsigned*)(BC + (8 * rg + i) * S128 + c2 * 4) = pk2(vb[0], vb[1]);
          *(LAS unsigned*)(CC + (8 * rg + i) * S128 + c2 * 4) = pk2(vc[0], vc[1]); }
#pragma unroll
      for (int j = 0; j < 2; ++j) { u32x4 p; p.x = pk2(bt[j][0], bt[j][1]); p.y = pk2(bt[j][2], bt[j][3]); p.z = pk2(bt[j][4], bt[j][5]); p.w = pk2(bt[j][6], bt[j][7]);
          *(LAS u32x4*)(BT + (2 * c2 + j) * S64 + rg * 16) = p; } }
    LDS_BAR();
    const size_t T = ((size_t)(b * 128 + n)) * 8 + g;
#pragma unroll
    for (int i = 0; i < 2; ++i) { const int c = tid + 512 * i, ln = c & 63;
        *(u32x4*)(a.Cg + T * 8192 + (size_t)c * 8) = *(const LAS u32x4*)(CC + (16 * (c >> 8) + (ln & 15)) * S128 + ((c >> 6) & 3) * 64 + (ln >> 4) * 16);
        *(u32x4*)(a.BTg + T * 8192 + (size_t)c * 8) = *(const LAS u32x4*)(BT + (16 * (c >> 7) + (ln & 15)) * S64 + ((c >> 6) & 1) * 64 + (ln >> 4) * 16); }
    { const int l0_ = 16 * (w & 3);
#pragma unroll
      for (int t = 0; t < 2; ++t) { const int m0 = 16 * ((w >> 2) * 2 + t);
          const f32x4 cbv = mma_tile<4>((f32x4){0.f, 0.f, 0.f, 0.f}, BC, S128, m0, CC, S128, l0_, fr, fq);
          u32x2 p; p.x = pk2(cbv[0], cbv[1]); p.y = pk2(cbv[2], cbv[3]);
          *(u32x2*)(a.CBg + T * 4096 + (size_t)(l0_ + fr) * 64 + m0 + 4 * fq) = p; } }
#pragma unroll
    for (int t = 0; t < 2; ++t) { const int h = 16 * g + 2 * w + t;
        const size_t di = ((size_t)b * SEQ + (size_t)n * 64 + lane) * 128 + h; const size_t dq = (size_t)16384 * 128;
        const float xx = ((a.dtp[di] + a.dtp[di + dq]) + (a.dtp[di + 2 * dq] + a.dtp[di + 3 * dq])) + a.dt_bias[h];
        const float dtv = xx > 20.f ? xx : log1pf(__expf(xx)); float cs = dtv * (-__expf(a.a_log[h]) * LOG2E);
#pragma unroll
        for (int o = 1; o < 64; o <<= 1) { const float tt = __shfl_up(cs, o); if (lane >= o) cs += tt; }
        float* tp = a.TABg + (((size_t)(b * 128 + n)) * 128 + h) * 128; tp[lane] = cs; tp[64 + lane] = dtv; }
    LDS_BAR();
}

struct SsdSt { u32x4 cb; unsigned x[7]; float tb[2]; };
struct SsdOp { bf16x8 cf[4], bf[2]; u32x2 z[2]; };
DI void ssd_unit(Frame& F, const Mix1Args& a, int u) {
    const int tid = F.tid, w = F.wave, lane = F.lane, fr = lane & 15, fq = lane >> 4;
    const int b = u >> 7, h = u & 127, g = h >> 4;
    constexpr int O_XDT = 0, O_XDS = 64 * S64, O_MM = 2 * 64 * S64, IMG = 3 * 64 * S64;
    LAS uchar* IMG0 = F.lds; LAS uchar* SB0 = IMG0 + 2 * IMG; LAS float* TAB = (LAS float*)(SB0 + 2 * 64 * S128) + w * 128;
    const int c2x = tid & 31, rg4 = tid >> 5;
    float xw[4][2], xb[2];
#pragma unroll
    for (int j = 0; j < 2; ++j) { const int chx = h * 64 + 2 * c2x + j; xb[j] = a.conv_b[chx];
#pragma unroll
        for (int k = 0; k < 4; ++k) xw[k][j] = a.conv_w[k * 10240 + chx]; }
    const float Dh = a.d_skip[h];
    const int ltile = w & 3, l0_ = 16 * ltile, ph = (w >> 2) * 2;
    const size_t rowbase = (size_t)b * SEQ;
    const unsigned vo16 = (unsigned)tid * 16u, vot = (unsigned)lane * 4u;
    const unsigned voc = (unsigned)((ltile * 256 + lane) * 16), vob = (unsigned)((w * 128 + lane) * 16);
    unsigned vox[7];
#pragma unroll
    for (int i = 0; i < 7; ++i) vox[i] = (unsigned)((4 * rg4 + i) * N3P + C_X + h * 64 + 2 * c2x) * 2u;
    const unsigned voz = (unsigned)((l0_ + fr) * N3P + C_Z + h * 64 + 16 * ph + 4 * fq) * 2u;
    const unsigned voo = (unsigned)((l0_ + fr) * a.out_ld + a.o_col + h * 64 + 16 * ph + 4 * fq) * 2u, vos = (unsigned)(l0_ + fr) * 4u;
    const char* const pC = (const char*)a.Cg; const char* const pB = (const char*)a.BTg; const char* const pCB = (const char*)a.CBg;
    const char* const pP = (const char*)a.proj; const char* const pT = (const char*)a.TABg; char* const pO = (char*)a.outp; char* const pS = (char*)a.ssq_y;
    for (int i = tid; i < 64 * S128 / 16; i += 512) ((LAS u32x4*)SB0)[i] = (u32x4){0u, 0u, 0u, 0u};
    f32x4 st[4];
#pragma unroll
    for (int t = 0; t < 4; ++t) st[t] = (f32x4){0.f, 0.f, 0.f, 0.f};
    auto load_st = [&](int n_, SsdSt& r) __attribute__((always_inline)) {
        const size_t T_ = ((size_t)(b * 128 + n_)) * 8 + g; const long r0_ = (long)rowbase + (long)n_ * 64;
        const char* uCB = pCB + T_ * 8192; const char* uX = pP + (r0_ - 3) * (long)(N3P * 2); const char* uT = pT + (((size_t)(b * 128 + n_)) * 128 + h) * 512;
        r.cb = *(const u32x4*)(uCB + vo16);
#pragma unroll
        for (int i = 0; i < 7; ++i) r.x[i] = (n_ == 0 && 4 * rg4 - 3 + i < 0) ? 0u : *(const unsigned*)(uX + vox[i]);
        r.tb[0] = *(const float*)(uT + vot); r.tb[1] = *(const float*)(uT + 256 + vot); };
    auto load_op = [&](int n_, SsdOp& r) __attribute__((always_inline)) {
        const size_t T_ = ((size_t)(b * 128 + n_)) * 8 + g; const long r0_ = (long)rowbase + (long)n_ * 64;
        const char* uC = pC + T_ * 16384; const char* uB = pB + T_ * 16384; const char* uZ = pP + r0_ * (long)(N3P * 2);
#pragma unroll
        for (int ks = 0; ks < 4; ++ks) r.cf[ks] = *(const bf16x8*)(uC + ks * 1024 + voc);
#pragma unroll
        for (int ks = 0; ks < 2; ++ks) r.bf[ks] = *(const bf16x8*)(uB + ks * 1024 + vob);
#pragma unroll
        for (int t = 0; t < 2; ++t) r.z[t] = *(const u32x2*)(uZ + 32 * t + voz); };
    u32x2 p_d[2] = {(u32x2){0u, 0u}, (u32x2){0u, 0u}}; float ss_d = 0.f;
    auto put = [&](int n_) __attribute__((always_inline)) {
        const size_t r0_ = rowbase + (size_t)n_ * 64; char* uO = pO + r0_ * (size_t)(a.out_ld * 2); char* uS = pS + r0_ * 4;
#pragma unroll
        for (int t = 0; t < 2; ++t) *(u32x2*)(uO + 32 * t + voo) = p_d[t];
        if (fq == 0) unsafeAtomicAdd((float*)(uS + vos), ss_d); };
    float el_c = 0.f, dec_c = 0.f;
    auto stage = [&](const SsdSt& c, LAS uchar* I) __attribute__((always_inline)) {
        TAB[lane] = c.tb[0]; TAB[64 + lane] = c.tb[1];
        asm volatile("s_waitcnt lgkmcnt(0)" ::: "memory");
        const float cs_last = TAB[63];
        { const int l = tid >> 3, m8 = (tid & 7) * 8; u32x4 p = (u32x4){0u, 0u, 0u, 0u}; const u32x4 cbc = c.cb;
          if (m8 <= l) { const float csl = TAB[l]; const float dsk = Dh * frcp(fmaxf(TAB[64 + l], 1e-20f)); const f32x4 ca = *(const LAS f32x4*)(TAB + m8), cb4 = *(const LAS f32x4*)(TAB + m8 + 4);
              float mv[8];
#pragma unroll
              for (int j = 0; j < 8; ++j) { const unsigned wv = j < 2 ? cbc.x : j < 4 ? cbc.y : j < 6 ? cbc.z : cbc.w; const float cbv = (j & 1) ? bfhi(wv) : bflo(wv);
                  const float csm = j < 4 ? ca[j & 3] : cb4[j & 3];
                  mv[j] = (m8 + j <= l) ? cbv * fexp2(fminf(csl - csm, 0.f)) : 0.f; if (m8 + j == l) mv[j] += dsk; }
              p.x = pk2(mv[0], mv[1]); p.y = pk2(mv[2], mv[3]); p.z = pk2(mv[4], mv[5]); p.w = pk2(mv[6], mv[7]); }
          *(LAS u32x4*)(I + O_MM + l * S64 + m8 * 2) = p; }
        { f32x2 xv[7];
#pragma unroll
          for (int i = 0; i < 7; ++i) xv[i] = (f32x2){bflo(c.x[i]), bfhi(c.x[i])};
          float xd[2][4], xs_[2][4];
#pragma unroll
          for (int i = 0; i < 4; ++i) { const int l = 4 * rg4 + i; const float dl = TAB[64 + l], sl = fexp2(cs_last - TAB[l]);
              f32x2 s2 = (f32x2){xb[0], xb[1]};
#pragma unroll
              for (int k = 0; k < 4; ++k) s2 += (f32x2){xw[k][0], xw[k][1]} * xv[i + k];
              xd[0][i] = fsilu(s2.x) * dl; xd[1][i] = fsilu(s2.y) * dl; xs_[0][i] = xd[0][i] * sl; xs_[1][i] = xd[1][i] * sl; }
#pragma unroll
          for (int j = 0; j < 2; ++j) { u32x2 p; p.x = pk2(xd[j][0], xd[j][1]); p.y = pk2(xd[j][2], xd[j][3]); *(LAS u32x2*)(I + O_XDT + (2 * c2x + j) * S64 + rg4 * 8) = p;
              p.x = pk2(xs_[j][0], xs_[j][1]); p.y = pk2(xs_[j][2], xs_[j][3]); *(LAS u32x2*)(I + O_XDS + (2 * c2x + j) * S64 + rg4 * 8) = p; } }
        el_c = fexp2(TAB[l0_ + fr]); dec_c = fexp2(cs_last); };
    auto compute = [&](int n, const SsdOp& o, LAS uchar* I, float el, float dec) __attribute__((always_inline)) {
        LAS uchar* SBc = SB0 + (n & 1) * 64 * S128; LAS uchar* SBn = SB0 + ((n + 1) & 1) * 64 * S128;
        f32x4 yacc[2];
        { bf16x8 sf[2][4], mf[2], xf[2][2];
#pragma unroll
          for (int ks = 0; ks < 4; ++ks) {
#pragma unroll
              for (int t = 0; t < 2; ++t) sf[t][ks] = *(const LAS bf16x8*)(SBc + (16 * (ph + t) + fr) * S128 + ks * 64 + fq * 16); }
#pragma unroll
          for (int ks = 0; ks < 2; ++ks) { mf[ks] = *(const LAS bf16x8*)(I + O_MM + (l0_ + fr) * S64 + ks * 64 + fq * 16);
#pragma unroll
              for (int t = 0; t < 2; ++t) xf[t][ks] = *(const LAS bf16x8*)(I + O_XDT + (16 * (ph + t) + fr) * S64 + ks * 64 + fq * 16); }
#pragma unroll
          for (int t = 0; t < 2; ++t) { f32x4 acc = (f32x4){0.f, 0.f, 0.f, 0.f};
#pragma unroll
              for (int ks = 0; ks < 4; ++ks) acc = __builtin_amdgcn_mfma_f32_16x16x32_bf16(sf[t][ks], o.cf[ks], acc, 0, 0, 0);
              acc = acc * el;
#pragma unroll
              for (int ks = 0; ks < 2; ++ks) acc = __builtin_amdgcn_mfma_f32_16x16x32_bf16(xf[t][ks], mf[ks], acc, 0, 0, 0);
              yacc[t] = acc; } }
        { bf16x8 xs2[4][2];
#pragma unroll
          for (int ks = 0; ks < 2; ++ks) {
#pragma unroll
              for (int t = 0; t < 4; ++t) xs2[t][ks] = *(const LAS bf16x8*)(I + O_XDS + (16 * t + fr) * S64 + ks * 64 + fq * 16); }
#pragma unroll
          for (int t = 0; t < 4; ++t) { st[t] = st[t] * dec;
#pragma unroll
              for (int ks = 0; ks < 2; ++ks) st[t] = __builtin_amdgcn_mfma_f32_16x16x32_bf16(o.bf[ks], xs2[t][ks], st[t], 0, 0, 0);
              u32x2 p; p.x = pk2(st[t][0], st[t][1]); p.y = pk2(st[t][2], st[t][3]); *(LAS u32x2*)(SBn + (16 * t + fr) * S128 + (16 * w + 4 * fq) * 2) = p; } }
        { float ss = 0.f;
#pragma unroll
          for (int t = 0; t < 2; ++t) {
              const float z0 = bflo(o.z[t].x), z1 = bfhi(o.z[t].x), z2 = bflo(o.z[t].y), z3 = bfhi(o.z[t].y);
              const float y0 = yacc[t][0] * fsilu(z0), y1 = yacc[t][1] * fsilu(z1), y2 = yacc[t][2] * fsilu(z2), y3 = yacc[t][3] * fsilu(z3);
              ss += (y0 * y0 + y1 * y1) + (y2 * y2 + y3 * y3);
              p_d[t].x = pk2(y0, y1); p_d[t].y = pk2(y2, y3); }
          ss_d = fq_sum(ss); } };
    auto step = [&](int n, SsdSt& sa, SsdSt& sb, SsdOp& oa, SsdOp& ob) __attribute__((always_inline)) {
        asm volatile("" : "+v"(sa.cb), "+v"(sa.x[0]), "+v"(sa.x[1]), "+v"(sa.x[2]), "+v"(sa.x[3]), "+v"(sa.x[4]), "+v"(sa.x[5]), "+v"(sa.x[6]), "+v"(sa.tb[0]), "+v"(sa.tb[1]) :: "memory");
        asm volatile("" : "+v"(oa.cf[0]), "+v"(oa.cf[1]), "+v"(oa.cf[2]), "+v"(oa.cf[3]), "+v"(oa.bf[0]), "+v"(oa.bf[1]), "+v"(oa.z[0]), "+v"(oa.z[1]) :: "memory");
        if (n > 0) put(n - 1);
        if (n + 2 < NCH) load_st(n + 2, sb);
        if (n + 1 < NCH) load_op(n + 1, ob);
        const float el = el_c, dec = dec_c;
        if (n + 1 < NCH) stage(sa, IMG0 + ((n + 1) & 1) * IMG);
        compute(n, oa, IMG0 + (n & 1) * IMG, el, dec);
        LDS_BAR(); };
    SsdSt s0, s1; SsdOp o0, o1;
    load_st(0, s0); load_op(0, o0);
    stage(s0, IMG0);
    load_st(1, s1);
    LDS_BAR();
    for (int n = 0; n < NCH; n += 2) { step(n, s1, s0, o0, o1); step(n + 1, s0, s1, o1, o0); }
    put(NCH - 1);
}
#if MODE_MULTI && (NAIVE_MIX0 || NAIVE_MIX1)
__global__ void __launch_bounds__(256) naive_hgrn2(Mix0Args a) {
    __shared__ float red[8][32];
    const int u = blockIdx.x, tid = threadIdx.x, b = u >> 7, h = (u >> 2) & 31, vs = u & 3, v = tid & 31, dg = tid >> 5;
    float S[16], lb[16];
#pragma unroll
    for (int i = 0; i < 16; ++i) { S[i] = 0.f; const int col = h * 128 + dg * 16 + i; const float l0 = a.lb_logits[col], l1 = a.lb_logits[4096 + col], l2 = a.lb_logits[8192 + col];
        const float mx = fmaxf(l0, fmaxf(l1, l2)); const float e0 = expf(l0 - mx), e1 = expf(l1 - mx), e2 = expf(l2 - mx); lb[i] = e0 / (e0 + e1 + e2); }
    const float anw = a.a_norm_w[h * 128 + vs * 32 + v];
    for (int t = 0; t < SEQ; ++t) {
        bf16* row = a.proj + ((size_t)b * SEQ + t) * N1;
        const float vv = bf2f(row[C_I + h * 128 + vs * 32 + v]);
        float part = 0.f;
#pragma unroll
        for (int i = 0; i < 16; ++i) { const int d = h * 128 + dg * 16 + i; const float q = bf2f(row[C_Q + d]), z = bf2f(row[C_F + d]);
            const float sg = 1.0f / (1.0f + expf(-z)); const float fg = lb[i] + (1.0f - lb[i]) * sg; const float kk = (1.0f - lb[i]) * (1.0f - sg);
            S[i] = fg * S[i] + kk * vv; part += (q / (1.0f + expf(-q))) * S[i]; }
        red[dg][v] = part;
        __syncthreads();
        if (dg == 0) { float o = 0.f;
#pragma unroll
            for (int g = 0; g < 8; ++g) o += red[g][v];
            float ss = o * o;
#pragma unroll
            for (int off = 1; off < 32; off <<= 1) ss += __shfl_xor(ss, off);
            if (v == 0) unsafeAtomicAdd(a.ssq_a + (size_t)b * SEQ + t, ss);
            const float ga = bf2f(row[C_GA + h * 128 + vs * 32 + v]);
            row[C_I + h * 128 + vs * 32 + v] = (bf16)(pk2(o * anw * (ga / (1.0f + expf(-ga))), 0.f) & 0xffffu); }
        __syncthreads();
    }
}
__global__ void __launch_bounds__(256) naive_rglru(Mix0Args a) {
    __shared__ float xcs[128]; __shared__ float redr[8][32]; __shared__ float redi[8][32];
    const int u = blockIdx.x, tid = threadIdx.x, b = u >> 7, nb = (u >> 2) & 31, qq = u & 3, j = tid & 31, kg = tid >> 5, cb = nb * 128, co = cb + qq * 32 + j;
    float wa[16], wx[16];
#pragma unroll
    for (int i = 0; i < 16; ++i) { const size_t o = ((size_t)(nb * 128 + kg * 16 + i)) * 128 + qq * 32 + j; wa[i] = a.wa[o]; wx[i] = a.wx[o]; }
    const float bav = a.ba[co], bxv = a.bx[co], sp = log1pf(expf(-a.lam[co]));
    float hst = 0.f;
    for (int t = 0; t < SEQ; ++t) {
        const size_t rowi = (size_t)b * SEQ + t;
        if (tid < 128) { const int ch = cb + tid; float s = a.conv_b[ch];
#pragma unroll
            for (int k = 0; k < 4; ++k) { const int tt = t - 3 + k; if (tt >= 0) s += a.conv_w[k * 4096 + ch] * bf2f(a.proj[((size_t)b * SEQ + tt) * N1 + C_XB + ch]); }
            xcs[tid] = s; }
        __syncthreads();
        float pr = 0.f, pi = 0.f;
#pragma unroll
        for (int i = 0; i < 16; ++i) { const float x = xcs[kg * 16 + i]; pr += x * wa[i]; pi += x * wx[i]; }
        redr[kg][j] = pr; redi[kg][j] = pi;
        __syncthreads();
        if (kg == 0) { float R = bav, I = bxv;
#pragma unroll
            for (int g = 0; g < 8; ++g) { R += redr[g][j]; I += redi[g][j]; }
            const float r = 1.0f / (1.0f + expf(-R)), ig = 1.0f / (1.0f + expf(-I));
            const float la = -8.0f * r * sp; const float aa = expf(la); const float uu = sqrtf(-expm1f(2.0f * la)) * (ig * xcs[qq * 32 + j]);
            hst = aa * hst + uu;
            bf16* gp = a.proj + rowi * N1 + C_GB + co; const float gb = bf2f(*gp);
            *gp = (bf16)(pk2(hst * (gb / (1.0f + expf(-gb))), 0.f) & 0xffffu); }
        __syncthreads();
    }
}
__global__ void __launch_bounds__(256) naive_ssd(Mix1Args a) {
    __shared__ float xs[64]; __shared__ float red[4][32];
    const int u = blockIdx.x, tid = threadIdx.x, b = u >> 7, h = u & 127, g = h >> 4, k = tid & 127, pg = tid >> 7, wv = tid >> 6, lane = tid & 63;
    float S[32];
#pragma unroll
    for (int i = 0; i < 32; ++i) S[i] = 0.f;
    const float A = -expf(a.a_log[h]), dtb = a.dt_bias[h], Dh = a.d_skip[h];
    const int chb = 8192 + g * 128 + k, chc = 9216 + g * 128 + k;
    for (int t = 0; t < SEQ; ++t) {
        const size_t rowi = (size_t)b * SEQ + t;
        float sb = a.conv_b[chb], sc = a.conv_b[chc];
#pragma unroll
        for (int kk = 0; kk < 4; ++kk) { const int tt = t - 3 + kk; if (tt >= 0) { const bf16* r = a.proj + ((size_t)b * SEQ + tt) * N3P + C_X;
            sb += a.conv_w[kk * 10240 + chb] * bf2f(r[chb]); sc += a.conv_w[kk * 10240 + chc] * bf2f(r[chc]); } }
        const float Bv = sb / (1.0f + expf(-sb)), Cv = sc / (1.0f + expf(-sc));
        if (tid < 64) { const int chx = h * 64 + tid; float s = a.conv_b[chx];
#pragma unroll
            for (int kk = 0; kk < 4; ++kk) { const int tt = t - 3 + kk; if (tt >= 0) s += a.conv_w[kk * 10240 + chx] * bf2f(a.proj[((size_t)b * SEQ + tt) * N3P + C_X + chx]); }
            xs[tid] = s / (1.0f + expf(-s)); }
        const float xx = bf2f(a.proj[rowi * N3P + C_DT + h]) + dtb; const float dt = xx > 20.f ? xx : log1pf(expf(xx)); const float da = expf(dt * A);
        __syncthreads();
#pragma unroll
        for (int i = 0; i < 32; ++i) { S[i] = S[i] * da + dt * xs[pg * 32 + i] * Bv; float y = Cv * S[i];
#pragma unroll
            for (int off = 1; off < 64; off <<= 1) y += __shfl_xor(y, off);
            if (lane == 0) red[wv][i] = y; }
        __syncthreads();
        if (tid < 64) { const int p = tid; const float y = red[(p >> 5) * 2][p & 31] + red[(p >> 5) * 2 + 1][p & 31] + Dh * xs[p];
            bf16* zp = a.proj + rowi * N3P + C_Z + h * 64 + p; const float z = bf2f(*zp); const float yy = y * (z / (1.0f + expf(-z)));
            float ss = yy * yy;
#pragma unroll
            for (int off = 1; off < 64; off <<= 1) ss += __shfl_xor(ss, off);
            if (p == 0) unsafeAtomicAdd(a.ssq_y + rowi, ss);
            *zp = (bf16)(pk2(yy, 0.f) & 0xffffu); }
        __syncthreads();
    }
}
#endif
struct Args { const float* in[22]; float* out; unsigned char* ws; int ph_lo, ph_hi, dummy, pad; };
constexpr int NPHASE = 10;
__global__ void __launch_bounds__(512, 2) fwd(Args args) {
    extern __shared__ __attribute__((aligned(16))) unsigned char lds[];
    Frame F;
    F.lds = (LAS uchar*)lds;
    F.MISC = (volatile LAS unsigned*)(F.lds + MISC_OFF);
    F.tid = threadIdx.x; F.lane = F.tid & 63; F.wave = __builtin_amdgcn_readfirstlane(F.tid >> 6);
    F.G = gridDim.x; { const int bx = blockIdx.x; F.vcu = (F.G % 8 == 0) ? (bx % 8) * (F.G / 8) + bx / 8 : bx; }
    unsigned char* ws = args.ws;
    F.ctl = (unsigned*)(ws + WS_CTL);
    for (int u = F.tid; u < (LDS_BYTES - LDSCTL_OFF) / 4; u += 512) ((LAS unsigned*)(F.lds + LDSCTL_OFF))[u] = 0u;
    __syncthreads();
    const int lo = args.ph_lo, hi = args.ph_hi;
    XcdBarrier bar; bar.bar = F.ctl + CW_BAR; bar.x = 0; bar.st = nullptr;
    if (hi - lo > 1) bar = xcd_barrier_post(F.ctl + CW_BAR, F.MISC + 8);
#define IN(k) (lo <= (k) && (k) < hi)
#define BOTH(k) (IN(k) && IN((k) + 1))
    const float* x = args.in[0]; const float* norm_w = args.in[1];
    bf16* W1 = (bf16*)(ws + WS_W1); bf16* W2 = (bf16*)(ws + WS_W2); bf16* W3 = (bf16*)(ws + WS_W3); bf16* W4 = (bf16*)(ws + WS_W4);
    bf16* HN = (bf16*)(ws + WS_HN); bf16* PROJ = (bf16*)(ws + WS_PROJ);
    float* ssq_a = (float*)(F.ctl + CW_SSQA); float* ssq_h1 = (float*)(F.ctl + CW_SSQH1); float* ssq_y = (float*)(F.ctl + CW_SSQY); float* ssq_h2 = (float*)(F.ctl + CW_SSQH2);
    constexpr int NOJ = 1 << 30;
    const bool dmy = args.dummy != 0; float* ssq_dmy = (float*)(F.ctl + CW_DUMMY);

    if (IN(0)) { const P0Args pa{x, norm_w, args.in[2], args.in[12], args.in[13], args.in[20], W1, W2, W3, W4, HN};
        p0_prologue(F, pa); if (BOTH(0)) xcd_barrier(bar); }
    if (IN(1)) { pg8::Gemm g{HN, W1, M, N1, D, D, D, NOJ, 0, 0}; pg8::StaticOrder S; S.init(M, N1, F.G, (int)blockIdx.x);
        pg8::EpiBf16 E{PROJ, N1, nullptr};
        pg8::gemm_phase<pg8::EpiBf16, pg8::StaticOrder, true, true>(F.lds, g, S, E);
        if (BOTH(1)) xcd_barrier(bar); }
    if (IN(2) || IN(3)) { const Mix0Args ma{PROJ, args.in[3], args.in[4], args.in[5], args.in[6], args.in[7], args.in[8], args.in[9], args.in[10], args.in[11], dmy ? ssq_dmy : ssq_a,
            PROJ, N1, dmy ? C_F : C_I, dmy ? C_F : C_GB, (bf16*)(ws + WS_PG), (bf16*)(ws + WS_HN), (float*)(ws + WS_GL), dmy ? 1 : 0,
            CvJob{args.in[12], args.in[13], args.in[20], norm_w + D, args.in[19], W2, W3, W4}, (bf16*)(ws + WS_W1), (float*)(ws + WS_W1 + 128 * MiB)};
        if (IN(2)) { hgrn2_prep_all(F, ma); if (BOTH(2)) xcd_barrier(bar); }
        if (IN(3)) { for (int u = F.vcu; u < 256; u += F.G) hgrn2_scan_unit(F, ma, u);
                     for (int u = F.vcu; u < 256; u += F.G) rglru_scan_unit(F, ma, u); if (BOTH(3)) xcd_barrier(bar); } }
    if (IN(4)) { pg8::Gemm g{PROJ + C_I, W2, M, D, K2, N1, K2, 64, (long)(C_GB - C_I - 4096) * 2, 0}; pg8::StaticOrder S; S.init(M, D, F.G, (int)blockIdx.x, 4);
        pg8::EpiRes16 E{x, nullptr, HN, ssq_a, nullptr, dmy ? ssq_dmy : ssq_h1};
        pg8::gemm_phase<pg8::EpiRes16, pg8::StaticOrder, true, true>(F.lds, g, S, E);
        if (BOTH(4)) xcd_barrier(bar); }
    if (IN(5)) { { pg8::Gemm g{HN, W3, M, N3DT, D, D, D, NOJ, 0, 0}; pg8::StaticOrder S; S.init(M, N3DT, F.G, (int)blockIdx.x);
          pg8::EpiBf16 E{PROJ, N3P, ssq_h1};
          pg8::gemm_phase<pg8::EpiBf16, pg8::StaticOrder, true, true>(F.lds, g, S, E); }
        { pg8::Gemm g{HN, W3 + (size_t)N3DT * D, M, 256, 1024, D, D, NOJ, 0, 2048}; pg8::KSplitOrder S; S.init(M, F.G, (int)blockIdx.x);
          pg8::EpiDtPart E{(float*)(ws + WS_W1), ssq_h1};
          pg8::gemm_phase<pg8::EpiDtPart, pg8::KSplitOrder, true, true>(F.lds, g, S, E); }
        if (BOTH(5)) xcd_barrier(bar); }
    if (IN(6) || IN(7)) { const Mix1Args ma{PROJ, args.in[14], args.in[15], args.in[16], args.in[17], args.in[18], args.in[19], dmy ? ssq_dmy : ssq_y, dmy ? (bf16*)(ws + WS_DUMMY1) : PROJ, dmy ? 8192 : N3P, dmy ? 0 : C_Z,
            (bf16*)(ws + WS_PREP), (bf16*)(ws + WS_PREP + 32 * MiB), (bf16*)(ws + WS_PREP + 64 * MiB), (float*)(ws + WS_PREP + 80 * MiB), dmy ? (args.dummy >> 4) : 0, (const float*)(ws + WS_W1)};
        if (IN(6)) { for (int U = F.vcu; U < 2048; U += F.G) ssd_prep_unit(F, ma, U); if (BOTH(6)) xcd_barrier(bar); }
        if (IN(7)) { for (int u = F.vcu; u < 256; u += F.G) ssd_unit(F, ma, u); if (BOTH(7)) xcd_barrier(bar); } }
    const bool fuse_fin = (F.G == 256);
    if (IN(8)) { pg8::Gemm g{PROJ + C_Z, W4, M, D, K4, N3P, K4, NOJ, 0, 0};
        if (fuse_fin) { pg8::StaticOrder S; S.init(M, D, F.G, (int)blockIdx.x, 2);
            pg8::EpiFinal E{HN, dmy ? (float*)(ws + WS_DUMMY1) : args.out, args.in[21], ssq_y, dmy ? ssq_dmy : ssq_h2, F.ctl + CW_PANEL + (dmy ? 64 * 64 : 0), F.ctl + CW_CODE};
            pg8::gemm_phase<pg8::EpiFinal, pg8::StaticOrder, true, true>(F.lds, g, S, E); }
        else { pg8::StaticOrder S; S.init(M, D, F.G, (int)blockIdx.x, 4);
            pg8::EpiRes16 E{nullptr, HN, dmy ? (bf16*)(ws + WS_DUMMY1) : HN, nullptr, ssq_y, dmy ? ssq_dmy : ssq_h2};
            pg8::gemm_phase<pg8::EpiRes16, pg8::StaticOrder, true, true>(F.lds, g, S, E);
            if (BOTH(8)) xcd_barrier(bar); } }
    if (IN(9) && !fuse_fin) p7_final(F, HN, dmy ? (float*)(ws + WS_DUMMY1) : args.out, ssq_h2, args.in[21]);
#undef IN
#undef BOTH
}

extern "C" void kernel_launch(void* const* d_in, const int* in_sizes, int n_in, void* d_out, int out_size, void* d_ws, size_t ws_size, hipStream_t stream) {
    static int grid = 0;
    if (grid == 0) {
        if (n_in != 22 || out_size != M * D || ws_size < WS_END) { fprintf(stderr, "kernel_launch: unexpected problem (n_in %d out %d ws %zu)\n", n_in, out_size, ws_size); grid = -1; return; }
        int dev = 0, cus = 0, per_cu = 0;
        if (hipGetDevice(&dev) != hipSuccess || hipDeviceGetAttribute(&cus, hipDeviceAttributeMultiprocessorCount, dev) != hipSuccess) { grid = -1; return; }
        if (hipFuncSetAttribute((const void*)fwd, hipFuncAttributeMaxDynamicSharedMemorySize, LDS_BYTES) != hipSuccess) { fprintf(stderr, "kernel_launch: hipFuncSetAttribute failed\n"); grid = -1; return; }
        if (hipOccupancyMaxActiveBlocksPerMultiprocessor(&per_cu, (const void*)fwd, 512, LDS_BYTES) != hipSuccess || per_cu < 1) fprintf(stderr, "kernel_launch: occupancy query reports %d\n", per_cu);
        (void)hipGetLastError();
        grid = cus;
    }
    if (grid < 0) return;
    (void)hipMemsetAsync((char*)d_ws + WS_CTL, 0, CTL_ZERO_BYTES, stream);
    Args a{};
    for (int i = 0; i < 22; ++i) a.in[i] = (const float*)d_in[i];
    a.out = (float*)d_out; a.ws = (unsigned char*)d_ws;
#if MODE_MULTI
    for (int ph = 0; ph < NPHASE; ++ph) {
        a.ph_lo = ph; a.ph_hi = ph + 1;
#if NAIVE_MIX0
        if (ph == 2) continue;
        if (ph == 3) { const Mix0Args ma{(bf16*)((char*)d_ws + WS_PROJ), a.in[3], a.in[4], a.in[5], a.in[6], a.in[7], a.in[8], a.in[9], a.in[10], a.in[11], (float*)((char*)d_ws + WS_CTL) + CW_SSQA, (bf16*)((char*)d_ws + WS_PROJ), N1, C_I, C_GB, nullptr, nullptr, nullptr, 0, CvJob{}};
            hipLaunchKernelGGL(naive_hgrn2, dim3(256), dim3(256), 0, stream, ma); hipLaunchKernelGGL(naive_rglru, dim3(256), dim3(256), 0, stream, ma); continue; }
#endif
#if NAIVE_MIX1
        if (ph == 6) continue;
        if (ph == 7) { const Mix1Args ma{(bf16*)((char*)d_ws + WS_PROJ), a.in[14], a.in[15], a.in[16], a.in[17], a.in[18], a.in[19], (float*)((char*)d_ws + WS_CTL) + CW_SSQY, (bf16*)((char*)d_ws + WS_PROJ), N3P, C_Z, nullptr, nullptr, nullptr, nullptr, 0, nullptr};
            hipLaunchKernelGGL(naive_ssd, dim3(256), dim3(256), 0, stream, ma); continue; }
#endif
        if ((PROBE_REP >> ph) & 1) { a.dummy = 1 | (PROBE_VAR << 4); hipLaunchKernelGGL(fwd, dim3(grid), dim3(512), LDS_BYTES, stream, a); a.dummy = 0; }
        hipLaunchKernelGGL(fwd, dim3(grid), dim3(512), LDS_BYTES, stream, a);
    }
#else
    a.ph_lo = 0; a.ph_hi = NPHASE;
    hipLaunchKernelGGL(fwd, dim3(grid), dim3(512), LDS_BYTES, stream, a);
#endif
}
```

```cpp
#include <hip/hip_runtime.h>
#include <cstdio>
#include <cstdint>

#ifndef MODE_MULTI
#define MODE_MULTI 0
#endif
#ifndef NAIVE_MIX0
#define NAIVE_MIX0 0
#endif
#ifndef NAIVE_MIX1
#define NAIVE_MIX1 0
#endif

#ifndef PROBE_REP
#define PROBE_REP 0
#endif

#ifndef PROBE_VAR
#define PROBE_VAR 0
#endif
#define GAS __attribute__((address_space(1)))
#define LAS __attribute__((address_space(3)))
#define DI __device__ __forceinline__
typedef unsigned short bf16;
typedef unsigned u32x4 __attribute__((ext_vector_type(4)));
typedef unsigned u32x2 __attribute__((ext_vector_type(2)));
typedef float f32x4 __attribute__((ext_vector_type(4)));
typedef float f32x2 __attribute__((ext_vector_type(2)));
typedef short bf16x8 __attribute__((ext_vector_type(8)));
typedef __bf16 bf16v2 __attribute__((ext_vector_type(2)));
typedef unsigned char uchar;

constexpr int SEQ = 8192, M = 16384, D = 4096;
constexpr int N1 = 24576, K2 = 8192, N3 = 18560, N3P = 18688, N3DT = 18432, K4 = 8192;
constexpr int NCH = SEQ / 64;
constexpr int C_Q = 0, C_F = 4096, C_I = 8192, C_GA = 12288, C_XB = 16384, C_GB = 20480;
constexpr int C_Z = 0, C_X = 8192, C_B = 16384, C_C = 17408, C_DT = 18432;
constexpr float EPS = 1e-6f;
constexpr float LOG2E = 1.4426950408889634f;

constexpr size_t MiB = 1u << 20;
constexpr size_t WS_CTL = 0, CTL_ZERO_BYTES = 1 * MiB;
constexpr size_t WS_W1 = 1 * MiB;
constexpr size_t WS_W2 = 193 * MiB;
constexpr size_t WS_W3 = 257 * MiB;
constexpr size_t WS_W4 = 403 * MiB;
constexpr size_t WS_HN = 467 * MiB;
constexpr size_t WS_PROJ = 595 * MiB;
constexpr size_t WS_END = 1432 * MiB;
constexpr int CW_TMO = 0, CW_CODE = 1;
constexpr int CW_BAR = 4096;
constexpr int CW_SSQA = 16384, CW_SSQH1 = 32768, CW_SSQY = 49152, CW_SSQH2 = 65536;
constexpr int CW_DUMMY = 81920;
constexpr int CW_PANEL = 98304;
static_assert((CW_PANEL + 2 * 64 * 64) * 4 <= (int)CTL_ZERO_BYTES, "ctl");
constexpr size_t WS_PREP = 1179 * MiB;
constexpr size_t WS_PG = 1363 * MiB, WS_GL = 1427 * MiB;
constexpr size_t WS_DUMMY1 = 1280 * MiB;

constexpr int RING_BYTES = 131072;
constexpr int LDS_BYTES = 147456;
constexpr int LDSCTL_OFF = LDS_BYTES - 512, MISC_OFF = LDSCTL_OFF + 320;

DI float bflo(unsigned w) { return __uint_as_float(w << 16); }
DI float bfhi(unsigned w) { return __uint_as_float(w & 0xffff0000u); }
DI float bf2f(unsigned h) { return __uint_as_float(h << 16); }
DI unsigned pk2(float lo, float hi) { f32x2 v = {lo, hi}; bf16v2 b = __builtin_convertvector(v, bf16v2); return __builtin_bit_cast(unsigned, b); }
DI float fexp2(float x) { return __builtin_amdgcn_exp2f(x); }
DI float flog2(float x) { return __builtin_amdgcn_logf(x); }
DI float frcp(float x) { return __builtin_amdgcn_rcpf(x); }
DI float fsigmoid(float x) { return frcp(1.0f + fexp2(-LOG2E * x)); }
DI float fsilu(float x) { return x * fsigmoid(x); }
#define LDS_BAR() do { asm volatile("s_waitcnt lgkmcnt(0)" ::: "memory"); __builtin_amdgcn_s_barrier(); asm volatile("" ::: "memory"); } while (0)
#define VM_WAIT() asm volatile("s_waitcnt vmcnt(0)" ::: "memory")
DI float fq_sum(float x) {
    auto r = __builtin_amdgcn_permlane16_swap(__float_as_uint(x), __float_as_uint(x), false, false); x = __uint_as_float(r[0]) + __uint_as_float(r[1]);
    auto q = __builtin_amdgcn_permlane32_swap(__float_as_uint(x), __float_as_uint(x), false, false); return __uint_as_float(q[0]) + __uint_as_float(q[1]);
}
DI float wave_sum(float v) {
#pragma unroll
    for (int o = 1; o < 64; o <<= 1) v += __shfl_xor(v, o);
    return v;
}
#define XB_TMO      128
#define XB_XCNT(j)  (256  + 64 * (j))
#define XB_XSUB(j)  (1280 + 64 * (j))
#define XB_XGEN(j)  (2304 + 64 * (j))
#define XB_TOP      3328
#define XB_TOPGEN   3392
#define XCD_BAR_WORDS 3456
#define XB_SPIN_CAP (1u << 18)

__device__ __forceinline__ unsigned xb_ld(unsigned* p)              { return __hip_atomic_load(p, __ATOMIC_RELAXED, __HIP_MEMORY_SCOPE_AGENT); }
__device__ __forceinline__ unsigned xb_add(unsigned* p, unsigned v) { return __hip_atomic_fetch_add(p, v, __ATOMIC_RELAXED, __HIP_MEMORY_SCOPE_AGENT); }
__device__ __forceinline__ unsigned xb_xcc_id() { return (unsigned)__builtin_amdgcn_s_getreg((3 << 11) | 20) & 0xFu; }
#define XB_SPIN(cond, bar) do { unsigned _sp = 0; while (cond) { __builtin_amdgcn_s_sleep(1); \
    if ((++_sp & 255u) == 0u) { if (xb_ld(&(bar)[XB_TMO])) break; if (_sp > XB_SPIN_CAP) { atomicAdd(&(bar)[XB_TMO], 1u); break; } } } } while (0)

struct XcdBarrier {
    unsigned* bar; unsigned x;
    volatile LAS unsigned* st;
};

__device__ __forceinline__ XcdBarrier xcd_barrier_post(unsigned* bar, volatile LAS unsigned* st) {
    XcdBarrier b; b.bar = bar; b.x = xb_xcc_id(); b.st = st;
    if (threadIdx.x == 0) (void)xb_add(&bar[XB_XCNT(b.x)], 1u);
    return b;
}
__device__ __forceinline__ void xcd_barrier_complete(unsigned* bar, unsigned x, unsigned& nloc, unsigned& nx) {
    const unsigned G = gridDim.x * gridDim.y * gridDim.z;
    unsigned sum, cnt, mine, sp = 0u;
    for (;;) {
        sum = 0u; cnt = 0u; mine = 0u;
#pragma unroll
        for (unsigned j = 0; j < 16; ++j) { const unsigned c = xb_ld(&bar[XB_XCNT(j)]); sum += c; cnt += (c > 0u) ? 1u : 0u; mine = (j == x) ? c : mine; }
        if (sum == G) break;
        __builtin_amdgcn_s_sleep(1);
        if ((++sp & 255u) == 0u) { if (xb_ld(&bar[XB_TMO])) break; if (sp > XB_SPIN_CAP) { atomicAdd(&bar[XB_TMO], 1u); break; } }
    }
    nloc = mine > 0u ? mine : 1u; nx = cnt > 0u ? cnt : 1u;
}

__device__ __forceinline__ void xcd_barrier(const XcdBarrier& b) {
    asm volatile("s_waitcnt vmcnt(0)" ::: "memory");
    __syncthreads();
    if (threadIdx.x == 0) {
        unsigned* bar = b.bar;
        __builtin_amdgcn_s_waitcnt(0);
        unsigned nloc = b.st[0], nx = b.st[1];
        if (nloc == 0u) { xcd_barrier_complete(bar, b.x, nloc, nx); b.st[0] = nloc; b.st[1] = nx; }
        const unsigned old = xb_add(&bar[XB_XSUB(b.x)], 1u);
        const unsigned gen = old / nloc;
        if (old + 1u == (gen + 1u) * nloc) {
            __builtin_amdgcn_fence(__ATOMIC_RELEASE, "agent");
            asm volatile("s_waitcnt vmcnt(0)" ::: "memory");
            const unsigned og = xb_add(&bar[XB_TOP], 1u);
            const unsigned tg = og / nx;
            if (og + 1u == (tg + 1u) * nx) xb_add(&bar[XB_TOPGEN], 1u);
            else XB_SPIN(xb_ld(&bar[XB_TOPGEN]) == tg, bar);
            __builtin_amdgcn_fence(__ATOMIC_ACQUIRE, "agent");
            xb_add(&bar[XB_XGEN(b.x)], 1u);
            asm volatile("s_waitcnt vmcnt(0)" ::: "memory");
        } else {
            XB_SPIN(xb_ld(&bar[XB_XGEN(b.x)]) == gen, bar);
            __builtin_amdgcn_fence(__ATOMIC_ACQUIRE, "agent");
            asm volatile("s_waitcnt vmcnt(0)" ::: "memory");
        }
    }
    __syncthreads();
}
namespace pg8 {
#define PG8_LAS __attribute__((address_space(3)))
typedef unsigned short bf16_t;
typedef short bf16x8 __attribute__((ext_vector_type(8)));
typedef float f32x4 __attribute__((ext_vector_type(4)));
typedef unsigned u32x4 __attribute__((ext_vector_type(4)));
constexpr int BM = 256, BK = 64, HALF = 128, HTB = HALF * BK * 2  , STAGE_BYTES = 8 * HTB, NXCD = 8, WGM = 8;

__host__ __device__ __forceinline__ int lds_byte(int r, int c) { const int st = (r >> 4) * 2 + (c >> 5), rr = r & 15, cc = c & 31, ob = rr * 64 + cc * 2; return st * 1024 + (ob ^ (((ob >> 9) & 1) << 5)); }
__host__ __device__ __forceinline__ void stage_rc(int b, int& R, int& C) { const int st = b / 1024, sb = b % 1024, swz = sb ^ (((sb >> 9) & 1) << 5); R = (st >> 1) * 16 + swz / 64; C = (st & 1) * 32 + (swz % 64) / 2; }
__host__ __device__ __forceinline__ int perm32(int rho) { const int n = rho >> 4, i = rho & 15; return 8 * (i >> 2) + 4 * n + (i & 3); }

struct Unit { int pm, pn, kq; };
struct Gemm { const bf16_t* A; const bf16_t* Bt; int M, N, K, lda, ldb, kj_t; long kj_bytes; long kq_bytes; };

struct StaticOrder {
    int nM, nN, nwg, G, c, wgm;
    __host__ __device__ void init(int M, int N, int G_, int c_, int wgm_ = WGM) { nM = M / BM; nN = N / BM; nwg = nM * nN; G = G_; c = c_; wgm = wgm_; }
    __host__ __device__ bool next(int i, Unit& u) const {
        const long L = (long)i * G + c; if (L >= nwg) return false;
        int wgid = (int)L; { const int q = nwg / NXCD, r = nwg % NXCD, xcd = wgid % NXCD, off = wgid / NXCD; wgid = (xcd < r ? xcd * (q + 1) : r * (q + 1) + (xcd - r) * q) + off; }
        const int nig = wgm * nN, gid = wgid / nig, fm = gid * wgm, gsz = (nM - fm) < wgm ? (nM - fm) : wgm;
        u.pm = fm + ((wgid % nig) % gsz); u.pn = (wgid % nig) / gsz; u.kq = 0; return true;
    }
    __device__ __forceinline__ void a_ready(const Unit&) const {}
    __device__ __forceinline__ void done(const Unit&) const {}
};


struct KSplitOrder {
    int nM, G, c;
    __host__ __device__ void init(int M, int G_, int c_) { nM = M / BM; G = G_; c = c_; }
    __host__ __device__ bool next(int i, Unit& u) const { const int L = i * G + c; if (L >= 4 * nM) return false; u.pm = L >> 2; u.pn = 0; u.kq = L & 3; return true; }
    __device__ __forceinline__ void a_ready(const Unit&) const {}
    __device__ __forceinline__ void done(const Unit&) const {}
};
DI unsigned cvt_pk_bf16(float lo, float hi) { f32x2 v = {lo, hi}; bf16v2 b = __builtin_convertvector(v, bf16v2); return __builtin_bit_cast(unsigned, b); }

struct EpiBf16 {
    static constexpr bool PERM = true, AFTER_DRAIN = false, MIDK = false;
    bf16_t* O; int ldc; const float* ssq;
    DI void midk(f32x4 (&)[2][2][4][2], const Unit&, int, int) const {}
    DI void operator()(const f32x4 (&acc)[2][2][4][2], const Unit& u, int wr, int wc, int fr, int fq) const {
        const int row0 = u.pm * BM + wr * 64 + fr; const int col0 = u.pn * BM + wc * 32 + 8 * fq;
        float rs[2][4];
#pragma unroll
        for (int ai = 0; ai < 2; ++ai)
#pragma unroll
            for (int m = 0; m < 4; ++m) rs[ai][m] = ssq ? __builtin_amdgcn_rsqf(ssq[row0 + ai * HALF + m * 16] * (1.0f / 4096.0f) + 1e-6f) : 1.0f;
#pragma unroll
        for (int ai = 0; ai < 2; ++ai)
#pragma unroll
            for (int m = 0; m < 4; ++m) { bf16_t* rowp = O + (size_t)(row0 + ai * HALF + m * 16) * ldc + col0; const float s = rs[ai][m];
#pragma unroll
                for (int bj = 0; bj < 2; ++bj) { const f32x4 v0 = acc[ai][bj][m][0] * s, v1 = acc[ai][bj][m][1] * s;
                    u32x4 w; w.x = cvt_pk_bf16(v0[0], v0[1]); w.y = cvt_pk_bf16(v0[2], v0[3]); w.z = cvt_pk_bf16(v1[0], v1[1]); w.w = cvt_pk_bf16(v1[2], v1[3]);
                    *(u32x4*)(rowp + bj * HALF) = w; } }
    }
};

struct EpiRes {
    static constexpr bool PERM = false, AFTER_DRAIN = false, MIDK = true;
    const float* base; float* out; bf16_t* hn; const float* nw; const float* ssq_mid; const float* ssq_epi; float* ssq_out;
    DI void midk(f32x4 (&acc)[2][2][4][2], const Unit& u, int wr, int fr) const {
        if (!ssq_mid) return;
        const int row0 = u.pm * BM + wr * 64 + fr;
#pragma unroll
        for (int ai = 0; ai < 2; ++ai)
#pragma unroll
            for (int m = 0; m < 4; ++m) { const float s = __builtin_amdgcn_rsqf(ssq_mid[row0 + ai * HALF + m * 16] * (1.0f / 4096.0f) + 1e-6f);
#pragma unroll
                for (int bj = 0; bj < 2; ++bj)
#pragma unroll
                    for (int n = 0; n < 2; ++n) acc[ai][bj][m][n] *= s; }
    }
    DI void operator()(const f32x4 (&acc)[2][2][4][2], const Unit& u, int wr, int wc, int fr, int fq) const {
        const int row0 = u.pm * BM + wr * 64 + fr, col0 = u.pn * BM + wc * 32 + 4 * fq;
        f32x4 nwv[2][2];
#pragma unroll
        for (int bj = 0; bj < 2; ++bj)
#pragma unroll
            for (int n = 0; n < 2; ++n) nwv[bj][n] = hn ? *(const f32x4*)(nw + col0 + bj * HALF + n * 16) : (f32x4){0.f, 0.f, 0.f, 0.f};
        f32x4 nxt[2][2];
#pragma unroll
        for (int bj = 0; bj < 2; ++bj)
#pragma unroll
            for (int n = 0; n < 2; ++n) nxt[bj][n] = *(const f32x4*)(base + (size_t)row0 * 4096 + col0 + bj * HALF + n * 16);
#pragma unroll
        for (int g = 0; g < 8; ++g) { const int ai = g >> 2, m = g & 3; const int row = row0 + ai * HALF + m * 16; const size_t off = (size_t)row * 4096 + col0;
            f32x4 cur[2][2];
#pragma unroll
            for (int bj = 0; bj < 2; ++bj)
#pragma unroll
                for (int n = 0; n < 2; ++n) cur[bj][n] = nxt[bj][n];
            if (g + 1 < 8) { const size_t offn = (size_t)(row0 + ((g + 1) >> 2) * HALF + ((g + 1) & 3) * 16) * 4096 + col0;
#pragma unroll
                for (int bj = 0; bj < 2; ++bj)
#pragma unroll
                    for (int n = 0; n < 2; ++n) nxt[bj][n] = *(const f32x4*)(base + offn + bj * HALF + n * 16); }
            const float s = ssq_epi ? __builtin_amdgcn_rsqf(ssq_epi[row] * (1.0f / 8192.0f) + 1e-6f) : 1.0f;
            float ss = 0.f;
#pragma unroll
            for (int bj = 0; bj < 2; ++bj)
#pragma unroll
                for (int n = 0; n < 2; ++n) { const f32x4 v = cur[bj][n] + acc[ai][bj][m][n] * s;
                    *(f32x4*)(out + off + bj * HALF + n * 16) = v; ss += (v[0] * v[0] + v[1] * v[1]) + (v[2] * v[2] + v[3] * v[3]);
                    if (hn) { const f32x4 w = nwv[bj][n]; u32x2 p; p.x = cvt_pk_bf16(v[0] * w[0], v[1] * w[1]); p.y = cvt_pk_bf16(v[2] * w[2], v[3] * w[3]);
                        *(u32x2*)(hn + off + bj * HALF + n * 16) = p; } }
            ss = fq_sum(ss);
            if (fq == 0) unsafeAtomicAdd(ssq_out + row, ss);
            asm volatile("" ::: "memory"); }
    }
};

struct EpiRes16 {
    static constexpr bool PERM = true, AFTER_DRAIN = false, MIDK = true;
    const float* base32; const bf16_t* base16; bf16_t* O; const float* ssq_mid; const float* ssq_epi; float* ssq_out;
    DI void midk(f32x4 (&acc)[2][2][4][2], const Unit& u, int wr, int fr) const {
        if (!ssq_mid) return;
        const int row0 = u.pm * BM + wr * 64 + fr;
#pragma unroll
        for (int ai = 0; ai < 2; ++ai)
#pragma unroll
            for (int m = 0; m < 4; ++m) { const float s = __builtin_amdgcn_rsqf(ssq_mid[row0 + ai * HALF + m * 16] * (1.0f / 4096.0f) + 1e-6f);
#pragma unroll
                for (int bj = 0; bj < 2; ++bj)
#pragma unroll
                    for (int n = 0; n < 2; ++n) acc[ai][bj][m][n] *= s; }
    }
    DI void operator()(const f32x4 (&acc)[2][2][4][2], const Unit& u, int wr, int wc, int fr, int fq) const {
        const int row0 = u.pm * BM + wr * 64 + fr, col0 = u.pn * BM + wc * 32 + 8 * fq;
        f32x4 nx32[2][2]; u32x4 nx16[2];
        if (base32) {
#pragma unroll
            for (int bj = 0; bj < 2; ++bj)
#pragma unroll
                for (int n = 0; n < 2; ++n) nx32[bj][n] = *(const f32x4*)(base32 + (size_t)row0 * 4096 + col0 + bj * HALF + 4 * n);
        } else {
#pragma unroll
            for (int bj = 0; bj < 2; ++bj) nx16[bj] = *(const u32x4*)(base16 + (size_t)row0 * 4096 + col0 + bj * HALF);
        }
#pragma unroll
        for (int g = 0; g < 8; ++g) { const int ai = g >> 2, m = g & 3; const int row = row0 + ai * HALF + m * 16; const size_t off = (size_t)row * 4096 + col0;
            f32x4 cur[2][2];
            if (base32) {
#pragma unroll
                for (int bj = 0; bj < 2; ++bj)
#pragma unroll
                    for (int n = 0; n < 2; ++n) cur[bj][n] = nx32[bj][n];
            } else {
#pragma unroll
                for (int bj = 0; bj < 2; ++bj) { const u32x4 w = nx16[bj]; cur[bj][0] = (f32x4){bflo(w.x), bfhi(w.x), bflo(w.y), bfhi(w.y)}; cur[bj][1] = (f32x4){bflo(w.z), bfhi(w.z), bflo(w.w), bfhi(w.w)}; }
            }
            if (g + 1 < 8) { const size_t offn = (size_t)(row0 + ((g + 1) >> 2) * HALF + ((g + 1) & 3) * 16) * 4096 + col0;
                if (base32) {
#pragma unroll
                    for (int bj = 0; bj < 2; ++bj)
#pragma unroll
                        for (int n = 0; n < 2; ++n) nx32[bj][n] = *(const f32x4*)(base32 + offn + bj * HALF + 4 * n);
                } else {
#pragma unroll
                    for (int bj = 0; bj < 2; ++bj) nx16[bj] = *(const u32x4*)(base16 + offn + bj * HALF);
                } }
            const float s = ssq_epi ? __builtin_amdgcn_rsqf(ssq_epi[row] * (1.0f / 8192.0f) + 1e-6f) : 1.0f;
            float ss = 0.f;
#pragma unroll
            for (int bj = 0; bj < 2; ++bj) { const f32x4 v0 = cur[bj][0] + acc[ai][bj][m][0] * s, v1 = cur[bj][1] + acc[ai][bj][m][1] * s;
                ss += ((v0[0] * v0[0] + v0[1] * v0[1]) + (v0[2] * v0[2] + v0[3] * v0[3])) + ((v1[0] * v1[0] + v1[1] * v1[1]) + (v1[2] * v1[2] + v1[3] * v1[3]));
                u32x4 w; w.x = cvt_pk_bf16(v0[0], v0[1]); w.y = cvt_pk_bf16(v0[2], v0[3]); w.z = cvt_pk_bf16(v1[0], v1[1]); w.w = cvt_pk_bf16(v1[2], v1[3]);
                *(u32x4*)(O + off + bj * HALF) = w; }
            ss = fq_sum(ss);
            if (fq == 0) unsafeAtomicAdd(ssq_out + row, ss);
            asm volatile("" ::: "memory"); }
    }
};

struct EpiDtPart {
    static constexpr bool PERM = false, AFTER_DRAIN = false, MIDK = false;
    float* part; const float* ssq;
    DI void midk(f32x4 (&)[2][2][4][2], const Unit&, int, int) const {}
    DI void operator()(const f32x4 (&acc)[2][2][4][2], const Unit& u, int wr, int wc, int fr, int fq) const {
        const int row0 = u.pm * BM + wr * 64 + fr, col0 = wc * 32 + 4 * fq; float* P = part + (size_t)u.kq * 16384 * 128;
#pragma unroll
        for (int ai = 0; ai < 2; ++ai)
#pragma unroll
            for (int m = 0; m < 4; ++m) { const int row = row0 + ai * HALF + m * 16; const float s = __builtin_amdgcn_rsqf(ssq[row] * (1.0f / 4096.0f) + 1e-6f);
#pragma unroll
                for (int n = 0; n < 2; ++n) *(f32x4*)(P + (size_t)row * 128 + col0 + 16 * n) = acc[ai][0][m][n] * s; }
    }
};

struct EpiFinal {
    static constexpr bool PERM = true, AFTER_DRAIN = false, MIDK = false;
    const bf16_t* base16; float* out; const float* fw; const float* ssq_epi; float* ssq_out; unsigned* cnt; unsigned* tmo;
    DI void midk(f32x4 (&)[2][2][4][2], const Unit&, int, int) const {}
    DI void operator()(f32x4 (&acc)[2][2][4][2], const Unit& u, int wr, int wc, int fr, int fq) const {
        const int row0 = u.pm * BM + wr * 64 + fr, col0 = u.pn * BM + wc * 32 + 8 * fq;
        u32x4 q16[2][2];
#define EF_LOAD(slot_, g_) do { const size_t o_ = (size_t)(row0 + ((g_) >> 2) * HALF + ((g_) & 3) * 16) * 4096 + col0; \
            _Pragma("unroll") for (int bj = 0; bj < 2; ++bj) q16[slot_][bj] = *(const u32x4*)(base16 + o_ + bj * HALF); } while (0)
        EF_LOAD(0, 0); EF_LOAD(1, 1);
#pragma unroll
        for (int g = 0; g < 8; ++g) { const int ai = g >> 2, m = g & 3; const int row = row0 + ai * HALF + m * 16;
            f32x4 cur[2][2];
#pragma unroll
            for (int bj = 0; bj < 2; ++bj) { const u32x4 w = q16[g & 1][bj]; cur[bj][0] = (f32x4){bflo(w.x), bfhi(w.x), bflo(w.y), bfhi(w.y)}; cur[bj][1] = (f32x4){bflo(w.z), bfhi(w.z), bflo(w.w), bfhi(w.w)}; }
            if (g + 2 < 8) EF_LOAD(g & 1, g + 2);
            const float s = __builtin_amdgcn_rsqf(ssq_epi[row] * (1.0f / 8192.0f) + 1e-6f);
            float ss = 0.f;
#pragma unroll
            for (int bj = 0; bj < 2; ++bj) { const f32x4 v0 = cur[bj][0] + acc[ai][bj][m][0] * s, v1 = cur[bj][1] + acc[ai][bj][m][1] * s;
                ss += ((v0[0] * v0[0] + v0[1] * v0[1]) + (v0[2] * v0[2] + v0[3] * v0[3])) + ((v1[0] * v1[0] + v1[1] * v1[1]) + (v1[2] * v1[2] + v1[3] * v1[3]));
                acc[ai][bj][m][0] = v0; acc[ai][bj][m][1] = v1; }
            ss = fq_sum(ss);
            if (fq == 0) unsafeAtomicAdd(ssq_out + row, ss); }
#undef EF_LOAD
        asm volatile("s_waitcnt vmcnt(0)" ::: "memory");
        unsigned* c = cnt + 64 * u.pm;
        if (fr == 0 && fq == 0) __hip_atomic_fetch_add(c, 1u, __ATOMIC_RELAXED, __HIP_MEMORY_SCOPE_AGENT);
        { unsigned sp = 0;
          while ((unsigned)__builtin_amdgcn_readfirstlane(__hip_atomic_load(c, __ATOMIC_RELAXED, __HIP_MEMORY_SCOPE_AGENT)) < 128u) {
              __builtin_amdgcn_s_sleep(2);
              if (++sp > (1u << 19)) { if (fr == 0 && fq == 0) __hip_atomic_store(tmo, 0x900u | (unsigned)(u.pm & 0xff), __ATOMIC_RELAXED, __HIP_MEMORY_SCOPE_AGENT); break; } } }
        f32x4 fwv[2][2];
#pragma unroll
        for (int bj = 0; bj < 2; ++bj)
#pragma unroll
            for (int n = 0; n < 2; ++n) fwv[bj][n] = *(const f32x4*)(fw + col0 + bj * HALF + 4 * n);
#pragma unroll
        for (int g = 0; g < 8; ++g) { const int ai = g >> 2, m = g & 3; const int row = row0 + ai * HALF + m * 16;
            const float tot = __hip_atomic_load(ssq_out + row, __ATOMIC_RELAXED, __HIP_MEMORY_SCOPE_AGENT);
            const float rs = __builtin_amdgcn_rsqf(tot * (1.0f / 4096.0f) + 1e-6f);
#pragma unroll
            for (int bj = 0; bj < 2; ++bj)
#pragma unroll
                for (int n = 0; n < 2; ++n) *(f32x4*)(out + (size_t)row * 4096 + col0 + bj * HALF + 4 * n) = acc[ai][bj][m][n] * rs * fwv[bj][n]; }
    }
};
template <class Epi, class Sched, bool ALIGN_EPI = false, bool SP2 = false>
__device__ __forceinline__ void gemm_phase(PG8_LAS unsigned char* lds, const Gemm g, const Sched& S, const Epi& E) {
    const int tid = threadIdx.x, wid = __builtin_amdgcn_readfirstlane(tid >> 6), lane = tid & 63, wr = wid >> 2, wc = wid & 3, fr = lane & 15, fq = lane >> 4;
    const int K = g.K, nt = K / BK;
    unsigned voffA[2], voffB[2];
#pragma unroll
    for (int i = 0; i < 2; ++i) { int R, C; stage_rc(tid * 16 + i * 8192, R, C); const int Rb = Epi::PERM ? ((R & ~31) + perm32(R & 31)) : R;
        voffA[i] = (unsigned)(R * g.lda + C) * 2u; voffB[i] = (unsigned)(Rb * g.ldb + C) * 2u; }
    const size_t kstep = (size_t)(BK * 2);
    const size_t hstepA = (size_t)HALF * g.lda * 2, hstepB = (size_t)HALF * g.ldb * 2;
    const size_t tstepA = 2 * hstepA, tstepB = 2 * hstepB;
    const unsigned ldsw = (unsigned)wid * 1024u;
    const int aoff = lds_byte(wr * 64 + fr, fq * 8), boff = lds_byte(wc * 32 + fr, fq * 8);
#define PG8_SA(b, h) (((b) * 2 + (h)) * HTB)
#define PG8_SB(b, h) ((4 + (b) * 2 + (h)) * HTB)
#define PG8_STAGE(bufoff, gbase, voff) do { _Pragma("unroll") for (int _i = 0; _i < 2; ++_i) \
        __builtin_amdgcn_global_load_lds((const unsigned*)((const char*)(gbase) + (voff)[_i]), (PG8_LAS unsigned*)(lds + (bufoff) + ldsw + _i * 8192), 16, 0, 0); } while (0)
#define PG8_LDA(dst, b, h) do { _Pragma("unroll") for (int m = 0; m < 4; ++m) _Pragma("unroll") for (int k = 0; k < 2; ++k) dst[m][k] = *(const PG8_LAS bf16x8*)(lds + PG8_SA(b, h) + aoff + m * 2048 + k * 1024); } while (0)
#define PG8_LDB(dst, b, h) do { _Pragma("unroll") for (int n = 0; n < 2; ++n) _Pragma("unroll") for (int k = 0; k < 2; ++k) dst[n][k] = *(const PG8_LAS bf16x8*)(lds + PG8_SB(b, h) + boff + n * 2048 + k * 1024); } while (0)
#define PG8_MMA(ai, bj, At, Bt) do { __builtin_amdgcn_s_setprio(1); _Pragma("unroll") for (int m = 0; m < 4; ++m) _Pragma("unroll") for (int n = 0; n < 2; ++n) _Pragma("unroll") for (int k = 0; k < 2; ++k) \
        acc[ai][bj][m][n] = __builtin_amdgcn_mfma_f32_16x16x32_bf16(Bt[n][k], At[m][k], acc[ai][bj][m][n], 0, 0, 0); __builtin_amdgcn_s_setprio(0); } while (0)
#define PG8_WAIT_V(n) asm volatile("s_waitcnt vmcnt(" #n ")" ::: "memory")
#define PG8_WAIT_L(n) asm volatile("s_waitcnt lgkmcnt(" #n ")" ::: "memory")
#define PG8_BAR __builtin_amdgcn_s_barrier()
#define PG8_SCHED __builtin_amdgcn_sched_barrier(0)
    Unit cur, nxt; int ui = 0;
    if (!S.next(0, cur)) return;
    f32x4 acc[2][2][4][2];
#pragma unroll
    for (int a = 0; a < 2; ++a)
#pragma unroll
        for (int b = 0; b < 2; ++b)
#pragma unroll
            for (int m = 0; m < 4; ++m)
#pragma unroll
                for (int n = 0; n < 2; ++n) acc[a][b][m][n] = (f32x4){0.f, 0.f, 0.f, 0.f};
    bf16x8 At[4][2], B0[2][2], B1[2][2];
    const char* cA = (const char*)g.A + (size_t)cur.pm * tstepA + cur.kq * g.kq_bytes; const char* cB = (const char*)g.Bt + (size_t)cur.pn * tstepB + cur.kq * g.kq_bytes;
    S.a_ready(cur);
    if constexpr (SP2) {
        PG8_STAGE(PG8_SB(0, 0), cB, voffB); PG8_STAGE(PG8_SB(0, 1), cB + hstepB, voffB); PG8_STAGE(PG8_SA(0, 0), cA, voffA); PG8_STAGE(PG8_SA(0, 1), cA + hstepA, voffA);
        if (wr == 1) PG8_BAR;
        PG8_WAIT_V(2); PG8_BAR;
        PG8_STAGE(PG8_SB(1, 0), cB + kstep, voffB); PG8_STAGE(PG8_SA(1, 0), cA + kstep, voffA); PG8_STAGE(PG8_SB(1, 1), cB + hstepB + kstep, voffB);
        PG8_WAIT_V(6); PG8_BAR;
    } else {
        PG8_STAGE(PG8_SB(0, 0), cB, voffB); PG8_STAGE(PG8_SA(0, 0), cA, voffA); PG8_STAGE(PG8_SB(0, 1), cB + hstepB, voffB); PG8_STAGE(PG8_SA(0, 1), cA + hstepA, voffA);
        if (wr == 1) PG8_BAR;
        PG8_WAIT_V(4); PG8_BAR;
        PG8_STAGE(PG8_SB(1, 0), cB + kstep, voffB); PG8_STAGE(PG8_SA(1, 0), cA + kstep, voffA); PG8_STAGE(PG8_SB(1, 1), cB + hstepB + kstep, voffB);
        PG8_WAIT_V(6); PG8_BAR;
    }
    for (;;) {
        const bool has_next = S.next(ui + 1, nxt);
        const char* nA = has_next ? (const char*)g.A + (size_t)nxt.pm * tstepA + nxt.kq * g.kq_bytes : cA; const char* nB = has_next ? (const char*)g.Bt + (size_t)nxt.pn * tstepB + nxt.kq * g.kq_bytes : cB;
        for (int t = 0; t < nt; t += 2) {
            const bool last = (t == nt - 2);
            const char* a1 = cA + (size_t)(t + 1) * kstep + (t >= g.kj_t ? g.kj_bytes : 0);
            const char* a2 = last ? nA : cA + (size_t)(t + 2) * kstep + (t + 2 >= g.kj_t ? g.kj_bytes : 0); const char* b2 = last ? nB : cB + (size_t)(t + 2) * kstep;
            const char* a3 = a2 + kstep; const char* b3 = b2 + kstep;
            if (last && has_next) S.a_ready(nxt);
            if constexpr (Epi::MIDK) { if (t == g.kj_t) E.midk(acc, cur, wr, fr); }
            if constexpr (SP2) {
            PG8_LDB(B0, 0, 0); PG8_LDB(B1, 0, 1); PG8_SCHED; PG8_LDA(At, 0, 0); PG8_STAGE(PG8_SA(1, 1), a1 + hstepA, voffA);
            PG8_WAIT_V(8); PG8_WAIT_L(0); PG8_BAR; PG8_MMA(0, 0, At, B0); PG8_MMA(0, 1, At, B1); PG8_BAR; PG8_SCHED;
            PG8_LDA(At, 0, 1); PG8_STAGE(PG8_SB(0, 0), b2, voffB); PG8_STAGE(PG8_SB(0, 1), b2 + hstepB, voffB); PG8_STAGE(PG8_SA(0, 0), a2, voffA);
            PG8_WAIT_V(8); PG8_WAIT_L(0); PG8_BAR; PG8_MMA(1, 0, At, B0); PG8_MMA(1, 1, At, B1); PG8_BAR; PG8_SCHED;
            PG8_LDB(B0, 1, 0); PG8_LDB(B1, 1, 1); PG8_SCHED; PG8_LDA(At, 1, 0); PG8_STAGE(PG8_SA(0, 1), a2 + hstepA, voffA);
            PG8_WAIT_V(8); PG8_WAIT_L(0); PG8_BAR; PG8_MMA(0, 0, At, B0); PG8_MMA(0, 1, At, B1); PG8_BAR; PG8_SCHED;
            PG8_LDA(At, 1, 1); PG8_STAGE(PG8_SB(1, 0), b3, voffB); PG8_STAGE(PG8_SB(1, 1), b3 + hstepB, voffB); PG8_STAGE(PG8_SA(1, 0), a3, voffA);
            PG8_WAIT_V(8); PG8_WAIT_L(0); PG8_BAR; PG8_MMA(1, 0, At, B0); PG8_MMA(1, 1, At, B1); PG8_BAR; PG8_SCHED;
            } else {
            PG8_LDB(B0, 0, 0); PG8_SCHED; PG8_LDA(At, 0, 0); PG8_STAGE(PG8_SA(1, 1), a1 + hstepA, voffA);
            PG8_WAIT_L(8); PG8_BAR; PG8_WAIT_L(0); PG8_MMA(0, 0, At, B0); PG8_BAR; PG8_SCHED;
            PG8_LDB(B1, 0, 1); PG8_STAGE(PG8_SB(0, 0), b2, voffB);
            PG8_BAR; PG8_WAIT_L(0); PG8_MMA(0, 1, At, B1); PG8_BAR;
            PG8_LDA(At, 0, 1); PG8_STAGE(PG8_SA(0, 0), a2, voffA);
            PG8_BAR; PG8_WAIT_L(0); PG8_MMA(1, 0, At, B0); PG8_BAR; PG8_SCHED;
            PG8_STAGE(PG8_SB(0, 1), b2 + hstepB, voffB);
            PG8_WAIT_V(6); PG8_BAR; PG8_MMA(1, 1, At, B1); PG8_BAR;
            PG8_LDB(B0, 1, 0); PG8_SCHED; PG8_LDA(At, 1, 0); PG8_STAGE(PG8_SA(0, 1), a2 + hstepA, voffA);
            PG8_WAIT_L(8); PG8_BAR; PG8_WAIT_L(0); PG8_MMA(0, 0, At, B0); PG8_BAR; PG8_SCHED;
            PG8_LDB(B1, 1, 1); PG8_STAGE(PG8_SB(1, 0), b3, voffB);
            PG8_BAR; PG8_WAIT_L(0); PG8_MMA(0, 1, At, B1); PG8_BAR;
            PG8_LDA(At, 1, 1); PG8_STAGE(PG8_SA(1, 0), a3, voffA);
            PG8_BAR; PG8_WAIT_L(0); PG8_MMA(1, 0, At, B0); PG8_BAR; PG8_SCHED;
            PG8_STAGE(PG8_SB(1, 1), b3 + hstepB, voffB);
            PG8_WAIT_V(6); PG8_BAR; PG8_MMA(1, 1, At, B1); PG8_BAR;
            }
        }
        if constexpr (ALIGN_EPI) { if (wr == 0) PG8_BAR; }
        if constexpr (!Epi::AFTER_DRAIN) { E(acc, cur, wr, wc, fr, fq); S.done(cur); }
        if (!has_next) break;
#pragma unroll
        for (int a = 0; a < 2; ++a)
#pragma unroll
            for (int b = 0; b < 2; ++b)
#pragma unroll
                for (int m = 0; m < 4; ++m)
#pragma unroll
                    for (int n = 0; n < 2; ++n) acc[a][b][m][n] = (f32x4){0.f, 0.f, 0.f, 0.f};
        cur = nxt; cA = nA; cB = nB; ++ui;
        if constexpr (ALIGN_EPI) { if (wr == 1) PG8_BAR; }
    }
    PG8_WAIT_V(0);
    if constexpr (!ALIGN_EPI) { if (wr == 0) PG8_BAR; }
    PG8_BAR;
    if constexpr (Epi::AFTER_DRAIN) { E.fused(acc, cur, wr, wc, fr, fq, lds, wid, lane); S.done(cur); }
#undef PG8_SA
#undef PG8_SB
#undef PG8_STAGE
#undef PG8_LDA
#undef PG8_LDB
#undef PG8_MMA
#undef PG8_WAIT_V
#undef PG8_WAIT_L
#undef PG8_BAR
#undef PG8_SCHED
}
}
struct Frame {
    LAS uchar* lds;
    volatile LAS unsigned* MISC;
    unsigned* ctl;
    int tid, lane, wave;
    int vcu, G;
};

constexpr int TSTR = 144;
DI void p0_transpose_item(const float* W, int K, int N, bf16* WT, LAS uchar* scr, int item, int lane, const float* kscale = nullptr) {
    const int nblk = N / 64, kb = item / nblk, nb = item % nblk, k0 = 64 * kb, n0 = 64 * nb;
    const int q = lane >> 4, c16 = lane & 15;
    f32x4 v[16];
#pragma unroll
    for (int i = 0; i < 16; ++i) v[i] = *(const f32x4*)(W + (size_t)(k0 + 16 * q + i) * N + n0 + 4 * c16);
    if (kscale) {
#pragma unroll
        for (int i = 0; i < 16; ++i) v[i] = v[i] * kscale[k0 + 16 * q + i]; }
#pragma unroll
    for (int j = 0; j < 4; ++j) { u32x4 lo, hi;
        lo.x = pk2(v[0][j], v[1][j]); lo.y = pk2(v[2][j], v[3][j]); lo.z = pk2(v[4][j], v[5][j]); lo.w = pk2(v[6][j], v[7][j]);
        hi.x = pk2(v[8][j], v[9][j]); hi.y = pk2(v[10][j], v[11][j]); hi.z = pk2(v[12][j], v[13][j]); hi.w = pk2(v[14][j], v[15][j]);
        LAS uchar* p = scr + (4 * c16 + j) * TSTR + q * 32; *(LAS u32x4*)p = lo; *(LAS u32x4*)(p + 16) = hi; }
    asm volatile("s_waitcnt lgkmcnt(0)" ::: "memory");
    const int c = lane & 7, nr = lane >> 3;
#pragma unroll
    for (int r = 0; r < 8; ++r) { const int n = nr + 8 * r;
        *(u32x4*)(WT + (size_t)(n0 + n) * K + k0 + 8 * c) = *(const LAS u32x4*)(scr + n * TSTR + c * 16); }
    asm volatile("s_waitcnt lgkmcnt(0)" ::: "memory");
}
struct CvJob { const float* e_w_out; const float* o_w_in; const float* o_w_out; const float* kscale3; const float* kscale4; bf16 *W2, *W3, *W4; };
constexpr int CV_I2 = (K2 / 64) * (D / 64), CV_I3 = (D / 64) * (N3 / 64), CV_I4 = (K4 / 64) * (D / 64), CV_NIT = CV_I2 + CV_I3 + CV_I4;
DI void cv_decode(const CvJob& j, int idx, const float*& W, int& K, int& N, bf16*& WT, const float*& ks, int& item) {
    if (idx < CV_I2) { W = j.e_w_out; K = K2; N = D; WT = j.W2; ks = nullptr; item = idx; }
    else if (idx < CV_I2 + CV_I3) { W = j.o_w_in; K = D; N = N3; WT = j.W3; ks = j.kscale3; item = idx - CV_I2; }
    else { W = j.o_w_out; K = K4; N = D; WT = j.W4; ks = j.kscale4; item = idx - CV_I2 - CV_I3; }
}
DI void cv_issue(const CvJob& j, int idx, int lane, f32x4 (&v)[16]) {
    const float* W; int K, N, item; bf16* WT; const float* ks; cv_decode(j, idx, W, K, N, WT, ks, item);
    const int nblk = N / 64, kb = item / nblk, nb = item % nblk, k0 = 64 * kb, n0 = 64 * nb, q = lane >> 4, c16 = lane & 15;
#pragma unroll
    for (int i = 0; i < 16; ++i) v[i] = *(const f32x4*)(W + (size_t)(k0 + 16 * q + i) * N + n0 + 4 * c16);
}
DI void cv_finish(const CvJob& j, int idx, int lane, const f32x4 (&vin)[16], LAS uchar* scr) {
    const float* W; int K, N, item; bf16* WT; const float* ks; cv_decode(j, idx, W, K, N, WT, ks, item);
    const int nblk = N / 64, kb = item / nblk, nb = item % nblk, k0 = 64 * kb, n0 = 64 * nb, q = lane >> 4, c16 = lane & 15;
    f32x4 v[16], kv[4];
    if (ks) {
#pragma unroll
        for (int i = 0; i < 4; ++i) kv[i] = *(const f32x4*)(ks + k0 + 16 * q + 4 * i); }
    else {
#pragma unroll
        for (int i = 0; i < 4; ++i) kv[i] = (f32x4){1.f, 1.f, 1.f, 1.f}; }
#pragma unroll
    for (int i = 0; i < 16; ++i) v[i] = vin[i] * kv[i >> 2][i & 3];
#pragma unroll
    for (int jj = 0; jj < 4; ++jj) { u32x4 lo, hi;
        lo.x = pk2(v[0][jj], v[1][jj]); lo.y = pk2(v[2][jj], v[3][jj]); lo.z = pk2(v[4][jj], v[5][jj]); lo.w = pk2(v[6][jj], v[7][jj]);
        hi.x = pk2(v[8][jj], v[9][jj]); hi.y = pk2(v[10][jj], v[11][jj]); hi.z = pk2(v[12][jj], v[13][jj]); hi.w = pk2(v[14][jj], v[15][jj]);
        LAS uchar* p = scr + (4 * c16 + jj) * TSTR + q * 32; *(LAS u32x4*)p = lo; *(LAS u32x4*)(p + 16) = hi; }
    asm volatile("s_waitcnt lgkmcnt(0)" ::: "memory");
    const int c = lane & 7, nr = lane >> 3;
#pragma unroll
    for (int r = 0; r < 8; ++r) { const int n = nr + 8 * r;
        *(u32x4*)(WT + (size_t)(n0 + n) * K + k0 + 8 * c) = *(const LAS u32x4*)(scr + n * TSTR + c * 16); }
    asm volatile("s_waitcnt lgkmcnt(0)" ::: "memory");
}
DI void rms_row_to_bf16(const float* xrow, const float* w, bf16* orow, int lane) {
    const f32x4* xr = (const f32x4*)xrow + lane; const f32x4* wr = (const f32x4*)w + lane;
    f32x4 v[16]; float s = 0.f;
#pragma unroll
    for (int j = 0; j < 16; ++j) { v[j] = xr[64 * j]; s += (v[j].x * v[j].x + v[j].y * v[j].y) + (v[j].z * v[j].z + v[j].w * v[j].w); }
    const float rstd = __builtin_amdgcn_rsqf(wave_sum(s) * (1.f / 4096.f) + EPS);
    u32x2* o8 = (u32x2*)orow + lane;
#pragma unroll
    for (int j = 0; j < 16; ++j) { const f32x4 ww = wr[64 * j]; u32x2 p; p.x = pk2(v[j].x * rstd * ww.x, v[j].y * rstd * ww.y); p.y = pk2(v[j].z * rstd * ww.z, v[j].w * rstd * ww.w); o8[64 * j] = p; }
}
struct P0Args { const float* x; const float* norm_w; const float* e_w_in; const float* e_w_out; const float* o_w_in; const float* o_w_out; bf16 *W1, *W2, *W3, *W4, *HN; };
DI void p0_prologue(Frame& F, const P0Args& a) {
    LAS uchar* scr = F.lds + F.wave * 16384;
    const int gw = F.vcu * 8 + F.wave, NGW = F.G * 8;
    constexpr int I1 = (D / 64) * (N1 / 64);
    for (int it = gw; it < I1; it += NGW) p0_transpose_item(a.e_w_in, D, N1, a.W1, scr, it, F.lane);
    { u32x4* z = (u32x4*)(a.W3 + (size_t)N3 * D); const int nz = (N3P - N3) * D / 8; const u32x4 zero = {0u, 0u, 0u, 0u};
      for (int i = gw * 64 + F.lane; i < nz; i += NGW * 64) z[i] = zero; }
    for (int m = gw; m < M; m += NGW) rms_row_to_bf16(a.x + (size_t)m * D, a.norm_w, a.HN + (size_t)m * D, F.lane);
}
DI void p7_final(Frame& F, const bf16* in, float* out, const float* ssq, const float* fw) {
    const int gw = F.vcu * 8 + F.wave, NGW = F.G * 8;
    for (int m = gw; m < M; m += NGW) {
        const float rstd = __builtin_amdgcn_rsqf(ssq[m] * (1.f / 4096.f) + EPS);
        const u32x4* xr = (const u32x4*)(in + (size_t)m * D) + F.lane; f32x4* orow = (f32x4*)(out + (size_t)m * D) + 2 * F.lane; const f32x4* wr = (const f32x4*)fw + 2 * F.lane;
#pragma unroll
        for (int j = 0; j < 8; ++j) { const u32x4 w = xr[64 * j]; const f32x4 w0 = wr[128 * j], w1 = wr[128 * j + 1];
            orow[128 * j] = (f32x4){bflo(w.x), bfhi(w.x), bflo(w.y), bfhi(w.y)} * rstd * w0;
            orow[128 * j + 1] = (f32x4){bflo(w.z), bfhi(w.z), bflo(w.w), bfhi(w.w)} * rstd * w1; }
    }
}
template <int KSTEPS> DI f32x4 mma_tile(f32x4 acc, const LAS uchar* P, int sp, int p0, const LAS uchar* Q, int sq, int q0, int fr, int fq) {
    bf16x8 a[KSTEPS], b[KSTEPS];
#pragma unroll
    for (int ks = 0; ks < KSTEPS; ++ks) { a[ks] = *(const LAS bf16x8*)(P + (p0 + fr) * sp + ks * 64 + fq * 16); b[ks] = *(const LAS bf16x8*)(Q + (q0 + fr) * sq + ks * 64 + fq * 16); }
#pragma unroll
    for (int ks = 0; ks < KSTEPS; ++ks) acc = __builtin_amdgcn_mfma_f32_16x16x32_bf16(a[ks], b[ks], acc, 0, 0, 0);
    return acc;
}
constexpr int S128 = 288, S64 = 160;

struct Mix0Args { bf16* proj; const float* lb_logits; const float* a_norm_w; const float* conv_w; const float* conv_b; const float* wa; const float* ba; const float* wx; const float* bx; const float* lam; float* ssq_a; bf16* outp; int out_ld, oa_col, ob_col;
                  bf16* Pg; bf16* KSTg; float* GLg; int dummy; CvJob cv; bf16* Qg; float* EREFg; };

DI void hgrn2_prep_all(Frame& F, const Mix0Args& a) {
    const int tid = F.tid, w = F.wave, lane = F.lane, fr = lane & 15, fq = lane >> 4;
    constexpr int PIMG = 2 * 64 * S128 + 128 * S64 + 4096;
    const int c2 = tid & 63, rg = tid >> 6;
    unsigned qr[8], fr_[8];
#define HP_LOAD(U_) do { const int h_ = (U_) & 31, n_ = ((U_) >> 5) & 127, b_ = (U_) >> 12; const size_t r_ = (size_t)b_ * SEQ + (size_t)n_ * 64 + 8 * rg; \
        _Pragma("unroll") for (int i = 0; i < 8; ++i) { qr[i] = *(const unsigned*)(a.proj + C_Q + h_ * 128 + 2 * c2 + (r_ + i) * N1); fr_[i] = *(const unsigned*)(a.proj + C_F + h_ * 128 + 2 * c2 + (r_ + i) * N1); } } while (0)
    if (F.vcu < 8192) HP_LOAD(F.vcu);
    float lb[2] = {0.f, 0.f}, oml[2] = {1.f, 1.f}; int h_prev = -1;
    int par = 0;
    for (int U = F.vcu; U < 8192; U += F.G, par ^= 1) {
    const int h = U & 31, n = (U >> 5) & 127, b = U >> 12;
    LAS uchar* QIN = F.lds + par * PIMG; LAS uchar* KIN = QIN + 64 * S128; LAS uchar* KST = KIN + 64 * S128; LAS float* TOT = (LAS float*)(KST + 128 * S64);
    if (h != h_prev) {
#pragma unroll
        for (int j = 0; j < 2; ++j) { const int col = h * 128 + 2 * c2 + j; const float l0 = a.lb_logits[col], l1 = a.lb_logits[4096 + col], l2 = a.lb_logits[8192 + col];
            const float mx = fmaxf(l0, fmaxf(l1, l2)); const float e0 = __expf(l0 - mx), e1 = __expf(l1 - mx), e2 = __expf(l2 - mx); lb[j] = e0 / (e0 + e1 + e2); oml[j] = 1.0f - lb[j]; }
        h_prev = h; }
    const size_t row0 = (size_t)b * SEQ + (size_t)n * 64;
    bf16* qcol = a.proj + C_Q + h * 128 + 2 * c2;
    unsigned qc[8], fc[8];
#pragma unroll
    for (int i = 0; i < 8; ++i) { qc[i] = qr[i]; fc[i] = fr_[i]; }
    if (U + F.G < 8192) HP_LOAD(U + F.G);
    float cum[2] = {0.f, 0.f}, cumv[8][2], kkv[8][2];
#pragma unroll
    for (int i = 0; i < 8; ++i)
#pragma unroll
        for (int j = 0; j < 2; ++j) { const float z = j ? bfhi(fc[i]) : bflo(fc[i]); const float e = fexp2(-LOG2E * z), sg = frcp(1.0f + e);
            const float fg = lb[j] + oml[j] * sg; cum[j] += flog2(fg); cumv[i][j] = cum[j]; kkv[i][j] = oml[j] * (1.0f - sg); }
    *(LAS f32x2*)(TOT + rg * 128 + 2 * c2) = (f32x2){cum[0], cum[1]};
    LDS_BAR();
    float off[2] = {0.f, 0.f}, ref[2] = {0.f, 0.f}, bl[2] = {0.f, 0.f};
#pragma unroll
    for (int g = 0; g < 8; ++g) { const f32x2 t = *(const LAS f32x2*)(TOT + g * 128 + 2 * c2);
        if (g < rg) { off[0] += t.x; off[1] += t.y; } if (g < 4) { ref[0] += t.x; ref[1] += t.y; } bl[0] += t.x; bl[1] += t.y; }
    float eref[2], ebl[2];
#pragma unroll
    for (int j = 0; j < 2; ++j) { eref[j] = fexp2(ref[j]); ebl[j] = fexp2(bl[j] - ref[j]); }
    const size_t T = ((size_t)(b * 32 + h)) * 128 + n;
    if (rg == 0) { *(f32x2*)(a.GLg + T * 128 + 2 * c2) = (f32x2){fexp2(bl[0]), fexp2(bl[1])}; *(f32x2*)(a.EREFg + T * 128 + 2 * c2) = (f32x2){eref[0], eref[1]}; }
    float ksv[2][8];
#pragma unroll
    for (int i = 0; i < 8; ++i) { float qi[2], ki[2];
#pragma unroll
        for (int j = 0; j < 2; ++j) { const float q = j ? bfhi(qc[i]) : bflo(qc[i]); const float qs = fsilu(q);
            const float e1 = fexp2(off[j] + cumv[i][j] - ref[j]), e2 = frcp(e1);
            qi[j] = qs * e1; ki[j] = kkv[i][j] * e2; ksv[j][i] = ki[j] * ebl[j]; }
        const int l = 8 * rg + i;
        *(LAS unsigned*)(QIN + l * S128 + c2 * 4) = pk2(qi[0], qi[1]);
        *(LAS unsigned*)(KIN + l * S128 + c2 * 4) = pk2(ki[0], ki[1]);
        }
#pragma unroll
    for (int j = 0; j < 2; ++j) { u32x4 p; p.x = pk2(ksv[j][0], ksv[j][1]); p.y = pk2(ksv[j][2], ksv[j][3]); p.z = pk2(ksv[j][4], ksv[j][5]); p.w = pk2(ksv[j][6], ksv[j][7]);
        *(LAS u32x4*)(KST + (2 * c2 + j) * S64 + rg * 16) = p; }
    LDS_BAR();
#pragma unroll
    for (int i = 0; i < 2; ++i) { const int c = tid + 512 * i, ln = c & 63;
        *(u32x4*)(a.Qg + T * 8192 + (size_t)c * 8) = *(const LAS u32x4*)(QIN + (16 * (c >> 8) + (ln & 15)) * S128 + ((c >> 6) & 3) * 64 + (ln >> 4) * 16);
        *(u32x4*)(a.KSTg + T * 8192 + (size_t)c * 8) = *(const LAS u32x4*)(KST + (16 * (c >> 7) + (ln & 15)) * S64 + ((c >> 6) & 1) * 64 + (ln >> 4) * 16); }
    { const int l0_ = 16 * (w & 3);
#pragma unroll
      for (int t = 0; t < 2; ++t) { const int s0 = 16 * ((w >> 2) * 2 + t);
          f32x4 sc = (f32x4){0.f, 0.f, 0.f, 0.f};
          if (s0 <= l0_ + 15) sc = mma_tile<4>(sc, KIN, S128, s0, QIN, S128, l0_, fr, fq);
          const int l = l0_ + fr, s = s0 + 4 * fq;
          u32x2 p; p.x = pk2(s <= l ? sc[0] : 0.f, s + 1 <= l ? sc[1] : 0.f); p.y = pk2(s + 2 <= l ? sc[2] : 0.f, s + 3 <= l ? sc[3] : 0.f);
          *(u32x2*)((char*)(a.Pg + T * 4096) + ((((w & 3) * 2 + (w >> 2)) * 64 + (2 * t + (fq >> 1)) * 16 + fr) * 16 + 8 * (fq & 1))) = p; } }
    }
#undef HP_LOAD
    LDS_BAR();
}

struct HgEa { unsigned v[4]; f32x4 er; };
struct HgOp { bf16x8 qf[4], pf[2], kf[2]; f32x4 g4; u32x2 ga; };
DI void hgrn2_scan_unit(Frame& F, const Mix0Args& a, int u) {
    const int tid = F.tid, w = F.wave, lane = F.lane, fr = lane & 15, fq = lane >> 4;
    const int b = u >> 7, h = (u >> 2) & 31, vs = u & 3;
    constexpr int VIMG = 32 * S64;
    LAS uchar* VT0 = F.lds; LAS uchar* STB0 = VT0 + 2 * VIMG;
    const int ltile = w & 3, jtile = w >> 2, l0_ = 16 * ltile, v0_ = 16 * jtile;
    const f32x4 anw = *(const f32x4*)(a.a_norm_w + h * 128 + vs * 32 + v0_ + 4 * fq);
    const int vv = tid & 31, lg = tid >> 5;
    for (int i = tid; i < 32 * S128 / 16; i += 512) ((LAS u32x4*)STB0)[i] = (u32x4){0u, 0u, 0u, 0u};
    f32x4 st[2] = {(f32x4){0.f, 0.f, 0.f, 0.f}, (f32x4){0.f, 0.f, 0.f, 0.f}};
    const size_t rowbase = (size_t)b * SEQ; const size_t Tb = ((size_t)(b * 32 + h)) * 128;
    const unsigned voq = (unsigned)((ltile * 256 + lane) * 16), vop = (unsigned)((ltile * 128 + lane) * 16), vok = (unsigned)((w * 128 + lane) * 16), vog = (unsigned)((16 * w + 4 * fq) * 4);
    unsigned vov[4];
#pragma unroll
    for (int i = 0; i < 4; ++i) vov[i] = (unsigned)((4 * lg + i) * N1 + C_I + h * 128 + vs * 32 + vv) * 2u;
    const unsigned voga = (unsigned)((l0_ + fr) * N1 + C_GA + h * 128 + vs * 32 + v0_ + 4 * fq) * 2u;
    const unsigned voo = (unsigned)((l0_ + fr) * a.out_ld + a.oa_col + h * 128 + vs * 32 + v0_ + 4 * fq) * 2u, vos = (unsigned)(l0_ + fr) * 4u;
    const char* const pQ = (const char*)a.Qg; const char* const pPm = (const char*)a.Pg; const char* const pK = (const char*)a.KSTg; const char* const pG = (const char*)a.GLg;
    const char* const pE = (const char*)a.EREFg; const char* const pP = (const char*)a.proj; char* const pO = (char*)a.outp; char* const pS = (char*)a.ssq_a;
    auto load_ea = [&](int n_, HgEa& r) __attribute__((always_inline)) {
        const char* uV = pP + (rowbase + (size_t)n_ * 64) * (size_t)(N1 * 2); const char* uE = pE + (Tb + n_) * 512;
#pragma unroll
        for (int i = 0; i < 4; ++i) r.v[i] = *(const unsigned short*)(uV + vov[i]);
        r.er = *(const f32x4*)(uE + vog); };
    auto load_g = [&](int n_, HgOp& r) __attribute__((always_inline)) { const char* uG = pG + (Tb + n_) * 512; const char* uGa = pP + (rowbase + (size_t)n_ * 64) * (size_t)(N1 * 2);
        r.g4 = *(const f32x4*)(uG + vog); r.ga = *(const u32x2*)(uGa + voga); };
    auto load_q = [&](int n_, HgOp& r) __attribute__((always_inline)) { const char* uQ = pQ + (Tb + n_) * 16384;
#pragma unroll
        for (int ks = 0; ks < 4; ++ks) r.qf[ks] = *(const bf16x8*)(uQ + ks * 1024 + voq); };
    auto load_pk = [&](int n_, HgOp& r) __attribute__((always_inline)) { const char* uPm = pPm + (Tb + n_) * 8192; const char* uK = pK + (Tb + n_) * 16384;
#pragma unroll
        for (int ks = 0; ks < 2; ++ks) { r.pf[ks] = *(const bf16x8*)(uPm + ks * 1024 + vop); r.kf[ks] = *(const bf16x8*)(uK + ks * 1024 + vok); } };
    auto load_op = [&](int n_, HgOp& r) __attribute__((always_inline)) { load_g(n_, r); load_q(n_, r); load_pk(n_, r); };
    u32x2 p_d = {0u, 0u}; float ss_d = 0.f;
    auto put = [&](int n_) __attribute__((always_inline)) {
        const size_t r0_ = rowbase + (size_t)n_ * 64;
        if (fq == 0) unsafeAtomicAdd((float*)(pS + r0_ * 4 + vos), ss_d);
        *(u32x2*)(pO + r0_ * (size_t)(a.out_ld * 2) + voo) = p_d; };
    auto stage = [&](const HgEa& e, LAS uchar* VT) __attribute__((always_inline)) {
        u32x2 p_; p_.x = e.v[0] | (e.v[1] << 16); p_.y = e.v[2] | (e.v[3] << 16); *(LAS u32x2*)(VT + vv * S64 + lg * 8) = p_; };
    bf16x8 v2[2][2]; f32x4 oacc;
    auto compute_o = [&](int n, const HgOp& o, LAS uchar* VTc) __attribute__((always_inline)) {
        LAS uchar* STBc = STB0 + (n & 1) * 32 * S128;
        bf16x8 sf[4];
#pragma unroll
        for (int ks = 0; ks < 4; ++ks) sf[ks] = *(const LAS bf16x8*)(STBc + (v0_ + fr) * S128 + ks * 64 + fq * 16);
#pragma unroll
        for (int ks = 0; ks < 2; ++ks) {
#pragma unroll
            for (int vt = 0; vt < 2; ++vt) v2[vt][ks] = *(const LAS bf16x8*)(VTc + (16 * vt + fr) * S64 + ks * 64 + fq * 16); }
        oacc = (f32x4){0.f, 0.f, 0.f, 0.f};
#pragma unroll
        for (int ks = 0; ks < 4; ++ks) oacc = __builtin_amdgcn_mfma_f32_16x16x32_bf16(sf[ks], o.qf[ks], oacc, 0, 0, 0); };
    auto compute_s = [&](int n, const HgOp& o, const f32x4 er_next) __attribute__((always_inline)) {
        LAS uchar* STBn = STB0 + ((n + 1) & 1) * 32 * S128;
#pragma unroll
        for (int ks = 0; ks < 2; ++ks) oacc = __builtin_amdgcn_mfma_f32_16x16x32_bf16(jtile ? v2[1][ks] : v2[0][ks], o.pf[ks], oacc, 0, 0, 0);
#pragma unroll
        for (int vt = 0; vt < 2; ++vt) { st[vt] = st[vt] * o.g4;
#pragma unroll
            for (int ks = 0; ks < 2; ++ks) st[vt] = __builtin_amdgcn_mfma_f32_16x16x32_bf16(o.kf[ks], v2[vt][ks], st[vt], 0, 0, 0);
            const f32x4 se = st[vt] * er_next;
            u32x2 p; p.x = pk2(se[0], se[1]); p.y = pk2(se[2], se[3]);
            *(LAS u32x2*)(STBn + (16 * vt + fr) * S128 + (16 * w + 4 * fq) * 2) = p; }
        const float ss = (oacc[0] * oacc[0] + oacc[1] * oacc[1]) + (oacc[2] * oacc[2] + oacc[3] * oacc[3]);
        ss_d = fq_sum(ss);
        const float g0 = bflo(o.ga.x), g1 = bfhi(o.ga.x), g2 = bflo(o.ga.y), g3 = bfhi(o.ga.y);
        p_d.x = pk2(oacc[0] * anw[0] * fsilu(g0), oacc[1] * anw[1] * fsilu(g1)); p_d.y = pk2(oacc[2] * anw[2] * fsilu(g2), oacc[3] * anw[3] * fsilu(g3)); };
    auto step = [&](int n, HgEa& ea, HgEa& eb, HgOp& oa, HgOp& ob) __attribute__((always_inline)) {
        asm volatile("" : "+v"(ea.v[0]), "+v"(ea.v[1]), "+v"(ea.v[2]), "+v"(ea.v[3]), "+v"(ea.er), "+v"(oa.g4), "+v"(oa.ga) :: "memory");
        asm volatile("" : "+v"(oa.qf[0]), "+v"(oa.qf[1]), "+v"(oa.qf[2]), "+v"(oa.qf[3]), "+v"(oa.pf[0]), "+v"(oa.pf[1]), "+v"(oa.kf[0]), "+v"(oa.kf[1]) :: "memory");
        if (n > 0) put(n - 1);
        if (n + 2 < NCH) load_ea(n + 2, eb);
        if (n + 1 < NCH) load_g(n + 1, ob);
        if (n + 1 < NCH) stage(ea, VT0 + ((n + 1) & 1) * VIMG);
        __builtin_amdgcn_sched_barrier(0);
        if (n + 1 < NCH) load_q(n + 1, ob);
        __builtin_amdgcn_sched_barrier(0);
        compute_o(n, oa, VT0 + (n & 1) * VIMG);
        __builtin_amdgcn_sched_barrier(0);
        if (n + 1 < NCH) load_pk(n + 1, ob);
        __builtin_amdgcn_sched_barrier(0);
        compute_s(n, oa, ea.er);
        LDS_BAR(); };
    HgEa e0, e1; HgOp o0, o1;
    load_ea(0, e0); load_op(0, o0);
    stage(e0, VT0);
    load_ea(1, e1);
    LDS_BAR();
    for (int n = 0; n < NCH; n += 2) { step(n, e1, e0, o0, o1); step(n + 1, e0, e1, o1, o0); }
    put(NCH - 1);
}


DI void rglru_scan_unit(Frame& F, const Mix0Args& a, int u) {
    const int tid = F.tid, w = F.wave, lane = F.lane, fr = lane & 15, fq = lane >> 4;
    const int b = u >> 7, nb = (u >> 2) & 31, qq = u & 3, cb = nb * 128;
    LAS uchar* XC0 = F.lds; LAS uchar* WAT = XC0 + 2 * 64 * S128; LAS uchar* WXT = WAT + 32 * S128;
    LAS float* SEG0 = (LAS float*)(WXT + 32 * S128); LAS float* HPREV = SEG0 + 2 * 1024;
    LAS uchar* CVS = F.lds + 65536 + w * 9216;
    const int gw = F.vcu * 8 + w, NGW = F.G * 8; const bool cv_on = (u == F.vcu);
    f32x4 cvv[16];
#pragma unroll
    for (int i = 0; i < 16; ++i) cvv[i] = (f32x4){0.f, 0.f, 0.f, 0.f};
    { const int j = tid & 31, kg = tid >> 5; float wv[8], xv[8];
#pragma unroll
      for (int i = 0; i < 8; ++i) { const size_t o = ((size_t)(nb * 128 + 8 * kg + i)) * 128 + qq * 32 + j; wv[i] = a.wa[o]; xv[i] = a.wx[o]; }
      u32x4 p; p.x = pk2(wv[0], wv[1]); p.y = pk2(wv[2], wv[3]); p.z = pk2(wv[4], wv[5]); p.w = pk2(wv[6], wv[7]); *(LAS u32x4*)(WAT + j * S128 + kg * 16) = p;
      p.x = pk2(xv[0], xv[1]); p.y = pk2(xv[2], xv[3]); p.z = pk2(xv[4], xv[5]); p.w = pk2(xv[6], xv[7]); *(LAS u32x4*)(WXT + j * S128 + kg * 16) = p; }
    if (tid < 64) HPREV[tid] = 0.f;
    const int c2 = tid & 63, rg = tid >> 6;
    float cw[4][2], cbs[2];
#pragma unroll
    for (int j = 0; j < 2; ++j) { const int ch = cb + 2 * c2 + j; cbs[j] = a.conv_b[ch];
#pragma unroll
        for (int k = 0; k < 4; ++k) cw[k][j] = a.conv_w[k * 4096 + ch]; }
    const int ltile = w & 3, jtile = w >> 2, l0_ = 16 * ltile, jj = 16 * jtile + fr, co = cb + qq * 32 + jj;
    const float bav = a.ba[co], bxv = a.bx[co], sp8l2 = 8.0f * LOG2E * log1pf(__expf(-a.lam[co]));
    const size_t rowbase = (size_t)b * SEQ;
    const bf16* xcol = a.proj + C_XB + cb + 2 * c2;
    const bf16* gbcol = a.proj + C_GB + co; bf16* obcol = a.outp + a.ob_col + co;
    unsigned xr[11], gbr[4];
#define RG_LOAD(n_) do { const long r0_ = (long)rowbase + (long)(n_) * 64; \
        _Pragma("unroll") for (int i = 0; i < 11; ++i) xr[i] = ((n_) == 0 && 8 * rg - 3 + i < 0) ? 0u : *(const unsigned*)(xcol + (size_t)(r0_ + 8 * rg - 3 + i) * N1); \
        _Pragma("unroll") for (int i = 0; i < 4; ++i) gbr[i] = *(const unsigned short*)(gbcol + (size_t)(r0_ + l0_ + 4 * fq + i) * N1); } while (0)
#define RG_STAGE(xc_) do { LAS uchar* X_ = (xc_); \
        _Pragma("unroll") for (int i = 0; i < 8; ++i) { f32x2 s2 = (f32x2){cbs[0], cbs[1]}; \
            _Pragma("unroll") for (int k = 0; k < 4; ++k) s2 += (f32x2){cw[k][0], cw[k][1]} * (f32x2){bflo(xr[i + k]), bfhi(xr[i + k])}; \
            *(LAS unsigned*)(X_ + (8 * rg + i) * S128 + c2 * 4) = pk2(s2.x, s2.y); } } while (0)
    RG_LOAD(0);
    RG_STAGE(XC0);
    unsigned gb_cur[4];
#pragma unroll
    for (int i = 0; i < 4; ++i) gb_cur[i] = gbr[i];
    RG_LOAD(1);
    LDS_BAR();
    for (int n = 0; n < NCH; ++n) {
        const size_t row0 = rowbase + (size_t)n * 64;
        LAS uchar* XCc = XC0 + (n & 1) * 64 * S128; LAS uchar* XCn = XC0 + ((n + 1) & 1) * 64 * S128;
        LAS float* SEGA = SEG0 + (n & 1) * 1024; LAS float* SEGH = SEGA + 512;
        unsigned gb_next[4];
#pragma unroll
        for (int i = 0; i < 4; ++i) gb_next[i] = gbr[i];
        if (n + 1 < NCH) RG_STAGE(XCn);
        if (n + 2 < NCH) RG_LOAD(n + 2);
        if (cv_on && (n & 3) == 0) { const int idx = (n >> 2) * NGW + gw; if (idx < CV_NIT) cv_issue(a.cv, idx, lane, cvv); }
        const f32x4 zero4 = (f32x4){0.f, 0.f, 0.f, 0.f};
        float av[4], uv[4]; float Aseg = 1.f, Hseg = 0.f;
        { bf16x8 xf[4], waf[4], wxf[4]; unsigned xcr[4];
#pragma unroll
          for (int ks = 0; ks < 4; ++ks) { xf[ks] = *(const LAS bf16x8*)(XCc + (l0_ + fr) * S128 + ks * 64 + fq * 16);
              waf[ks] = *(const LAS bf16x8*)(WAT + (16 * jtile + fr) * S128 + ks * 64 + fq * 16); wxf[ks] = *(const LAS bf16x8*)(WXT + (16 * jtile + fr) * S128 + ks * 64 + fq * 16); }
#pragma unroll
          for (int r = 0; r < 4; ++r) xcr[r] = *(const LAS unsigned short*)(XCc + (l0_ + 4 * fq + r) * S128 + (qq * 32 + jj) * 2);
          f32x4 R = zero4, I = zero4;
#pragma unroll
          for (int ks = 0; ks < 4; ++ks) { R = __builtin_amdgcn_mfma_f32_16x16x32_bf16(xf[ks], waf[ks], R, 0, 0, 0); I = __builtin_amdgcn_mfma_f32_16x16x32_bf16(xf[ks], wxf[ks], I, 0, 0, 0); }
#pragma unroll
          for (int r = 0; r < 4; ++r) {
              const float rr = fsigmoid(R[r] + bav), ig = fsigmoid(I[r] + bxv);
              const float aa = fexp2(-sp8l2 * rr); const float om = __builtin_fmaf(-aa, aa, 1.0f);
              av[r] = aa; uv[r] = __builtin_sqrtf(om) * (ig * bf2f(xcr[r]));
              Hseg = aa * Hseg + uv[r]; Aseg *= aa; } }
        const int sgi = ltile * 4 + fq;
        SEGA[sgi * 32 + jj] = Aseg; SEGH[sgi * 32 + jj] = Hseg;
        LDS_BAR();
        float carry = HPREV[(n & 1) * 32 + jj]; float sa[15], sh[15];
#pragma unroll
        for (int s = 0; s < 15; ++s) { sa[s] = SEGA[s * 32 + jj]; sh[s] = SEGH[s * 32 + jj]; }
#pragma unroll
        for (int s = 0; s < 15; ++s) carry = (s < sgi) ? sa[s] * carry + sh[s] : carry;
#pragma unroll
        for (int r = 0; r < 4; ++r) { carry = av[r] * carry + uv[r];
            const float o = carry * fsilu(bf2f(gb_cur[r]));
            obcol[(row0 + l0_ + 4 * fq + r) * a.out_ld] = (bf16)(pk2(o, 0.f) & 0xffffu); }
        if (sgi == 15) HPREV[((n + 1) & 1) * 32 + jj] = carry;
#pragma unroll
        for (int i = 0; i < 4; ++i) gb_cur[i] = gb_next[i];
        if (cv_on && (n & 3) == 2) { const int idx = (n >> 2) * NGW + gw; if (idx < CV_NIT) cv_finish(a.cv, idx, lane, cvv, CVS); }
    }
    if (cv_on) for (int sl = NCH / 4; sl * NGW + gw < CV_NIT; ++sl) { cv_issue(a.cv, sl * NGW + gw, lane, cvv); cv_finish(a.cv, sl * NGW + gw, lane, cvv, CVS); }
#undef RG_LOAD
#undef RG_STAGE
    LDS_BAR();
}
struct Mix1Args { bf16* proj; const float* conv_w; const float* conv_b; const float* dt_bias; const float* a_log; const float* d_skip; const float* norm_w; float* ssq_y; bf16* outp; int out_ld, o_col;
                  bf16* Cg; bf16* BTg; bf16* CBg; float* TABg; int var; const float* dtp; };
constexpr int SX = 144;

DI void ssd_prep_unit(Frame& F, const Mix1Args& a, int U) {
    const int tid = F.tid, w = F.wave, lane = F.lane, fr = lane & 15, fq = lane >> 4;
    const int g = U & 7, n = (U >> 3) & 127, b = U >> 10;
    LAS uchar* CC = F.lds; LAS uchar* BC = CC + 64 * S128; LAS uchar* BT = BC + 64 * S128;
    const int c2 = tid & 63, rg = tid >> 6;
    float bw[4][2], bb[2], cw[4][2], cbs[2];
#pragma unroll
    for (int j = 0; j < 2; ++j) { const int chb = 8192 + g * 128 + 2 * c2 + j, chc = 9216 + g * 128 + 2 * c2 + j;
        bb[j] = a.conv_b[chb]; cbs[j] = a.conv_b[chc];
#pragma unroll
        for (int k = 0; k < 4; ++k) { bw[k][j] = a.conv_w[k * 10240 + chb]; cw[k][j] = a.conv_w[k * 10240 + chc]; } }
    const long r0 = (long)b * SEQ + (long)n * 64 + 8 * rg - 3;
    const bf16* bcol = a.proj + C_B + g * 128 + 2 * c2;
    const bf16* ccol = a.proj + C_C + g * 128 + 2 * c2;
    unsigned bc[11], cc[11];
#pragma unroll
    for (int i = 0; i < 11; ++i) { const bool zz = (n == 0 && 8 * rg - 3 + i < 0);
        bc[i] = zz ? 0u : *(const unsigned*)(bcol + (size_t)(r0 + i) * N3P); cc[i] = zz ? 0u : *(const unsigned*)(ccol + (size_t)(r0 + i) * N3P); }
    { float bt[2][8];
#pragma unroll
      for (int i = 0; i < 8; ++i) { float vb[2], vc[2];
#pragma unroll
          for (int j = 0; j < 2; ++j) { float sb = bb[j], sc = cbs[j];
#pragma unroll
              for (int k = 0; k < 4; ++k) { sb += bw[k][j] * (j ? bfhi(bc[i + k]) : bflo(bc[i + k])); sc += cw[k][j] * (j ? bfhi(cc[i + k]) : bflo(cc[i + k])); }
              vb[j] = fsilu(sb); vc[j] = fsilu(sc); bt[j][i] = vb[j]; }
          *(LAS unsigned*)(BC + (8 * rg + i) * S128 + c2 * 4) = pk2(vb[0], vb[1]);
          *(LAS unsigned*)(CC + (8 * rg + i) * S128 + c2 * 4) = pk2(vc[0], vc[1]); }
#pragma unroll
      for (int j = 0; j < 2; ++j) { u32x4 p; p.x = pk2(bt[j][0], bt[j][1]); p.y = pk2(bt[j][2], bt[j][3]); p.z = pk2(bt[j][4], bt[j][5]); p.w = pk2(bt[j][6], bt[j][7]);
          *(LAS u32x4*)(BT + (2 * c2 + j) * S64 + rg * 16) = p; } }
    LDS_BAR();
    const size_t T = ((size_t)(b * 128 + n)) * 8 + g;
#pragma unroll
    for (int i = 0; i < 2; ++i) { const int c = tid + 512 * i, ln = c & 63;
        *(u32x4*)(a.Cg + T * 8192 + (size_t)c * 8) = *(const LAS u32x4*)(CC + (16 * (c >> 8) + (ln & 15)) * S128 + ((c >> 6) & 3) * 64 + (ln >> 4) * 16);
        *(u32x4*)(a.BTg + T * 8192 + (size_t)c * 8) = *(const LAS u32x4*)(BT + (16 * (c >> 7) + (ln & 15)) * S64 + ((c >> 6) & 1) * 64 + (ln >> 4) * 16); }
    { const int l0_ = 16 * (w & 3);
#pragma unroll
      for (int t = 0; t < 2; ++t) { const int m0 = 16 * ((w >> 2) * 2 + t);
          const f32x4 cbv = mma_tile<4>((f32x4){0.f, 0.f, 0.f, 0.f}, BC, S128, m0, CC, S128, l0_, fr, fq);
          u32x2 p; p.x = pk2(cbv[0], cbv[1]); p.y = pk2(cbv[2], cbv[3]);
          *(u32x2*)(a.CBg + T * 4096 + (size_t)(l0_ + fr) * 64 + m0 + 4 * fq) = p; } }
#pragma unroll
    for (int t = 0; t < 2; ++t) { const int h = 16 * g + 2 * w + t;
        const size_t di = ((size_t)b * SEQ + (size_t)n * 64 + lane) * 128 + h; const size_t dq = (size_t)16384 * 128;
        const float xx = ((a.dtp[di] + a.dtp[di + dq]) + (a.dtp[di + 2 * dq] + a.dtp[di + 3 * dq])) + a.dt_bias[h];
        const float dtv = xx > 20.f ? xx : log1pf(__expf(xx)); float cs = dtv * (-__expf(a.a_log[h]) * LOG2E);
#pragma unroll
        for (int o = 1; o < 64; o <<= 1) { const float tt = __shfl_up(cs, o); if (lane >= o) cs += tt; }
        float* tp = a.TABg + (((size_t)(b * 128 + n)) * 128 + h) * 128; tp[lane] = cs; tp[64 + lane] = dtv; }
    LDS_BAR();
}

struct SsdSt { u32x4 cb; unsigned x[7]; float tb[2]; };
struct SsdOp { bf16x8 cf[4], bf[2]; u32x2 z[2]; };
DI void ssd_unit(Frame& F, const Mix1Args& a, int u) {
    const int tid = F.tid, w = F.wave, lane = F.lane, fr = lane & 15, fq = lane >> 4;
    const int b = u >> 7, h = u & 127, g = h >> 4;
    constexpr int O_XDT = 0, O_XDS = 64 * S64, O_MM = 2 * 64 * S64, IMG = 3 * 64 * S64;
    LAS uchar* IMG0 = F.lds; LAS uchar* SB0 = IMG0 + 2 * IMG; LAS float* TAB = (LAS float*)(SB0 + 2 * 64 * S128) + w * 128;
    const int c2x = tid & 31, rg4 = tid >> 5;
    float xw[4][2], xb[2];
#pragma unroll
    for (int j = 0; j < 2; ++j) { const int chx = h * 64 + 2 * c2x + j; xb[j] = a.conv_b[chx];
#pragma unroll
        for (int k = 0; k < 4; ++k) xw[k][j] = a.conv_w[k * 10240 + chx]; }
    const float Dh = a.d_skip[h];
    const int ltile = w & 3, l0_ = 16 * ltile, ph = (w >> 2) * 2;
    const size_t rowbase = (size_t)b * SEQ;
    const unsigned vo16 = (unsigned)tid * 16u, vot = (unsigned)lane * 4u;
    const unsigned voc = (unsigned)((ltile * 256 + lane) * 16), vob = (unsigned)((w * 128 + lane) * 16);
    unsigned vox[7];
#pragma unroll
    for (int i = 0; i < 7; ++i) vox[i] = (unsigned)((4 * rg4 + i) * N3P + C_X + h * 64 + 2 * c2x) * 2u;
    const unsigned voz = (unsigned)((l0_ + fr) * N3P + C_Z + h * 64 + 16 * ph + 4 * fq) * 2u;
    const unsigned voo = (unsigned)((l0_ + fr) * a.out_ld + a.o_col + h * 64 + 16 * ph + 4 * fq) * 2u, vos = (unsigned)(l0_ + fr) * 4u;
    const char* const pC = (const char*)a.Cg; const char* const pB = (const char*)a.BTg; const char* const pCB = (const char*)a.CBg;
    const char* const pP = (const char*)a.proj; const char* const pT = (const char*)a.TABg; char* const pO = (char*)a.outp; char* const pS = (char*)a.ssq_y;
    for (int i = tid; i < 64 * S128 / 16; i += 512) ((LAS u32x4*)SB0)[i] = (u32x4){0u, 0u, 0u, 0u};
    f32x4 st[4];
#pragma unroll
    for (int t = 0; t < 4; ++t) st[t] = (f32x4){0.f, 0.f, 0.f, 0.f};
    auto load_st = [&](int n_, SsdSt& r) __attribute__((always_inline)) {
        const size_t T_ = ((size_t)(b * 128 + n_)) * 8 + g; const long r0_ = (long)rowbase + (long)n_ * 64;
        const char* uCB = pCB + T_ * 8192; const char* uX = pP + (r0_ - 3) * (long)(N3P * 2); const char* uT = pT + (((size_t)(b * 128 + n_)) * 128 + h) * 512;
        r.cb = *(const u32x4*)(uCB + vo16);
#pragma unroll
        for (int i = 0; i < 7; ++i) r.x[i] = (n_ == 0 && 4 * rg4 - 3 + i < 0) ? 0u : *(const unsigned*)(uX + vox[i]);
        r.tb[0] = *(const float*)(uT + vot); r.tb[1] = *(const float*)(uT + 256 + vot); };
    auto load_z = [&](int n_, SsdOp& r) __attribute__((always_inline)) { const char* uZ = pP + ((long)rowbase + (long)n_ * 64) * (long)(N3P * 2);
#pragma unroll
        for (int t = 0; t < 2; ++t) r.z[t] = *(const u32x2*)(uZ + 32 * t + voz); };
    auto load_c = [&](int n_, SsdOp& r) __attribute__((always_inline)) { const char* uC = pC + (((size_t)(b * 128 + n_)) * 8 + g) * 16384;
#pragma unroll
        for (int ks = 0; ks < 4; ++ks) r.cf[ks] = *(const bf16x8*)(uC + ks * 1024 + voc); };
    auto load_b = [&](int n_, SsdOp& r) __attribute__((always_inline)) { const char* uB = pB + (((size_t)(b * 128 + n_)) * 8 + g) * 16384;
#pragma unroll
        for (int ks = 0; ks < 2; ++ks) r.bf[ks] = *(const bf16x8*)(uB + ks * 1024 + vob); };
    auto load_op = [&](int n_, SsdOp& r) __attribute__((always_inline)) { load_z(n_, r); load_c(n_, r); load_b(n_, r); };
    u32x2 p_d[2] = {(u32x2){0u, 0u}, (u32x2){0u, 0u}}; float ss_d = 0.f;
    auto put = [&](int n_) __attribute__((always_inline)) {
        const size_t r0_ = rowbase + (size_t)n_ * 64; char* uO = pO + r0_ * (size_t)(a.out_ld * 2); char* uS = pS + r0_ * 4;
#pragma unroll
        for (int t = 0; t < 2; ++t) *(u32x2*)(uO + 32 * t + voo) = p_d[t];
        if (fq == 0) unsafeAtomicAdd((float*)(uS + vos), ss_d); };
    float el_c = 0.f, dec_c = 0.f;
    auto stage = [&](const SsdSt& c, LAS uchar* I) __attribute__((always_inline)) {
        TAB[lane] = c.tb[0]; TAB[64 + lane] = c.tb[1];
        asm volatile("s_waitcnt lgkmcnt(0)" ::: "memory");
        const float cs_last = TAB[63];
        { const int l = tid >> 3, m8 = (tid & 7) * 8; u32x4 p = (u32x4){0u, 0u, 0u, 0u}; const u32x4 cbc = c.cb;
          if (m8 <= l) { const float csl = TAB[l]; const float dsk = Dh * frcp(fmaxf(TAB[64 + l], 1e-20f)); const f32x4 ca = *(const LAS f32x4*)(TAB + m8), cb4 = *(const LAS f32x4*)(TAB + m8 + 4);
              float mv[8];
#pragma unroll
              for (int j = 0; j < 8; ++j) { const unsigned wv = j < 2 ? cbc.x : j < 4 ? cbc.y : j < 6 ? cbc.z : cbc.w; const float cbv = (j & 1) ? bfhi(wv) : bflo(wv);
                  const float csm = j < 4 ? ca[j & 3] : cb4[j & 3];
                  mv[j] = (m8 + j <= l) ? cbv * fexp2(fminf(csl - csm, 0.f)) : 0.f; if (m8 + j == l) mv[j] += dsk; }
              p.x = pk2(mv[0], mv[1]); p.y = pk2(mv[2], mv[3]); p.z = pk2(mv[4], mv[5]); p.w = pk2(mv[6], mv[7]); }
          *(LAS u32x4*)(I + O_MM + l * S64 + m8 * 2) = p; }
        { f32x2 xv[7];
#pragma unroll
          for (int i = 0; i < 7; ++i) xv[i] = (f32x2){bflo(c.x[i]), bfhi(c.x[i])};
          float xd[2][4], xs_[2][4];
#pragma unroll
          for (int i = 0; i < 4; ++i) { const int l = 4 * rg4 + i; const float dl = TAB[64 + l], sl = fexp2(cs_last - TAB[l]);
              f32x2 s2 = (f32x2){xb[0], xb[1]};
#pragma unroll
              for (int k = 0; k < 4; ++k) s2 += (f32x2){xw[k][0], xw[k][1]} * xv[i + k];
              xd[0][i] = fsilu(s2.x) * dl; xd[1][i] = fsilu(s2.y) * dl; xs_[0][i] = xd[0][i] * sl; xs_[1][i] = xd[1][i] * sl; }
#pragma unroll
          for (int j = 0; j < 2; ++j) { u32x2 p; p.x = pk2(xd[j][0], xd[j][1]); p.y = pk2(xd[j][2], xd[j][3]); *(LAS u32x2*)(I + O_XDT + (2 * c2x + j) * S64 + rg4 * 8) = p;
              p.x = pk2(xs_[j][0], xs_[j][1]); p.y = pk2(xs_[j][2], xs_[j][3]); *(LAS u32x2*)(I + O_XDS + (2 * c2x + j) * S64 + rg4 * 8) = p; } }
        el_c = fexp2(TAB[l0_ + fr]); dec_c = fexp2(cs_last); };
    f32x4 yacc[2];
    auto compute_y = [&](int n, const SsdOp& o, LAS uchar* I, float el) __attribute__((always_inline)) {
        LAS uchar* SBc = SB0 + (n & 1) * 64 * S128;
        { bf16x8 sf[2][4], mf[2], xf[2][2];
#pragma unroll
          for (int ks = 0; ks < 4; ++ks) {
#pragma unroll
              for (int t = 0; t < 2; ++t) sf[t][ks] = *(const LAS bf16x8*)(SBc + (16 * (ph + t) + fr) * S128 + ks * 64 + fq * 16); }
#pragma unroll
          for (int ks = 0; ks < 2; ++ks) { mf[ks] = *(const LAS bf16x8*)(I + O_MM + (l0_ + fr) * S64 + ks * 64 + fq * 16);
#pragma unroll
              for (int t = 0; t < 2; ++t) xf[t][ks] = *(const LAS bf16x8*)(I + O_XDT + (16 * (ph + t) + fr) * S64 + ks * 64 + fq * 16); }
#pragma unroll
          for (int t = 0; t < 2; ++t) { f32x4 acc = (f32x4){0.f, 0.f, 0.f, 0.f};
#pragma unroll
              for (int ks = 0; ks < 4; ++ks) acc = __builtin_amdgcn_mfma_f32_16x16x32_bf16(sf[t][ks], o.cf[ks], acc, 0, 0, 0);
              acc = acc * el;
#pragma unroll
              for (int ks = 0; ks < 2; ++ks) acc = __builtin_amdgcn_mfma_f32_16x16x32_bf16(xf[t][ks], mf[ks], acc, 0, 0, 0);
              yacc[t] = acc; } } };
    auto compute_s = [&](int n, const SsdOp& o, LAS uchar* I, float dec) __attribute__((always_inline)) {
        LAS uchar* SBn = SB0 + ((n + 1) & 1) * 64 * S128;
        { bf16x8 xs2[4][2];
#pragma unroll
          for (int ks = 0; ks < 2; ++ks) {
#pragma unroll
              for (int t = 0; t < 4; ++t) xs2[t][ks] = *(const LAS bf16x8*)(I + O_XDS + (16 * t + fr) * S64 + ks * 64 + fq * 16); }
#pragma unroll
          for (int t = 0; t < 4; ++t) { st[t] = st[t] * dec;
#pragma unroll
              for (int ks = 0; ks < 2; ++ks) st[t] = __builtin_amdgcn_mfma_f32_16x16x32_bf16(o.bf[ks], xs2[t][ks], st[t], 0, 0, 0);
              u32x2 p; p.x = pk2(st[t][0], st[t][1]); p.y = pk2(st[t][2], st[t][3]); *(LAS u32x2*)(SBn + (16 * t + fr) * S128 + (16 * w + 4 * fq) * 2) = p; } }
        { float ss = 0.f;
#pragma unroll
          for (int t = 0; t < 2; ++t) {
              const float z0 = bflo(o.z[t].x), z1 = bfhi(o.z[t].x), z2 = bflo(o.z[t].y), z3 = bfhi(o.z[t].y);
              const float y0 = yacc[t][0] * fsilu(z0), y1 = yacc[t][1] * fsilu(z1), y2 = yacc[t][2] * fsilu(z2), y3 = yacc[t][3] * fsilu(z3);
              ss += (y0 * y0 + y1 * y1) + (y2 * y2 + y3 * y3);
              p_d[t].x = pk2(y0, y1); p_d[t].y = pk2(y2, y3); }
          ss_d = fq_sum(ss); } };
    auto step = [&](int n, SsdSt& sa, SsdSt& sb, SsdOp& oa, SsdOp& ob) __attribute__((always_inline)) {
        asm volatile("" : "+v"(sa.cb), "+v"(sa.x[0]), "+v"(sa.x[1]), "+v"(sa.x[2]), "+v"(sa.x[3]), "+v"(sa.x[4]), "+v"(sa.x[5]), "+v"(sa.x[6]), "+v"(sa.tb[0]), "+v"(sa.tb[1]) :: "memory");
        asm volatile("" : "+v"(oa.cf[0]), "+v"(oa.cf[1]), "+v"(oa.cf[2]), "+v"(oa.cf[3]), "+v"(oa.bf[0]), "+v"(oa.bf[1]), "+v"(oa.z[0]), "+v"(oa.z[1]) :: "memory");
        if (n > 0) put(n - 1);
        if (n + 2 < NCH) load_st(n + 2, sb);
        if (n + 1 < NCH) load_z(n + 1, ob);
        __builtin_amdgcn_sched_barrier(0);
        const float el = el_c, dec = dec_c;
        if (n + 1 < NCH) stage(sa, IMG0 + ((n + 1) & 1) * IMG);
        __builtin_amdgcn_sched_barrier(0);
        if (n + 1 < NCH) load_c(n + 1, ob);
        __builtin_amdgcn_sched_barrier(0);
        compute_y(n, oa, IMG0 + (n & 1) * IMG, el);
        __builtin_amdgcn_sched_barrier(0);
        if (n + 1 < NCH) load_b(n + 1, ob);
        __builtin_amdgcn_sched_barrier(0);
        compute_s(n, oa, IMG0 + (n & 1) * IMG, dec);
        LDS_BAR(); };
    SsdSt s0, s1; SsdOp o0, o1;
    load_st(0, s0); load_op(0, o0);
    stage(s0, IMG0);
    load_st(1, s1);
    LDS_BAR();
    for (int n = 0; n < NCH; n += 2) { step(n, s1, s0, o0, o1); step(n + 1, s0, s1, o1, o0); }
    put(NCH - 1);
}
#if MODE_MULTI && (NAIVE_MIX0 || NAIVE_MIX1)
__global__ void __launch_bounds__(256) naive_hgrn2(Mix0Args a) {
    __shared__ float red[8][32];
    const int u = blockIdx.x, tid = threadIdx.x, b = u >> 7, h = (u >> 2) & 31, vs = u & 3, v = tid & 31, dg = tid >> 5;
    float S[16], lb[16];
#pragma unroll
    for (int i = 0; i < 16; ++i) { S[i] = 0.f; const int col = h * 128 + dg * 16 + i; const float l0 = a.lb_logits[col], l1 = a.lb_logits[4096 + col], l2 = a.lb_logits[8192 + col];
        const float mx = fmaxf(l0, fmaxf(l1, l2)); const float e0 = expf(l0 - mx), e1 = expf(l1 - mx), e2 = expf(l2 - mx); lb[i] = e0 / (e0 + e1 + e2); }
    const float anw = a.a_norm_w[h * 128 + vs * 32 + v];
    for (int t = 0; t < SEQ; ++t) {
        bf16* row = a.proj + ((size_t)b * SEQ + t) * N1;
        const float vv = bf2f(row[C_I + h * 128 + vs * 32 + v]);
        float part = 0.f;
#pragma unroll
        for (int i = 0; i < 16; ++i) { const int d = h * 128 + dg * 16 + i; const float q = bf2f(row[C_Q + d]), z = bf2f(row[C_F + d]);
            const float sg = 1.0f / (1.0f + expf(-z)); const float fg = lb[i] + (1.0f - lb[i]) * sg; const float kk = (1.0f - lb[i]) * (1.0f - sg);
            S[i] = fg * S[i] + kk * vv; part += (q / (1.0f + expf(-q))) * S[i]; }
        red[dg][v] = part;
        __syncthreads();
        if (dg == 0) { float o = 0.f;
#pragma unroll
            for (int g = 0; g < 8; ++g) o += red[g][v];
            float ss = o * o;
#pragma unroll
            for (int off = 1; off < 32; off <<= 1) ss += __shfl_xor(ss, off);
            if (v == 0) unsafeAtomicAdd(a.ssq_a + (size_t)b * SEQ + t, ss);
            const float ga = bf2f(row[C_GA + h * 128 + vs * 32 + v]);
            row[C_I + h * 128 + vs * 32 + v] = (bf16)(pk2(o * anw * (ga / (1.0f + expf(-ga))), 0.f) & 0xffffu); }
        __syncthreads();
    }
}
__global__ void __launch_bounds__(256) naive_rglru(Mix0Args a) {
    __shared__ float xcs[128]; __shared__ float redr[8][32]; __shared__ float redi[8][32];
    const int u = blockIdx.x, tid = threadIdx.x, b = u >> 7, nb = (u >> 2) & 31, qq = u & 3, j = tid & 31, kg = tid >> 5, cb = nb * 128, co = cb + qq * 32 + j;
    float wa[16], wx[16];
#pragma unroll
    for (int i = 0; i < 16; ++i) { const size_t o = ((size_t)(nb * 128 + kg * 16 + i)) * 128 + qq * 32 + j; wa[i] = a.wa[o]; wx[i] = a.wx[o]; }
    const float bav = a.ba[co], bxv = a.bx[co], sp = log1pf(expf(-a.lam[co]));
    float hst = 0.f;
    for (int t = 0; t < SEQ; ++t) {
        const size_t rowi = (size_t)b * SEQ + t;
        if (tid < 128) { const int ch = cb + tid; float s = a.conv_b[ch];
#pragma unroll
            for (int k = 0; k < 4; ++k) { const int tt = t - 3 + k; if (tt >= 0) s += a.conv_w[k * 4096 + ch] * bf2f(a.proj[((size_t)b * SEQ + tt) * N1 + C_XB + ch]); }
            xcs[tid] = s; }
        __syncthreads();
        float pr = 0.f, pi = 0.f;
#pragma unroll
        for (int i = 0; i < 16; ++i) { const float x = xcs[kg * 16 + i]; pr += x * wa[i]; pi += x * wx[i]; }
        redr[kg][j] = pr; redi[kg][j] = pi;
        __syncthreads();
        if (kg == 0) { float R = bav, I = bxv;
#pragma unroll
            for (int g = 0; g < 8; ++g) { R += redr[g][j]; I += redi[g][j]; }
            const float r = 1.0f / (1.0f + expf(-R)), ig = 1.0f / (1.0f + expf(-I));
            const float la = -8.0f * r * sp; const float aa = expf(la); const float uu = sqrtf(-expm1f(2.0f * la)) * (ig * xcs[qq * 32 + j]);
            hst = aa * hst + uu;
            bf16* gp = a.proj + rowi * N1 + C_GB + co; const float gb = bf2f(*gp);
            *gp = (bf16)(pk2(hst * (gb / (1.0f + expf(-gb))), 0.f) & 0xffffu); }
        __syncthreads();
    }
}
__global__ void __launch_bounds__(256) naive_ssd(Mix1Args a) {
    __shared__ float xs[64]; __shared__ float red[4][32];
    const int u = blockIdx.x, tid = threadIdx.x, b = u >> 7, h = u & 127, g = h >> 4, k = tid & 127, pg = tid >> 7, wv = tid >> 6, lane = tid & 63;
    float S[32];
#pragma unroll
    for (int i = 0; i < 32; ++i) S[i] = 0.f;
    const float A = -expf(a.a_log[h]), dtb = a.dt_bias[h], Dh = a.d_skip[h];
    const int chb = 8192 + g * 128 + k, chc = 9216 + g * 128 + k;
    for (int t = 0; t < SEQ; ++t) {
        const size_t rowi = (size_t)b * SEQ + t;
        float sb = a.conv_b[chb], sc = a.conv_b[chc];
#pragma unroll
        for (int kk = 0; kk < 4; ++kk) { const int tt = t - 3 + kk; if (tt >= 0) { const bf16* r = a.proj + ((size_t)b * SEQ + tt) * N3P + C_X;
            sb += a.conv_w[kk * 10240 + chb] * bf2f(r[chb]); sc += a.conv_w[kk * 10240 + chc] * bf2f(r[chc]); } }
        const float Bv = sb / (1.0f + expf(-sb)), Cv = sc / (1.0f + expf(-sc));
        if (tid < 64) { const int chx = h * 64 + tid; float s = a.conv_b[chx];
#pragma unroll
            for (int kk = 0; kk < 4; ++kk) { const int tt = t - 3 + kk; if (tt >= 0) s += a.conv_w[kk * 10240 + chx] * bf2f(a.proj[((size_t)b * SEQ + tt) * N3P + C_X + chx]); }
            xs[tid] = s / (1.0f + expf(-s)); }
        const float xx = bf2f(a.proj[rowi * N3P + C_DT + h]) + dtb; const float dt = xx > 20.f ? xx : log1pf(expf(xx)); const float da = expf(dt * A);
        __syncthreads();
#pragma unroll
        for (int i = 0; i < 32; ++i) { S[i] = S[i] * da + dt * xs[pg * 32 + i] * Bv; float y = Cv * S[i];
#pragma unroll
            for (int off = 1; off < 64; off <<= 1) y += __shfl_xor(y, off);
            if (lane == 0) red[wv][i] = y; }
        __syncthreads();
        if (tid < 64) { const int p = tid; const float y = red[(p >> 5) * 2][p & 31] + red[(p >> 5) * 2 + 1][p & 31] + Dh * xs[p];
            bf16* zp = a.proj + rowi * N3P + C_Z + h * 64 + p; const float z = bf2f(*zp); const float yy = y * (z / (1.0f + expf(-z)));
            float ss = yy * yy;
#pragma unroll
            for (int off = 1; off < 64; off <<= 1) ss += __shfl_xor(ss, off);
            if (p == 0) unsafeAtomicAdd(a.ssq_y + rowi, ss);
            *zp = (bf16)(pk2(yy, 0.f) & 0xffffu); }
        __syncthreads();
    }
}
#endif
struct Args { const float* in[22]; float* out; unsigned char* ws; int ph_lo, ph_hi, dummy, pad; };
constexpr int NPHASE = 10;
__global__ void __launch_bounds__(512, 2) fwd(Args args) {
    extern __shared__ __attribute__((aligned(16))) unsigned char lds[];
    Frame F;
    F.lds = (LAS uchar*)lds;
    F.MISC = (volatile LAS unsigned*)(F.lds + MISC_OFF);
    F.tid = threadIdx.x; F.lane = F.tid & 63; F.wave = __builtin_amdgcn_readfirstlane(F.tid >> 6);
    F.G = gridDim.x; { const int bx = blockIdx.x; F.vcu = (F.G % 8 == 0) ? (bx % 8) * (F.G / 8) + bx / 8 : bx; }
    unsigned char* ws = args.ws;
    F.ctl = (unsigned*)(ws + WS_CTL);
    for (int u = F.tid; u < (LDS_BYTES - LDSCTL_OFF) / 4; u += 512) ((LAS unsigned*)(F.lds + LDSCTL_OFF))[u] = 0u;
    __syncthreads();
    const int lo = args.ph_lo, hi = args.ph_hi;
    XcdBarrier bar; bar.bar = F.ctl + CW_BAR; bar.x = 0; bar.st = nullptr;
    if (hi - lo > 1) bar = xcd_barrier_post(F.ctl + CW_BAR, F.MISC + 8);
#define IN(k) (lo <= (k) && (k) < hi)
#define BOTH(k) (IN(k) && IN((k) + 1))
    const float* x = args.in[0]; const float* norm_w = args.in[1];
    bf16* W1 = (bf16*)(ws + WS_W1); bf16* W2 = (bf16*)(ws + WS_W2); bf16* W3 = (bf16*)(ws + WS_W3); bf16* W4 = (bf16*)(ws + WS_W4);
    bf16* HN = (bf16*)(ws + WS_HN); bf16* PROJ = (bf16*)(ws + WS_PROJ);
    float* ssq_a = (float*)(F.ctl + CW_SSQA); float* ssq_h1 = (float*)(F.ctl + CW_SSQH1); float* ssq_y = (float*)(F.ctl + CW_SSQY); float* ssq_h2 = (float*)(F.ctl + CW_SSQH2);
    constexpr int NOJ = 1 << 30;
    const bool dmy = args.dummy != 0; float* ssq_dmy = (float*)(F.ctl + CW_DUMMY);

    if (IN(0)) { const P0Args pa{x, norm_w, args.in[2], args.in[12], args.in[13], args.in[20], W1, W2, W3, W4, HN};
        p0_prologue(F, pa); if (BOTH(0)) xcd_barrier(bar); }
    if (IN(1)) { pg8::Gemm g{HN, W1, M, N1, D, D, D, NOJ, 0, 0}; pg8::StaticOrder S; S.init(M, N1, F.G, (int)blockIdx.x);
        pg8::EpiBf16 E{PROJ, N1, nullptr};
        pg8::gemm_phase<pg8::EpiBf16, pg8::StaticOrder, true, true>(F.lds, g, S, E);
        if (BOTH(1)) xcd_barrier(bar); }
    if (IN(2) || IN(3)) { const Mix0Args ma{PROJ, args.in[3], args.in[4], args.in[5], args.in[6], args.in[7], args.in[8], args.in[9], args.in[10], args.in[11], dmy ? ssq_dmy : ssq_a,
            PROJ, N1, dmy ? C_F : C_I, dmy ? C_F : C_GB, (bf16*)(ws + WS_PG), (bf16*)(ws + WS_HN), (float*)(ws + WS_GL), dmy ? 1 : 0,
            CvJob{args.in[12], args.in[13], args.in[20], norm_w + D, args.in[19], W2, W3, W4}, (bf16*)(ws + WS_W1), (float*)(ws + WS_W1 + 128 * MiB)};
        if (IN(2)) { hgrn2_prep_all(F, ma); if (BOTH(2)) xcd_barrier(bar); }
        if (IN(3)) { for (int u = F.vcu; u < 256; u += F.G) hgrn2_scan_unit(F, ma, u);
                     for (int u = F.vcu; u < 256; u += F.G) rglru_scan_unit(F, ma, u); if (BOTH(3)) xcd_barrier(bar); } }
    if (IN(4)) { pg8::Gemm g{PROJ + C_I, W2, M, D, K2, N1, K2, 64, (long)(C_GB - C_I - 4096) * 2, 0}; pg8::StaticOrder S; S.init(M, D, F.G, (int)blockIdx.x, 4);
        pg8::EpiRes16 E{x, nullptr, HN, ssq_a, nullptr, dmy ? ssq_dmy : ssq_h1};
        pg8::gemm_phase<pg8::EpiRes16, pg8::StaticOrder, true, true>(F.lds, g, S, E);
        if (BOTH(4)) xcd_barrier(bar); }
    if (IN(5)) { { pg8::Gemm g{HN, W3, M, N3DT, D, D, D, NOJ, 0, 0}; pg8::StaticOrder S; S.init(M, N3DT, F.G, (int)blockIdx.x);
          pg8::EpiBf16 E{PROJ, N3P, ssq_h1};
          pg8::gemm_phase<pg8::EpiBf16, pg8::StaticOrder, true, true>(F.lds, g, S, E); }
        { pg8::Gemm g{HN, W3 + (size_t)N3DT * D, M, 256, 1024, D, D, NOJ, 0, 2048}; pg8::KSplitOrder S; S.init(M, F.G, (int)blockIdx.x);
          pg8::EpiDtPart E{(float*)(ws + WS_W1), ssq_h1};
          pg8::gemm_phase<pg8::EpiDtPart, pg8::KSplitOrder, true, true>(F.lds, g, S, E); }
        if (BOTH(5)) xcd_barrier(bar); }
    if (IN(6) || IN(7)) { const Mix1Args ma{PROJ, args.in[14], args.in[15], args.in[16], args.in[17], args.in[18], args.in[19], dmy ? ssq_dmy : ssq_y, dmy ? (bf16*)(ws + WS_DUMMY1) : PROJ, dmy ? 8192 : N3P, dmy ? 0 : C_Z,
            (bf16*)(ws + WS_PREP), (bf16*)(ws + WS_PREP + 32 * MiB), (bf16*)(ws + WS_PREP + 64 * MiB), (float*)(ws + WS_PREP + 80 * MiB), dmy ? (args.dummy >> 4) : 0, (const float*)(ws + WS_W1)};
        if (IN(6)) { for (int U = F.vcu; U < 2048; U += F.G) ssd_prep_unit(F, ma, U); if (BOTH(6)) xcd_barrier(bar); }
        if (IN(7)) { for (int u = F.vcu; u < 256; u += F.G) ssd_unit(F, ma, u); if (BOTH(7)) xcd_barrier(bar); } }
    const bool fuse_fin = (F.G == 256);
    if (IN(8)) { pg8::Gemm g{PROJ + C_Z, W4, M, D, K4, N3P, K4, NOJ, 0, 0};
        if (fuse_fin) { pg8::StaticOrder S; S.init(M, D, F.G, (int)blockIdx.x, 2);
            pg8::EpiFinal E{HN, dmy ? (float*)(ws + WS_DUMMY1) : args.out, args.in[21], ssq_y, dmy ? ssq_dmy : ssq_h2, F.ctl + CW_PANEL + (dmy ? 64 * 64 : 0), F.ctl + CW_CODE};
            pg8::gemm_phase<pg8::EpiFinal, pg8::StaticOrder, true, true>(F.lds, g, S, E); }
        else { pg8::StaticOrder S; S.init(M, D, F.G, (int)blockIdx.x, 4);
            pg8::EpiRes16 E{nullptr, HN, dmy ? (bf16*)(ws + WS_DUMMY1) : HN, nullptr, ssq_y, dmy ? ssq_dmy : ssq_h2};
            pg8::gemm_phase<pg8::EpiRes16, pg8::StaticOrder, true, true>(F.lds, g, S, E);
            if (BOTH(8)) xcd_barrier(bar); } }
    if (IN(9) && !fuse_fin) p7_final(F, HN, dmy ? (float*)(ws + WS_DUMMY1) : args.out, ssq_h2, args.in[21]);
#undef IN
#undef BOTH
}

extern "C" void kernel_launch(void* const* d_in, const int* in_sizes, int n_in, void* d_out, int out_size, void* d_ws, size_t ws_size, hipStream_t stream) {
    static int grid = 0;
    if (grid == 0) {
        if (n_in != 22 || out_size != M * D || ws_size < WS_END) { fprintf(stderr, "kernel_launch: unexpected problem (n_in %d out %d ws %zu)\n", n_in, out_size, ws_size); grid = -1; return; }
        int dev = 0, cus = 0, per_cu = 0;
        if (hipGetDevice(&dev) != hipSuccess || hipDeviceGetAttribute(&cus, hipDeviceAttributeMultiprocessorCount, dev) != hipSuccess) { grid = -1; return; }
        if (hipFuncSetAttribute((const void*)fwd, hipFuncAttributeMaxDynamicSharedMemorySize, LDS_BYTES) != hipSuccess) { fprintf(stderr, "kernel_launch: hipFuncSetAttribute failed\n"); grid = -1; return; }
        if (hipOccupancyMaxActiveBlocksPerMultiprocessor(&per_cu, (const void*)fwd, 512, LDS_BYTES) != hipSuccess || per_cu < 1) fprintf(stderr, "kernel_launch: occupancy query reports %d\n", per_cu);
        (void)hipGetLastError();
        grid = cus;
    }
    if (grid < 0) return;
    (void)hipMemsetAsync((char*)d_ws + WS_CTL, 0, CTL_ZERO_BYTES, stream);
    Args a{};
    for (int i = 0; i < 22; ++i) a.in[i] = (const float*)d_in[i];
    a.out = (float*)d_out; a.ws = (unsigned char*)d_ws;
#if MODE_MULTI
    for (int ph = 0; ph < NPHASE; ++ph) {
        a.ph_lo = ph; a.ph_hi = ph + 1;
#if NAIVE_MIX0
        if (ph == 2) continue;
        if (ph == 3) { const Mix0Args ma{(bf16*)((char*)d_ws + WS_PROJ), a.in[3], a.in[4], a.in[5], a.in[6], a.in[7], a.in[8], a.in[9], a.in[10], a.in[11], (float*)((char*)d_ws + WS_CTL) + CW_SSQA, (bf16*)((char*)d_ws + WS_PROJ), N1, C_I, C_GB, nullptr, nullptr, nullptr, 0, CvJob{}};
            hipLaunchKernelGGL(naive_hgrn2, dim3(256), dim3(256), 0, stream, ma); hipLaunchKernelGGL(naive_rglru, dim3(256), dim3(256), 0, stream, ma); continue; }
#endif
#if NAIVE_MIX1
        if (ph == 6) continue;
        if (ph == 7) { const Mix1Args ma{(bf16*)((char*)d_ws + WS_PROJ), a.in[14], a.in[15], a.in[16], a.in[17], a.in[18], a.in[19], (float*)((char*)d_ws + WS_CTL) + CW_SSQY, (bf16*)((char*)d_ws + WS_PROJ), N3P, C_Z, nullptr, nullptr, nullptr, nullptr, 0, nullptr};
            hipLaunchKernelGGL(naive_ssd, dim3(256), dim3(256), 0, stream, ma); continue; }
#endif
        if ((PROBE_REP >> ph) & 1) { a.dummy = 1 | (PROBE_VAR << 4); hipLaunchKernelGGL(fwd, dim3(grid), dim3(512), LDS_BYTES, stream, a); a.dummy = 0; }
        hipLaunchKernelGGL(fwd, dim3(grid), dim3(512), LDS_BYTES, stream, a);
    }
#else
    a.ph_lo = 0; a.ph_hi = NPHASE;
    hipLaunchKernelGGL(fwd, dim3(grid), dim3(512), LDS_BYTES, stream, a);
#endif
}
```

```cpp
#include <hip/hip_runtime.h>
#include <cstdio>
#include <cstdint>

#ifndef MODE_MULTI
#define MODE_MULTI 0
#endif
#ifndef NAIVE_MIX0
#define NAIVE_MIX0 0
#endif
#ifndef NAIVE_MIX1
#define NAIVE_MIX1 0
#endif

#ifndef PROBE_REP
#define PROBE_REP 0
#endif

#ifndef PROBE_VAR
#define PROBE_VAR 0
#endif
#define GAS __attribute__((address_space(1)))
#define LAS __attribute__((address_space(3)))
#define DI __device__ __forceinline__
typedef unsigned short bf16;
typedef unsigned u32x4 __attribute__((ext_vector_type(4)));
typedef unsigned u32x2 __attribute__((ext_vector_type(2)));
typedef float f32x4 __attribute__((ext_vector_type(4)));
typedef float f32x2 __attribute__((ext_vector_type(2)));
typedef short bf16x8 __attribute__((ext_vector_type(8)));
typedef __bf16 bf16v2 __attribute__((ext_vector_type(2)));
typedef unsigned char uchar;

constexpr int SEQ = 8192, M = 16384, D = 4096;
constexpr int N1 = 24576, K2 = 8192, N3 = 18560, N3P = 18688, N3DT = 18432, K4 = 8192;
constexpr int NCH = SEQ / 64;
constexpr int C_Q = 0, C_F = 4096, C_I = 8192, C_GA = 12288, C_XB = 16384, C_GB = 20480;
constexpr int C_Z = 0, C_X = 8192, C_B = 16384, C_C = 17408, C_DT = 18432;
constexpr float EPS = 1e-6f;
constexpr float LOG2E = 1.4426950408889634f;

constexpr size_t MiB = 1u << 20;
constexpr size_t WS_CTL = 0, CTL_ZERO_BYTES = 1 * MiB;
constexpr size_t WS_W1 = 1 * MiB;
constexpr size_t WS_W2 = 193 * MiB;
constexpr size_t WS_W3 = 257 * MiB;
constexpr size_t WS_W4 = 403 * MiB;
constexpr size_t WS_HN = 467 * MiB;
constexpr size_t WS_PROJ = 595 * MiB;
constexpr size_t WS_END = 1432 * MiB;
constexpr int CW_TMO = 0, CW_CODE = 1;
constexpr int CW_BAR = 4096;
constexpr int CW_SSQA = 16384, CW_SSQH1 = 32768, CW_SSQY = 49152, CW_SSQH2 = 65536;
constexpr int CW_DUMMY = 81920;
constexpr int CW_PANEL = 98304;
static_assert((CW_PANEL + 2 * 64 * 64) * 4 <= (int)CTL_ZERO_BYTES, "ctl");
constexpr size_t WS_PREP = 1179 * MiB;
constexpr size_t WS_PG = 1363 * MiB, WS_GL = 1427 * MiB;
constexpr size_t WS_DUMMY1 = 1280 * MiB;

constexpr int RING_BYTES = 131072;
constexpr int LDS_BYTES = 147456;
constexpr int LDSCTL_OFF = LDS_BYTES - 512, MISC_OFF = LDSCTL_OFF + 320;

DI float bflo(unsigned w) { return __uint_as_float(w << 16); }
DI float bfhi(unsigned w) { return __uint_as_float(w & 0xffff0000u); }
DI float bf2f(unsigned h) { return __uint_as_float(h << 16); }
DI unsigned pk2(float lo, float hi) { f32x2 v = {lo, hi}; bf16v2 b = __builtin_convertvector(v, bf16v2); return __builtin_bit_cast(unsigned, b); }
DI float fexp2(float x) { return __builtin_amdgcn_exp2f(x); }
DI float flog2(float x) { return __builtin_amdgcn_logf(x); }
DI float frcp(float x) { return __builtin_amdgcn_rcpf(x); }
DI float fsigmoid(float x) { return frcp(1.0f + fexp2(-LOG2E * x)); }
DI float fsilu(float x) { return x * fsigmoid(x); }
#define LDS_BAR() do { asm volatile("s_waitcnt lgkmcnt(0)" ::: "memory"); __builtin_amdgcn_s_barrier(); asm volatile("" ::: "memory"); } while (0)
#define VM_WAIT() asm volatile("s_waitcnt vmcnt(0)" ::: "memory")
DI float fq_sum(float x) {
    auto r = __builtin_amdgcn_permlane16_swap(__float_as_uint(x), __float_as_uint(x), false, false); x = __uint_as_float(r[0]) + __uint_as_float(r[1]);
    auto q = __builtin_amdgcn_permlane32_swap(__float_as_uint(x), __float_as_uint(x), false, false); return __uint_as_float(q[0]) + __uint_as_float(q[1]);
}
DI float wave_sum(float v) {
#pragma unroll
    for (int o = 1; o < 64; o <<= 1) v += __shfl_xor(v, o);
    return v;
}
#define XB_TMO      128
#define XB_XCNT(j)  (256  + 64 * (j))
#define XB_XSUB(j)  (1280 + 64 * (j))
#define XB_XGEN(j)  (2304 + 64 * (j))
#define XB_TOP      3328
#define XB_TOPGEN   3392
#define XCD_BAR_WORDS 3456
#define XB_SPIN_CAP (1u << 18)

__device__ __forceinline__ unsigned xb_ld(unsigned* p)              { return __hip_atomic_load(p, __ATOMIC_RELAXED, __HIP_MEMORY_SCOPE_AGENT); }
__device__ __forceinline__ unsigned xb_add(unsigned* p, unsigned v) { return __hip_atomic_fetch_add(p, v, __ATOMIC_RELAXED, __HIP_MEMORY_SCOPE_AGENT); }
__device__ __forceinline__ unsigned xb_xcc_id() { return (unsigned)__builtin_amdgcn_s_getreg((3 << 11) | 20) & 0xFu; }
#define XB_SPIN(cond, bar) do { unsigned _sp = 0; while (cond) { __builtin_amdgcn_s_sleep(1); \
    if ((++_sp & 255u) == 0u) { if (xb_ld(&(bar)[XB_TMO])) break; if (_sp > XB_SPIN_CAP) { atomicAdd(&(bar)[XB_TMO], 1u); break; } } } } while (0)

struct XcdBarrier {
    unsigned* bar; unsigned x;
    volatile LAS unsigned* st;
};

__device__ __forceinline__ XcdBarrier xcd_barrier_post(unsigned* bar, volatile LAS unsigned* st) {
    XcdBarrier b; b.bar = bar; b.x = xb_xcc_id(); b.st = st;
    if (threadIdx.x == 0) (void)xb_add(&bar[XB_XCNT(b.x)], 1u);
    return b;
}
__device__ __forceinline__ void xcd_barrier_complete(unsigned* bar, unsigned x, unsigned& nloc, unsigned& nx) {
    const unsigned G = gridDim.x * gridDim.y * gridDim.z;
    unsigned sum, cnt, mine, sp = 0u;
    for (;;) {
        sum = 0u; cnt = 0u; mine = 0u;
#pragma unroll
        for (unsigned j = 0; j < 16; ++j) { const unsigned c = xb_ld(&bar[XB_XCNT(j)]); sum += c; cnt += (c > 0u) ? 1u : 0u; mine = (j == x) ? c : mine; }
        if (sum == G) break;
        __builtin_amdgcn_s_sleep(1);
        if ((++sp & 255u) == 0u) { if (xb_ld(&bar[XB_TMO])) break; if (sp > XB_SPIN_CAP) { atomicAdd(&bar[XB_TMO], 1u); break; } }
    }
    nloc = mine > 0u ? mine : 1u; nx = cnt > 0u ? cnt : 1u;
}

__device__ __forceinline__ void xcd_barrier(const XcdBarrier& b) {
    asm volatile("s_waitcnt vmcnt(0)" ::: "memory");
    __syncthreads();
    if (threadIdx.x == 0) {
        unsigned* bar = b.bar;
        __builtin_amdgcn_s_waitcnt(0);
        unsigned nloc = b.st[0], nx = b.st[1];
        if (nloc == 0u) { xcd_barrier_complete(bar, b.x, nloc, nx); b.st[0] = nloc; b.st[1] = nx; }
        const unsigned old = xb_add(&bar[XB_XSUB(b.x)], 1u);
        const unsigned gen = old / nloc;
        if (old + 1u == (gen + 1u) * nloc) {
            __builtin_amdgcn_fence(__ATOMIC_RELEASE, "agent");
            asm volatile("s_waitcnt vmcnt(0)" ::: "memory");
            const unsigned og = xb_add(&bar[XB_TOP], 1u);
            const unsigned tg = og / nx;
            if (og + 1u == (tg + 1u) * nx) xb_add(&bar[XB_TOPGEN], 1u);
            else XB_SPIN(xb_ld(&bar[XB_TOPGEN]) == tg, bar);
            __builtin_amdgcn_fence(__ATOMIC_ACQUIRE, "agent");
            xb_add(&bar[XB_XGEN(b.x)], 1u);
            asm volatile("s_waitcnt vmcnt(0)" ::: "memory");
        } else {
            XB_SPIN(xb_ld(&bar[XB_XGEN(b.x)]) == gen, bar);
            __builtin_amdgcn_fence(__ATOMIC_ACQUIRE, "agent");
            asm volatile("s_waitcnt vmcnt(0)" ::: "memory");
        }
    }
    __syncthreads();
}
namespace pg8 {
#define PG8_LAS __attribute__((address_space(3)))
typedef unsigned short bf16_t;
typedef short bf16x8 __attribute__((ext_vector_type(8)));
typedef float f32x4 __attribute__((ext_vector_type(4)));
typedef unsigned u32x4 __attribute__((ext_vector_type(4)));
constexpr int BM = 256, BK = 64, HALF = 128, HTB = HALF * BK * 2  , STAGE_BYTES = 8 * HTB, NXCD = 8, WGM = 8;

__host__ __device__ __forceinline__ int lds_byte(int r, int c) { const int st = (r >> 4) * 2 + (c >> 5), rr = r & 15, cc = c & 31, ob = rr * 64 + cc * 2; return st * 1024 + (ob ^ (((ob >> 9) & 1) << 5)); }
__host__ __device__ __forceinline__ void stage_rc(int b, int& R, int& C) { const int st = b / 1024, sb = b % 1024, swz = sb ^ (((sb >> 9) & 1) << 5); R = (st >> 1) * 16 + swz / 64; C = (st & 1) * 32 + (swz % 64) / 2; }
__host__ __device__ __forceinline__ int perm32(int rho) { const int n = rho >> 4, i = rho & 15; return 8 * (i >> 2) + 4 * n + (i & 3); }

struct Unit { int pm, pn, kq; };
struct Gemm { const bf16_t* A; const bf16_t* Bt; int M, N, K, lda, ldb, kj_t; long kj_bytes; long kq_bytes; };

struct StaticOrder {
    int nM, nN, nwg, G, c, wgm;
    __host__ __device__ void init(int M, int N, int G_, int c_, int wgm_ = WGM) { nM = M / BM; nN = N / BM; nwg = nM * nN; G = G_; c = c_; wgm = wgm_; }
    __host__ __device__ bool next(int i, Unit& u) const {
        const long L = (long)i * G + c; if (L >= nwg) return false;
        int wgid = (int)L; { const int q = nwg / NXCD, r = nwg % NXCD, xcd = wgid % NXCD, off = wgid / NXCD; wgid = (xcd < r ? xcd * (q + 1) : r * (q + 1) + (xcd - r) * q) + off; }
        const int nig = wgm * nN, gid = wgid / nig, fm = gid * wgm, gsz = (nM - fm) < wgm ? (nM - fm) : wgm;
        u.pm = fm + ((wgid % nig) % gsz); u.pn = (wgid % nig) / gsz; u.kq = 0; return true;
    }
    __device__ __forceinline__ void a_ready(const Unit&) const {}
    __device__ __forceinline__ void done(const Unit&) const {}
};


struct KSplitOrder {
    int nM, G, c;
    __host__ __device__ void init(int M, int G_, int c_) { nM = M / BM; G = G_; c = c_; }
    __host__ __device__ bool next(int i, Unit& u) const { const int L = i * G + c; if (L >= 4 * nM) return false; u.pm = L >> 2; u.pn = 0; u.kq = L & 3; return true; }
    __device__ __forceinline__ void a_ready(const Unit&) const {}
    __device__ __forceinline__ void done(const Unit&) const {}
};
DI unsigned cvt_pk_bf16(float lo, float hi) { f32x2 v = {lo, hi}; bf16v2 b = __builtin_convertvector(v, bf16v2); return __builtin_bit_cast(unsigned, b); }

struct EpiBf16 {
    static constexpr bool PERM = true, AFTER_DRAIN = false, MIDK = false;
    bf16_t* O; int ldc; const float* ssq;
    DI void midk(f32x4 (&)[2][2][4][2], const Unit&, int, int) const {}
    DI void operator()(const f32x4 (&acc)[2][2][4][2], const Unit& u, int wr, int wc, int fr, int fq) const {
        const int row0 = u.pm * BM + wr * 64 + fr; const int col0 = u.pn * BM + wc * 32 + 8 * fq;
        float rs[2][4];
#pragma unroll
        for (int ai = 0; ai < 2; ++ai)
#pragma unroll
            for (int m = 0; m < 4; ++m) rs[ai][m] = ssq ? __builtin_amdgcn_rsqf(ssq[row0 + ai * HALF + m * 16] * (1.0f / 4096.0f) + 1e-6f) : 1.0f;
#pragma unroll
        for (int ai = 0; ai < 2; ++ai)
#pragma unroll
            for (int m = 0; m < 4; ++m) { bf16_t* rowp = O + (size_t)(row0 + ai * HALF + m * 16) * ldc + col0; const float s = rs[ai][m];
#pragma unroll
                for (int bj = 0; bj < 2; ++bj) { const f32x4 v0 = acc[ai][bj][m][0] * s, v1 = acc[ai][bj][m][1] * s;
                    u32x4 w; w.x = cvt_pk_bf16(v0[0], v0[1]); w.y = cvt_pk_bf16(v0[2], v0[3]); w.z = cvt_pk_bf16(v1[0], v1[1]); w.w = cvt_pk_bf16(v1[2], v1[3]);
                    *(u32x4*)(rowp + bj * HALF) = w; } }
    }
};

struct EpiRes {
    static constexpr bool PERM = false, AFTER_DRAIN = false, MIDK = true;
    const float* base; float* out; bf16_t* hn; const float* nw; const float* ssq_mid; const float* ssq_epi; float* ssq_out;
    DI void midk(f32x4 (&acc)[2][2][4][2], const Unit& u, int wr, int fr) const {
        if (!ssq_mid) return;
        const int row0 = u.pm * BM + wr * 64 + fr;
#pragma unroll
        for (int ai = 0; ai < 2; ++ai)
#pragma unroll
            for (int m = 0; m < 4; ++m) { const float s = __builtin_amdgcn_rsqf(ssq_mid[row0 + ai * HALF + m * 16] * (1.0f / 4096.0f) + 1e-6f);
#pragma unroll
                for (int bj = 0; bj < 2; ++bj)
#pragma unroll
                    for (int n = 0; n < 2; ++n) acc[ai][bj][m][n] *= s; }
    }
    DI void operator()(const f32x4 (&acc)[2][2][4][2], const Unit& u, int wr, int wc, int fr, int fq) const {
        const int row0 = u.pm * BM + wr * 64 + fr, col0 = u.pn * BM + wc * 32 + 4 * fq;
        f32x4 nwv[2][2];
#pragma unroll
        for (int bj = 0; bj < 2; ++bj)
#pragma unroll
            for (int n = 0; n < 2; ++n) nwv[bj][n] = hn ? *(const f32x4*)(nw + col0 + bj * HALF + n * 16) : (f32x4){0.f, 0.f, 0.f, 0.f};
        f32x4 nxt[2][2];
#pragma unroll
        for (int bj = 0; bj < 2; ++bj)
#pragma unroll
            for (int n = 0; n < 2; ++n) nxt[bj][n] = *(const f32x4*)(base + (size_t)row0 * 4096 + col0 + bj * HALF + n * 16);
#pragma unroll
        for (int g = 0; g < 8; ++g) { const int ai = g >> 2, m = g & 3; const int row = row0 + ai * HALF + m * 16; const size_t off = (size_t)row * 4096 + col0;
            f32x4 cur[2][2];
#pragma unroll
            for (int bj = 0; bj < 2; ++bj)
#pragma unroll
                for (int n = 0; n < 2; ++n) cur[bj][n] = nxt[bj][n];
            if (g + 1 < 8) { const size_t offn = (size_t)(row0 + ((g + 1) >> 2) * HALF + ((g + 1) & 3) * 16) * 4096 + col0;
#pragma unroll
                for (int bj = 0; bj < 2; ++bj)
#pragma unroll
                    for (int n = 0; n < 2; ++n) nxt[bj][n] = *(const f32x4*)(base + offn + bj * HALF + n * 16); }
            const float s = ssq_epi ? __builtin_amdgcn_rsqf(ssq_epi[row] * (1.0f / 8192.0f) + 1e-6f) : 1.0f;
            float ss = 0.f;
#pragma unroll
            for (int bj = 0; bj < 2; ++bj)
#pragma unroll
                for (int n = 0; n < 2; ++n) { const f32x4 v = cur[bj][n] + acc[ai][bj][m][n] * s;
                    *(f32x4*)(out + off + bj * HALF + n * 16) = v; ss += (v[0] * v[0] + v[1] * v[1]) + (v[2] * v[2] + v[3] * v[3]);
                    if (hn) { const f32x4 w = nwv[bj][n]; u32x2 p; p.x = cvt_pk_bf16(v[0] * w[0], v[1] * w[1]); p.y = cvt_pk_bf16(v[2] * w[2], v[3] * w[3]);
                        *(u32x2*)(hn + off + bj * HALF + n * 16) = p; } }
            ss = fq_sum(ss);
            if (fq == 0) unsafeAtomicAdd(ssq_out + row, ss);
            asm volatile("" ::: "memory"); }
    }
};

struct EpiRes16 {
    static constexpr bool PERM = true, AFTER_DRAIN = false, MIDK = true;
    const float* base32; const bf16_t* base16; bf16_t* O; const float* ssq_mid; const float* ssq_epi; float* ssq_out;
    DI void midk(f32x4 (&acc)[2][2][4][2], const Unit& u, int wr, int fr) const {
        if (!ssq_mid) return;
        const int row0 = u.pm * BM + wr * 64 + fr;
#pragma unroll
        for (int ai = 0; ai < 2; ++ai)
#pragma unroll
            for (int m = 0; m < 4; ++m) { const float s = __builtin_amdgcn_rsqf(ssq_mid[row0 + ai * HALF + m * 16] * (1.0f / 4096.0f) + 1e-6f);
#pragma unroll
                for (int bj = 0; bj < 2; ++bj)
#pragma unroll
                    for (int n = 0; n < 2; ++n) acc[ai][bj][m][n] *= s; }
    }
    DI void operator()(const f32x4 (&acc)[2][2][4][2], const Unit& u, int wr, int wc, int fr, int fq) const {
        const int row0 = u.pm * BM + wr * 64 + fr, col0 = u.pn * BM + wc * 32 + 8 * fq;
        f32x4 nx32[2][2]; u32x4 nx16[2];
        if (base32) {
#pragma unroll
            for (int bj = 0; bj < 2; ++bj)
#pragma unroll
                for (int n = 0; n < 2; ++n) nx32[bj][n] = *(const f32x4*)(base32 + (size_t)row0 * 4096 + col0 + bj * HALF + 4 * n);
        } else {
#pragma unroll
            for (int bj = 0; bj < 2; ++bj) nx16[bj] = *(const u32x4*)(base16 + (size_t)row0 * 4096 + col0 + bj * HALF);
        }
#pragma unroll
        for (int g = 0; g < 8; ++g) { const int ai = g >> 2, m = g & 3; const int row = row0 + ai * HALF + m * 16; const size_t off = (size_t)row * 4096 + col0;
            f32x4 cur[2][2];
            if (base32) {
#pragma unroll
                for (int bj = 0; bj < 2; ++bj)
#pragma unroll
                    for (int n = 0; n < 2; ++n) cur[bj][n] = nx32[bj][n];
            } else {
#pragma unroll
                for (int bj = 0; bj < 2; ++bj) { const u32x4 w = nx16[bj]; cur[bj][0] = (f32x4){bflo(w.x), bfhi(w.x), bflo(w.y), bfhi(w.y)}; cur[bj][1] = (f32x4){bflo(w.z), bfhi(w.z), bflo(w.w), bfhi(w.w)}; }
            }
            if (g + 1 < 8) { const size_t offn = (size_t)(row0 + ((g + 1) >> 2) * HALF + ((g + 1) & 3) * 16) * 4096 + col0;
                if (base32) {
#pragma unroll
                    for (int bj = 0; bj < 2; ++bj)
#pragma unroll
                        for (int n = 0; n < 2; ++n) nx32[bj][n] = *(const f32x4*)(base32 + offn + bj * HALF + 4 * n);
                } else {
#pragma unroll
                    for (int bj = 0; bj < 2; ++bj) nx16[bj] = *(const u32x4*)(base16 + offn + bj * HALF);
                } }
            const float s = ssq_epi ? __builtin_amdgcn_rsqf(ssq_epi[row] * (1.0f / 8192.0f) + 1e-6f) : 1.0f;
            float ss = 0.f;
#pragma unroll
            for (int bj = 0; bj < 2; ++bj) { const f32x4 v0 = cur[bj][0] + acc[ai][bj][m][0] * s, v1 = cur[bj][1] + acc[ai][bj][m][1] * s;
                ss += ((v0[0] * v0[0] + v0[1] * v0[1]) + (v0[2] * v0[2] + v0[3] * v0[3])) + ((v1[0] * v1[0] + v1[1] * v1[1]) + (v1[2] * v1[2] + v1[3] * v1[3]));
                u32x4 w; w.x = cvt_pk_bf16(v0[0], v0[1]); w.y = cvt_pk_bf16(v0[2], v0[3]); w.z = cvt_pk_bf16(v1[0], v1[1]); w.w = cvt_pk_bf16(v1[2], v1[3]);
                *(u32x4*)(O + off + bj * HALF) = w; }
            ss = fq_sum(ss);
            if (fq == 0) unsafeAtomicAdd(ssq_out + row, ss);
            asm volatile("" ::: "memory"); }
    }
};

struct EpiDtPart {
    static constexpr bool PERM = false, AFTER_DRAIN = false, MIDK = false;
    float* part; const float* ssq;
    DI void midk(f32x4 (&)[2][2][4][2], const Unit&, int, int) const {}
    DI void operator()(const f32x4 (&acc)[2][2][4][2], const Unit& u, int wr, int wc, int fr, int fq) const {
        const int row0 = u.pm * BM + wr * 64 + fr, col0 = wc * 32 + 4 * fq; float* P = part + (size_t)u.kq * 16384 * 128;
#pragma unroll
        for (int ai = 0; ai < 2; ++ai)
#pragma unroll
            for (int m = 0; m < 4; ++m) { const int row = row0 + ai * HALF + m * 16; const float s = __builtin_amdgcn_rsqf(ssq[row] * (1.0f / 4096.0f) + 1e-6f);
#pragma unroll
                for (int n = 0; n < 2; ++n) *(f32x4*)(P + (size_t)row * 128 + col0 + 16 * n) = acc[ai][0][m][n] * s; }
    }
};

struct EpiFinal {
    static constexpr bool PERM = true, AFTER_DRAIN = false, MIDK = false;
    const bf16_t* base16; float* out; const float* fw; const float* ssq_epi; float* ssq_out; unsigned* cnt; unsigned* tmo;
    DI void midk(f32x4 (&)[2][2][4][2], const Unit&, int, int) const {}
    DI void operator()(f32x4 (&acc)[2][2][4][2], const Unit& u, int wr, int wc, int fr, int fq) const {
        const int row0 = u.pm * BM + wr * 64 + fr, col0 = u.pn * BM + wc * 32 + 8 * fq;
        u32x4 q16[2][2];
#define EF_LOAD(slot_, g_) do { const size_t o_ = (size_t)(row0 + ((g_) >> 2) * HALF + ((g_) & 3) * 16) * 4096 + col0; \
            _Pragma("unroll") for (int bj = 0; bj < 2; ++bj) q16[slot_][bj] = *(const u32x4*)(base16 + o_ + bj * HALF); } while (0)
        EF_LOAD(0, 0); EF_LOAD(1, 1);
#pragma unroll
        for (int g = 0; g < 8; ++g) { const int ai = g >> 2, m = g & 3; const int row = row0 + ai * HALF + m * 16;
            f32x4 cur[2][2];
#pragma unroll
            for (int bj = 0; bj < 2; ++bj) { const u32x4 w = q16[g & 1][bj]; cur[bj][0] = (f32x4){bflo(w.x), bfhi(w.x), bflo(w.y), bfhi(w.y)}; cur[bj][1] = (f32x4){bflo(w.z), bfhi(w.z), bflo(w.w), bfhi(w.w)}; }
            if (g + 2 < 8) EF_LOAD(g & 1, g + 2);
            const float s = __builtin_amdgcn_rsqf(ssq_epi[row] * (1.0f / 8192.0f) + 1e-6f);
            float ss = 0.f;
#pragma unroll
            for (int bj = 0; bj < 2; ++bj) { const f32x4 v0 = cur[bj][0] + acc[ai][bj][m][0] * s, v1 = cur[bj][1] + acc[ai][bj][m][1] * s;
                ss += ((v0[0] * v0[0] + v0[1] * v0[1]) + (v0[2] * v0[2] + v0[3] * v0[3])) + ((v1[0] * v1[0] + v1[1] * v1[1]) + (v1[2] * v1[2] + v1[3] * v1[3]));
                acc[ai][bj][m][0] = v0; acc[ai][bj][m][1] = v1; }
            ss = fq_sum(ss);
            if (fq == 0) unsafeAtomicAdd(ssq_out + row, ss); }
#undef EF_LOAD
        asm volatile("s_waitcnt vmcnt(0)" ::: "memory");
        unsigned* c = cnt + 64 * u.pm;
        if (fr == 0 && fq == 0) __hip_atomic_fetch_add(c, 1u, __ATOMIC_RELAXED, __HIP_MEMORY_SCOPE_AGENT);
        { unsigned sp = 0;
          while ((unsigned)__builtin_amdgcn_readfirstlane(__hip_atomic_load(c, __ATOMIC_RELAXED, __HIP_MEMORY_SCOPE_AGENT)) < 128u) {
              __builtin_amdgcn_s_sleep(2);
              if (++sp > (1u << 19)) { if (fr == 0 && fq == 0) __hip_atomic_store(tmo, 0x900u | (unsigned)(u.pm & 0xff), __ATOMIC_RELAXED, __HIP_MEMORY_SCOPE_AGENT); break; } } }
        f32x4 fwv[2][2];
#pragma unroll
        for (int bj = 0; bj < 2; ++bj)
#pragma unroll
            for (int n = 0; n < 2; ++n) fwv[bj][n] = *(const f32x4*)(fw + col0 + bj * HALF + 4 * n);
#pragma unroll
        for (int g = 0; g < 8; ++g) { const int ai = g >> 2, m = g & 3; const int row = row0 + ai * HALF + m * 16;
            const float tot = __hip_atomic_load(ssq_out + row, __ATOMIC_RELAXED, __HIP_MEMORY_SCOPE_AGENT);
            const float rs = __builtin_amdgcn_rsqf(tot * (1.0f / 4096.0f) + 1e-6f);
#pragma unroll
            for (int bj = 0; bj < 2; ++bj)
#pragma unroll
                for (int n = 0; n < 2; ++n) *(f32x4*)(out + (size_t)row * 4096 + col0 + bj * HALF + 4 * n) = acc[ai][bj][m][n] * rs * fwv[bj][n]; }
    }
};
template <class Epi, class Sched, bool ALIGN_EPI = false, bool SP2 = false>
__device__ __forceinline__ void gemm_phase(PG8_LAS unsigned char* lds, const Gemm g, const Sched& S, const Epi& E) {
    const int tid = threadIdx.x, wid = __builtin_amdgcn_readfirstlane(tid >> 6), lane = tid & 63, wr = wid >> 2, wc = wid & 3, fr = lane & 15, fq = lane >> 4;
    const int K = g.K, nt = K / BK;
    unsigned voffA[2], voffB[2];
#pragma unroll
    for (int i = 0; i < 2; ++i) { int R, C; stage_rc(tid * 16 + i * 8192, R, C); const int Rb = Epi::PERM ? ((R & ~31) + perm32(R & 31)) : R;
        voffA[i] = (unsigned)(R * g.lda + C) * 2u; voffB[i] = (unsigned)(Rb * g.ldb + C) * 2u; }
    const size_t kstep = (size_t)(BK * 2);
    const size_t hstepA = (size_t)HALF * g.lda * 2, hstepB = (size_t)HALF * g.ldb * 2;
    const size_t tstepA = 2 * hstepA, tstepB = 2 * hstepB;
    const unsigned ldsw = (unsigned)wid * 1024u;
    const int aoff = lds_byte(wr * 64 + fr, fq * 8), boff = lds_byte(wc * 32 + fr, fq * 8);
#define PG8_SA(b, h) (((b) * 2 + (h)) * HTB)
#define PG8_SB(b, h) ((4 + (b) * 2 + (h)) * HTB)
#define PG8_STAGE(bufoff, gbase, voff) do { _Pragma("unroll") for (int _i = 0; _i < 2; ++_i) \
        __builtin_amdgcn_global_load_lds((const unsigned*)((const char*)(gbase) + (voff)[_i]), (PG8_LAS unsigned*)(lds + (bufoff) + ldsw + _i * 8192), 16, 0, 0); } while (0)
#define PG8_LDA(dst, b, h) do { _Pragma("unroll") for (int m = 0; m < 4; ++m) _Pragma("unroll") for (int k = 0; k < 2; ++k) dst[m][k] = *(const PG8_LAS bf16x8*)(lds + PG8_SA(b, h) + aoff + m * 2048 + k * 1024); } while (0)
#define PG8_LDB(dst, b, h) do { _Pragma("unroll") for (int n = 0; n < 2; ++n) _Pragma("unroll") for (int k = 0; k < 2; ++k) dst[n][k] = *(const PG8_LAS bf16x8*)(lds + PG8_SB(b, h) + boff + n * 2048 + k * 1024); } while (0)
#define PG8_MMA(ai, bj, At, Bt) do { __builtin_amdgcn_s_setprio(1); _Pragma("unroll") for (int m = 0; m < 4; ++m) _Pragma("unroll") for (int n = 0; n < 2; ++n) _Pragma("unroll") for (int k = 0; k < 2; ++k) \
        acc[ai][bj][m][n] = __builtin_amdgcn_mfma_f32_16x16x32_bf16(Bt[n][k], At[m][k], acc[ai][bj][m][n], 0, 0, 0); __builtin_amdgcn_s_setprio(0); } while (0)
#define PG8_WAIT_V(n) asm volatile("s_waitcnt vmcnt(" #n ")" ::: "memory")
#define PG8_WAIT_L(n) asm volatile("s_waitcnt lgkmcnt(" #n ")" ::: "memory")
#define PG8_BAR __builtin_amdgcn_s_barrier()
#define PG8_SCHED __builtin_amdgcn_sched_barrier(0)
    Unit cur, nxt; int ui = 0;
    if (!S.next(0, cur)) return;
    f32x4 acc[2][2][4][2];
#pragma unroll
    for (int a = 0; a < 2; ++a)
#pragma unroll
        for (int b = 0; b < 2; ++b)
#pragma unroll
            for (int m = 0; m < 4; ++m)
#pragma unroll
                for (int n = 0; n < 2; ++n) acc[a][b][m][n] = (f32x4){0.f, 0.f, 0.f, 0.f};
    bf16x8 At[4][2], B0[2][2], B1[2][2];
    const char* cA = (const char*)g.A + (size_t)cur.pm * tstepA + cur.kq * g.kq_bytes; const char* cB = (const char*)g.Bt + (size_t)cur.pn * tstepB + cur.kq * g.kq_bytes;
    S.a_ready(cur);
    if constexpr (SP2) {
        PG8_STAGE(PG8_SB(0, 0), cB, voffB); PG8_STAGE(PG8_SB(0, 1), cB + hstepB, voffB); PG8_STAGE(PG8_SA(0, 0), cA, voffA); PG8_STAGE(PG8_SA(0, 1), cA + hstepA, voffA);
        if (wr == 1) PG8_BAR;
        PG8_WAIT_V(2); PG8_BAR;
        PG8_STAGE(PG8_SB(1, 0), cB + kstep, voffB); PG8_STAGE(PG8_SA(1, 0), cA + kstep, voffA); PG8_STAGE(PG8_SB(1, 1), cB + hstepB + kstep, voffB);
        PG8_WAIT_V(6); PG8_BAR;
    } else {
        PG8_STAGE(PG8_SB(0, 0), cB, voffB); PG8_STAGE(PG8_SA(0, 0), cA, voffA); PG8_STAGE(PG8_SB(0, 1), cB + hstepB, voffB); PG8_STAGE(PG8_SA(0, 1), cA + hstepA, voffA);
        if (wr == 1) PG8_BAR;
        PG8_WAIT_V(4); PG8_BAR;
        PG8_STAGE(PG8_SB(1, 0), cB + kstep, voffB); PG8_STAGE(PG8_SA(1, 0), cA + kstep, voffA); PG8_STAGE(PG8_SB(1, 1), cB + hstepB + kstep, voffB);
        PG8_WAIT_V(6); PG8_BAR;
    }
    for (;;) {
        const bool has_next = S.next(ui + 1, nxt);
        const char* nA = has_next ? (const char*)g.A + (size_t)nxt.pm * tstepA + nxt.kq * g.kq_bytes : cA; const char* nB = has_next ? (const char*)g.Bt + (size_t)nxt.pn * tstepB + nxt.kq * g.kq_bytes : cB;
        for (int t = 0; t < nt; t += 2) {
            const bool last = (t == nt - 2);
            const char* a1 = cA + (size_t)(t + 1) * kstep + (t >= g.kj_t ? g.kj_bytes : 0);
            const char* a2 = last ? nA : cA + (size_t)(t + 2) * kstep + (t + 2 >= g.kj_t ? g.kj_bytes : 0); const char* b2 = last ? nB : cB + (size_t)(t + 2) * kstep;
            const char* a3 = a2 + kstep; const char* b3 = b2 + kstep;
            if (last && has_next) S.a_ready(nxt);
            if constexpr (Epi::MIDK) { if (t == g.kj_t) E.midk(acc, cur, wr, fr); }
            if constexpr (SP2) {
            PG8_LDB(B0, 0, 0); PG8_LDB(B1, 0, 1); PG8_SCHED; PG8_LDA(At, 0, 0); PG8_STAGE(PG8_SA(1, 1), a1 + hstepA, voffA);
            PG8_WAIT_V(8); PG8_WAIT_L(0); PG8_BAR; PG8_MMA(0, 0, At, B0); PG8_MMA(0, 1, At, B1); PG8_BAR; PG8_SCHED;
            PG8_LDA(At, 0, 1); PG8_STAGE(PG8_SB(0, 0), b2, voffB); PG8_STAGE(PG8_SB(0, 1), b2 + hstepB, voffB); PG8_STAGE(PG8_SA(0, 0), a2, voffA);
            PG8_WAIT_V(8); PG8_WAIT_L(0); PG8_BAR; PG8_MMA(1, 0, At, B0); PG8_MMA(1, 1, At, B1); PG8_BAR; PG8_SCHED;
            PG8_LDB(B0, 1, 0); PG8_LDB(B1, 1, 1); PG8_SCHED; PG8_LDA(At, 1, 0); PG8_STAGE(PG8_SA(0, 1), a2 + hstepA, voffA);
            PG8_WAIT_V(8); PG8_WAIT_L(0); PG8_BAR; PG8_MMA(0, 0, At, B0); PG8_MMA(0, 1, At, B1); PG8_BAR; PG8_SCHED;
            PG8_LDA(At, 1, 1); PG8_STAGE(PG8_SB(1, 0), b3, voffB); PG8_STAGE(PG8_SB(1, 1), b3 + hstepB, voffB); PG8_STAGE(PG8_SA(1, 0), a3, voffA);
            PG8_WAIT_V(8); PG8_WAIT_L(0); PG8_BAR; PG8_MMA(1, 0, At, B0); PG8_MMA(1, 1, At, B1); PG8_BAR; PG8_SCHED;
            } else {
            PG8_LDB(B0, 0, 0); PG8_SCHED; PG8_LDA(At, 0, 0); PG8_STAGE(PG8_SA(1, 1), a1 + hstepA, voffA);
            PG8_WAIT_L(8); PG8_BAR; PG8_WAIT_L(0); PG8_MMA(0, 0, At, B0); PG8_BAR; PG8_SCHED;
            PG8_LDB(B1, 0, 1); PG8_STAGE(PG8_SB(0, 0), b2, voffB);
            PG8_BAR; PG8_WAIT_L(0); PG8_MMA(0, 1, At, B1); PG8_BAR;
            PG8_LDA(At, 0, 1); PG8_STAGE(PG8_SA(0, 0), a2, voffA);
            PG8_BAR; PG8_WAIT_L(0); PG8_MMA(1, 0, At, B0); PG8_BAR; PG8_SCHED;
            PG8_STAGE(PG8_SB(0, 1), b2 + hstepB, voffB);
            PG8_WAIT_V(6); PG8_BAR; PG8_MMA(1, 1, At, B1); PG8_BAR;
            PG8_LDB(B0, 1, 0); PG8_SCHED; PG8_LDA(At, 1, 0); PG8_STAGE(PG8_SA(0, 1), a2 + hstepA, voffA);
            PG8_WAIT_L(8); PG8_BAR; PG8_WAIT_L(0); PG8_MMA(0, 0, At, B0); PG8_BAR; PG8_SCHED;
            PG8_LDB(B1, 1, 1); PG8_STAGE(PG8_SB(1, 0), b3, voffB);
            PG8_BAR; PG8_WAIT_L(0); PG8_MMA(0, 1, At, B1); PG8_BAR;
            PG8_LDA(At, 1, 1); PG8_STAGE(PG8_SA(1, 0), a3, voffA);
            PG8_BAR; PG8_WAIT_L(0); PG8_MMA(1, 0, At, B0); PG8_BAR; PG8_SCHED;
            PG8_STAGE(PG8_SB(1, 1), b3 + hstepB, voffB);
            PG8_WAIT_V(6); PG8_BAR; PG8_MMA(1, 1, At, B1); PG8_BAR;
            }
        }
        if constexpr (ALIGN_EPI) { if (wr == 0) PG8_BAR; }
        if constexpr (!Epi::AFTER_DRAIN) { E(acc, cur, wr, wc, fr, fq); S.done(cur); }
        if (!has_next) break;
#pragma unroll
        for (int a = 0; a < 2; ++a)
#pragma unroll
            for (int b = 0; b < 2; ++b)
#pragma unroll
                for (int m = 0; m < 4; ++m)
#pragma unroll
                    for (int n = 0; n < 2; ++n) acc[a][b][m][n] = (f32x4){0.f, 0.f, 0.f, 0.f};
        cur = nxt; cA = nA; cB = nB; ++ui;
        if constexpr (ALIGN_EPI) { if (wr == 1) PG8_BAR; }
    }
    PG8_WAIT_V(0);
    if constexpr (!ALIGN_EPI) { if (wr == 0) PG8_BAR; }
    PG8_BAR;
    if constexpr (Epi::AFTER_DRAIN) { E.fused(acc, cur, wr, wc, fr, fq, lds, wid, lane); S.done(cur); }
#undef PG8_SA
#undef PG8_SB
#undef PG8_STAGE
#undef PG8_LDA
#undef PG8_LDB
#undef PG8_MMA
#undef PG8_WAIT_V
#undef PG8_WAIT_L
#undef PG8_BAR
#undef PG8_SCHED
}
}
struct Frame {
    LAS uchar* lds;
    volatile LAS unsigned* MISC;
    unsigned* ctl;
    int tid, lane, wave;
    int vcu, G;
};

constexpr int TSTR = 144;
DI void p0_transpose_item(const float* W, int K, int N, bf16* WT, LAS uchar* scr, int item, int lane, const float* kscale = nullptr) {
    const int nblk = N / 64, kb = item / nblk, nb = item % nblk, k0 = 64 * kb, n0 = 64 * nb;
    const int q = lane >> 4, c16 = lane & 15;
    f32x4 v[16];
#pragma unroll
    for (int i = 0; i < 16; ++i) v[i] = *(const f32x4*)(W + (size_t)(k0 + 16 * q + i) * N + n0 + 4 * c16);
    if (kscale) {
#pragma unroll
        for (int i = 0; i < 16; ++i) v[i] = v[i] * kscale[k0 + 16 * q + i]; }
#pragma unroll
    for (int j = 0; j < 4; ++j) { u32x4 lo, hi;
        lo.x = pk2(v[0][j], v[1][j]); lo.y = pk2(v[2][j], v[3][j]); lo.z = pk2(v[4][j], v[5][j]); lo.w = pk2(v[6][j], v[7][j]);
        hi.x = pk2(v[8][j], v[9][j]); hi.y = pk2(v[10][j], v[11][j]); hi.z = pk2(v[12][j], v[13][j]); hi.w = pk2(v[14][j], v[15][j]);
        LAS uchar* p = scr + (4 * c16 + j) * TSTR + q * 32; *(LAS u32x4*)p = lo; *(LAS u32x4*)(p + 16) = hi; }
    asm volatile("s_waitcnt lgkmcnt(0)" ::: "memory");
    const int c = lane & 7, nr = lane >> 3;
#pragma unroll
    for (int r = 0; r < 8; ++r) { const int n = nr + 8 * r;
        *(u32x4*)(WT + (size_t)(n0 + n) * K + k0 + 8 * c) = *(const LAS u32x4*)(scr + n * TSTR + c * 16); }
    asm volatile("s_waitcnt lgkmcnt(0)" ::: "memory");
}
struct CvJob { const float* e_w_out; const float* o_w_in; const float* o_w_out; const float* kscale3; const float* kscale4; bf16 *W2, *W3, *W4; };
constexpr int CV_I2 = (K2 / 64) * (D / 64), CV_I3 = (D / 64) * (N3 / 64), CV_I4 = (K4 / 64) * (D / 64), CV_NIT = CV_I2 + CV_I3 + CV_I4;
DI void cv_decode(const CvJob& j, int idx, const float*& W, int& K, int& N, bf16*& WT, const float*& ks, int& item) {
    if (idx < CV_I2) { W = j.e_w_out; K = K2; N = D; WT = j.W2; ks = nullptr; item = idx; }
    else if (idx < CV_I2 + CV_I3) { W = j.o_w_in; K = D; N = N3; WT = j.W3; ks = j.kscale3; item = idx - CV_I2; }
    else { W = j.o_w_out; K = K4; N = D; WT = j.W4; ks = j.kscale4; item = idx - CV_I2 - CV_I3; }
}
DI void cv_issue_q(const CvJob& j, int idx, int lane, f32x4 (&v)[4], int r0) {
    const float* W; int K, N, item; bf16* WT; const float* ks; cv_decode(j, idx, W, K, N, WT, ks, item);
    const int nblk = N / 64, kb = item / nblk, nb = item % nblk, k0 = 64 * kb, n0 = 64 * nb, q = lane >> 4, c16 = lane & 15;
    const char* ub = (const char*)(W + (size_t)(k0 + r0) * N + n0);
    const unsigned vo = (unsigned)((16 * q) * N + 4 * c16) * 4u;
#pragma unroll
    for (int i = 0; i < 4; ++i) v[i] = *(const f32x4*)(ub + (size_t)i * N * 4 + vo);
}
DI void cv_finish(const CvJob& j, int idx, int lane, const f32x4 (&q0)[4], const f32x4 (&q1)[4], const f32x4 (&q2)[4], const f32x4 (&q3)[4], LAS uchar* scr) {
    const float* W; int K, N, item; bf16* WT; const float* ks; cv_decode(j, idx, W, K, N, WT, ks, item);
    const int nblk = N / 64, kb = item / nblk, nb = item % nblk, k0 = 64 * kb, n0 = 64 * nb, q = lane >> 4, c16 = lane & 15;
    f32x4 v[16], kv[4];
    if (ks) {
#pragma unroll
        for (int i = 0; i < 4; ++i) kv[i] = *(const f32x4*)(ks + k0 + 16 * q + 4 * i); }
    else {
#pragma unroll
        for (int i = 0; i < 4; ++i) kv[i] = (f32x4){1.f, 1.f, 1.f, 1.f}; }
#pragma unroll
    for (int i = 0; i < 16; ++i) v[i] = (i < 4 ? q0[i & 3] : i < 8 ? q1[i & 3] : i < 12 ? q2[i & 3] : q3[i & 3]) * kv[i >> 2][i & 3];
#pragma unroll
    for (int jj = 0; jj < 4; ++jj) { u32x4 lo, hi;
        lo.x = pk2(v[0][jj], v[1][jj]); lo.y = pk2(v[2][jj], v[3][jj]); lo.z = pk2(v[4][jj], v[5][jj]); lo.w = pk2(v[6][jj], v[7][jj]);
        hi.x = pk2(v[8][jj], v[9][jj]); hi.y = pk2(v[10][jj], v[11][jj]); hi.z = pk2(v[12][jj], v[13][jj]); hi.w = pk2(v[14][jj], v[15][jj]);
        LAS uchar* p = scr + (4 * c16 + jj) * TSTR + q * 32; *(LAS u32x4*)p = lo; *(LAS u32x4*)(p + 16) = hi; }
    asm volatile("s_waitcnt lgkmcnt(0)" ::: "memory");
    const int c = lane & 7, nr = lane >> 3;
#pragma unroll
    for (int hf = 0; hf < 2; ++hf) {
#pragma unroll
        for (int r = 4 * hf; r < 4 * hf + 4; ++r) { const int n = nr + 8 * r;
            *(u32x4*)(WT + (size_t)(n0 + n) * K + k0 + 8 * c) = *(const LAS u32x4*)(scr + n * TSTR + c * 16); }
        asm volatile("s_waitcnt lgkmcnt(0)" ::: "memory"); }
}
DI void rms_row_to_bf16(const float* xrow, const float* w, bf16* orow, int lane) {
    const f32x4* xr = (const f32x4*)xrow + lane; const f32x4* wr = (const f32x4*)w + lane;
    f32x4 v[16]; float s = 0.f;
#pragma unroll
    for (int j = 0; j < 16; ++j) { v[j] = xr[64 * j]; s += (v[j].x * v[j].x + v[j].y * v[j].y) + (v[j].z * v[j].z + v[j].w * v[j].w); }
    const float rstd = __builtin_amdgcn_rsqf(wave_sum(s) * (1.f / 4096.f) + EPS);
    u32x2* o8 = (u32x2*)orow + lane;
#pragma unroll
    for (int j = 0; j < 16; ++j) { const f32x4 ww = wr[64 * j]; u32x2 p; p.x = pk2(v[j].x * rstd * ww.x, v[j].y * rstd * ww.y); p.y = pk2(v[j].z * rstd * ww.z, v[j].w * rstd * ww.w); o8[64 * j] = p; }
}
struct P0Args { const float* x; const float* norm_w; const float* e_w_in; const float* e_w_out; const float* o_w_in; const float* o_w_out; bf16 *W1, *W2, *W3, *W4, *HN; };
DI void p0_prologue(Frame& F, const P0Args& a) {
    LAS uchar* scr = F.lds + F.wave * 16384;
    const int gw = F.vcu * 8 + F.wave, NGW = F.G * 8;
    constexpr int I1 = (D / 64) * (N1 / 64);
    for (int it = gw; it < I1; it += NGW) p0_transpose_item(a.e_w_in, D, N1, a.W1, scr, it, F.lane);
    { u32x4* z = (u32x4*)(a.W3 + (size_t)N3 * D); const int nz = (N3P - N3) * D / 8; const u32x4 zero = {0u, 0u, 0u, 0u};
      for (int i = gw * 64 + F.lane; i < nz; i += NGW * 64) z[i] = zero; }
    for (int m = gw; m < M; m += NGW) rms_row_to_bf16(a.x + (size_t)m * D, a.norm_w, a.HN + (size_t)m * D, F.lane);
}
DI void p7_final(Frame& F, const bf16* in, float* out, const float* ssq, const float* fw) {
    const int gw = F.vcu * 8 + F.wave, NGW = F.G * 8;
    for (int m = gw; m < M; m += NGW) {
        const float rstd = __builtin_amdgcn_rsqf(ssq[m] * (1.f / 4096.f) + EPS);
        const u32x4* xr = (const u32x4*)(in + (size_t)m * D) + F.lane; f32x4* orow = (f32x4*)(out + (size_t)m * D) + 2 * F.lane; const f32x4* wr = (const f32x4*)fw + 2 * F.lane;
#pragma unroll
        for (int j = 0; j < 8; ++j) { const u32x4 w = xr[64 * j]; const f32x4 w0 = wr[128 * j], w1 = wr[128 * j + 1];
            orow[128 * j] = (f32x4){bflo(w.x), bfhi(w.x), bflo(w.y), bfhi(w.y)} * rstd * w0;
            orow[128 * j + 1] = (f32x4){bflo(w.z), bfhi(w.z), bflo(w.w), bfhi(w.w)} * rstd * w1; }
    }
}
template <int KSTEPS> DI f32x4 mma_tile(f32x4 acc, const LAS uchar* P, int sp, int p0, const LAS uchar* Q, int sq, int q0, int fr, int fq) {
    bf16x8 a[KSTEPS], b[KSTEPS];
#pragma unroll
    for (int ks = 0; ks < KSTEPS; ++ks) { a[ks] = *(const LAS bf16x8*)(P + (p0 + fr) * sp + ks * 64 + fq * 16); b[ks] = *(const LAS bf16x8*)(Q + (q0 + fr) * sq + ks * 64 + fq * 16); }
#pragma unroll
    for (int ks = 0; ks < KSTEPS; ++ks) acc = __builtin_amdgcn_mfma_f32_16x16x32_bf16(a[ks], b[ks], acc, 0, 0, 0);
    return acc;
}
constexpr int S128 = 288, S64 = 160;

struct Mix0Args { bf16* proj; const float* lb_logits; const float* a_norm_w; const float* conv_w; const float* conv_b; const float* wa; const float* ba; const float* wx; const float* bx; const float* lam; float* ssq_a; bf16* outp; int out_ld, oa_col, ob_col;
                  bf16* Pg; bf16* KSTg; float* GLg; int dummy; CvJob cv; bf16* Qg; float* EREFg; };

DI void hgrn2_prep_all(Frame& F, const Mix0Args& a) {
    const int tid = F.tid, w = F.wave, lane = F.lane, fr = lane & 15, fq = lane >> 4;
    constexpr int PIMG = 2 * 64 * S128 + 128 * S64 + 4096;
    const int c2 = tid & 63, rg = tid >> 6;
    unsigned qr[8], fr_[8];
#define HP_LOAD(U_) do { const int h_ = (U_) & 31, n_ = ((U_) >> 5) & 127, b_ = (U_) >> 12; const size_t r_ = (size_t)b_ * SEQ + (size_t)n_ * 64 + 8 * rg; \
        _Pragma("unroll") for (int i = 0; i < 8; ++i) { qr[i] = *(const unsigned*)(a.proj + C_Q + h_ * 128 + 2 * c2 + (r_ + i) * N1); fr_[i] = *(const unsigned*)(a.proj + C_F + h_ * 128 + 2 * c2 + (r_ + i) * N1); } } while (0)
    if (F.vcu < 8192) HP_LOAD(F.vcu);
    float lb[2] = {0.f, 0.f}, oml[2] = {1.f, 1.f}; int h_prev = -1;
    int par = 0;
    for (int U = F.vcu; U < 8192; U += F.G, par ^= 1) {
    const int h = U & 31, n = (U >> 5) & 127, b = U >> 12;
    LAS uchar* QIN = F.lds + par * PIMG; LAS uchar* KIN = QIN + 64 * S128; LAS uchar* KST = KIN + 64 * S128; LAS float* TOT = (LAS float*)(KST + 128 * S64);
    if (h != h_prev) {
#pragma unroll
        for (int j = 0; j < 2; ++j) { const int col = h * 128 + 2 * c2 + j; const float l0 = a.lb_logits[col], l1 = a.lb_logits[4096 + col], l2 = a.lb_logits[8192 + col];
            const float mx = fmaxf(l0, fmaxf(l1, l2)); const float e0 = __expf(l0 - mx), e1 = __expf(l1 - mx), e2 = __expf(l2 - mx); lb[j] = e0 / (e0 + e1 + e2); oml[j] = 1.0f - lb[j]; }
        h_prev = h; }
    const size_t row0 = (size_t)b * SEQ + (size_t)n * 64;
    bf16* qcol = a.proj + C_Q + h * 128 + 2 * c2;
    unsigned qc[8], fc[8];
#pragma unroll
    for (int i = 0; i < 8; ++i) { qc[i] = qr[i]; fc[i] = fr_[i]; }
    if (U + F.G < 8192) HP_LOAD(U + F.G);
    float cum[2] = {0.f, 0.f}, cumv[8][2], kkv[8][2];
#pragma unroll
    for (int i = 0; i < 8; ++i)
#pragma unroll
        for (int j = 0; j < 2; ++j) { const float z = j ? bfhi(fc[i]) : bflo(fc[i]); const float e = fexp2(-LOG2E * z), sg = frcp(1.0f + e);
            const float fg = lb[j] + oml[j] * sg; cum[j] += flog2(fg); cumv[i][j] = cum[j]; kkv[i][j] = oml[j] * (1.0f - sg); }
    *(LAS f32x2*)(TOT + rg * 128 + 2 * c2) = (f32x2){cum[0], cum[1]};
    LDS_BAR();
    float off[2] = {0.f, 0.f}, ref[2] = {0.f, 0.f}, bl[2] = {0.f, 0.f};
#pragma unroll
    for (int g = 0; g < 8; ++g) { const f32x2 t = *(const LAS f32x2*)(TOT + g * 128 + 2 * c2);
        if (g < rg) { off[0] += t.x; off[1] += t.y; } if (g < 4) { ref[0] += t.x; ref[1] += t.y; } bl[0] += t.x; bl[1] += t.y; }
    float eref[2], ebl[2];
#pragma unroll
    for (int j = 0; j < 2; ++j) { eref[j] = fexp2(ref[j]); ebl[j] = fexp2(bl[j] - ref[j]); }
    const size_t T = ((size_t)(b * 32 + h)) * 128 + n;
    if (rg == 0) { *(f32x2*)(a.GLg + T * 128 + 2 * c2) = (f32x2){fexp2(bl[0]), fexp2(bl[1])}; *(f32x2*)(a.EREFg + T * 128 + 2 * c2) = (f32x2){eref[0], eref[1]}; }
    float ksv[2][8];
#pragma unroll
    for (int i = 0; i < 8; ++i) { float qi[2], ki[2];
#pragma unroll
        for (int j = 0; j < 2; ++j) { const float q = j ? bfhi(qc[i]) : bflo(qc[i]); const float qs = fsilu(q);
            const float e1 = fexp2(off[j] + cumv[i][j] - ref[j]), e2 = frcp(e1);
            qi[j] = qs * e1; ki[j] = kkv[i][j] * e2; ksv[j][i] = ki[j] * ebl[j]; }
        const int l = 8 * rg + i;
        *(LAS unsigned*)(QIN + l * S128 + c2 * 4) = pk2(qi[0], qi[1]);
        *(LAS unsigned*)(KIN + l * S128 + c2 * 4) = pk2(ki[0], ki[1]);
        }
#pragma unroll
    for (int j = 0; j < 2; ++j) { u32x4 p; p.x = pk2(ksv[j][0], ksv[j][1]); p.y = pk2(ksv[j][2], ksv[j][3]); p.z = pk2(ksv[j][4], ksv[j][5]); p.w = pk2(ksv[j][6], ksv[j][7]);
        *(LAS u32x4*)(KST + (2 * c2 + j) * S64 + rg * 16) = p; }
    LDS_BAR();
#pragma unroll
    for (int i = 0; i < 2; ++i) { const int c = tid + 512 * i, ln = c & 63;
        *(u32x4*)(a.Qg + T * 8192 + (size_t)c * 8) = *(const LAS u32x4*)(QIN + (16 * (c >> 8) + (ln & 15)) * S128 + ((c >> 6) & 3) * 64 + (ln >> 4) * 16);
        *(u32x4*)(a.KSTg + T * 8192 + (size_t)c * 8) = *(const LAS u32x4*)(KST + (16 * (c >> 7) + (ln & 15)) * S64 + ((c >> 6) & 1) * 64 + (ln >> 4) * 16); }
    { const int l0_ = 16 * (w & 3);
#pragma unroll
      for (int t = 0; t < 2; ++t) { const int s0 = 16 * ((w >> 2) * 2 + t);
          f32x4 sc = (f32x4){0.f, 0.f, 0.f, 0.f};
          if (s0 <= l0_ + 15) sc = mma_tile<4>(sc, KIN, S128, s0, QIN, S128, l0_, fr, fq);
          const int l = l0_ + fr, s = s0 + 4 * fq;
          u32x2 p; p.x = pk2(s <= l ? sc[0] : 0.f, s + 1 <= l ? sc[1] : 0.f); p.y = pk2(s + 2 <= l ? sc[2] : 0.f, s + 3 <= l ? sc[3] : 0.f);
          *(u32x2*)((char*)(a.Pg + T * 4096) + ((((w & 3) * 2 + (w >> 2)) * 64 + (2 * t + (fq >> 1)) * 16 + fr) * 16 + 8 * (fq & 1))) = p; } }
    }
#undef HP_LOAD
    LDS_BAR();
}

struct HgEa { unsigned v[2]; f32x4 er; };
struct HgOp { bf16x8 qf[4], pf[2], kf[2]; f32x4 g4; u32x2 ga; };
DI void hgrn2_scan_unit(Frame& F, const Mix0Args& a, int u) {
    const int tid = F.tid, w = F.wave, lane = F.lane, fr = lane & 15, fq = lane >> 4;
    const int b = u >> 7, h = (u >> 2) & 31, vs = u & 3;
    constexpr int VIMG = 32 * S64;
    LAS uchar* VT0 = F.lds; LAS uchar* STB0 = VT0 + 2 * VIMG;
    const int ltile = w & 3, jtile = w >> 2, l0_ = 16 * ltile, v0_ = 16 * jtile;
    const f32x4 anw = *(const f32x4*)(a.a_norm_w + h * 128 + vs * 32 + v0_ + 4 * fq);
    const int vp = tid & 15, lr = tid >> 4;
    for (int i = tid; i < 32 * S128 / 16; i += 512) ((LAS u32x4*)STB0)[i] = (u32x4){0u, 0u, 0u, 0u};
    f32x4 st[2] = {(f32x4){0.f, 0.f, 0.f, 0.f}, (f32x4){0.f, 0.f, 0.f, 0.f}};
    const size_t rowbase = (size_t)b * SEQ; const size_t Tb = ((size_t)(b * 32 + h)) * 128;
    const unsigned voq = (unsigned)((ltile * 256 + lane) * 16), vop = (unsigned)((ltile * 128 + lane) * 16), vok = (unsigned)((w * 128 + lane) * 16), vog = (unsigned)((16 * w + 4 * fq) * 4);
    unsigned vov[2];
#pragma unroll
    for (int i = 0; i < 2; ++i) vov[i] = (unsigned)((2 * lr + i) * N1 + C_I + h * 128 + vs * 32 + 2 * vp) * 2u;
    const unsigned voga = (unsigned)((l0_ + fr) * N1 + C_GA + h * 128 + vs * 32 + v0_ + 4 * fq) * 2u;
    const unsigned voo = (unsigned)((l0_ + fr) * a.out_ld + a.oa_col + h * 128 + vs * 32 + v0_ + 4 * fq) * 2u, vos = (unsigned)(l0_ + fr) * 4u;
    const char* const pQ = (const char*)a.Qg; const char* const pPm = (const char*)a.Pg; const char* const pK = (const char*)a.KSTg; const char* const pG = (const char*)a.GLg;
    const char* const pE = (const char*)a.EREFg; const char* const pP = (const char*)a.proj; char* const pO = (char*)a.outp; char* const pS = (char*)a.ssq_a;
    auto load_ea = [&](int n_, HgEa& r) __attribute__((always_inline)) {
        const char* uV = pP + (rowbase + (size_t)n_ * 64) * (size_t)(N1 * 2); const char* uE = pE + (Tb + n_) * 512;
#pragma unroll
        for (int i = 0; i < 2; ++i) r.v[i] = *(const unsigned*)(uV + vov[i]);
        r.er = *(const f32x4*)(uE + vog); };
    auto load_g = [&](int n_, HgOp& r) __attribute__((always_inline)) { const char* uG = pG + (Tb + n_) * 512; const char* uGa = pP + (rowbase + (size_t)n_ * 64) * (size_t)(N1 * 2);
        r.g4 = *(const f32x4*)(uG + vog); r.ga = *(const u32x2*)(uGa + voga); };
    auto load_q = [&](int n_, HgOp& r) __attribute__((always_inline)) { const char* uQ = pQ + (Tb + n_) * 16384;
#pragma unroll
        for (int ks = 0; ks < 4; ++ks) r.qf[ks] = *(const bf16x8*)(uQ + ks * 1024 + voq); };
    auto load_pk = [&](int n_, HgOp& r) __attribute__((always_inline)) { const char* uPm = pPm + (Tb + n_) * 8192; const char* uK = pK + (Tb + n_) * 16384;
#pragma unroll
        for (int ks = 0; ks < 2; ++ks) { r.pf[ks] = *(const bf16x8*)(uPm + ks * 1024 + vop); r.kf[ks] = *(const bf16x8*)(uK + ks * 1024 + vok); } };
    auto load_op = [&](int n_, HgOp& r) __attribute__((always_inline)) { load_g(n_, r); load_q(n_, r); load_pk(n_, r); };
    u32x2 p_d = {0u, 0u}; float ss_d = 0.f;
    auto put = [&](int n_) __attribute__((always_inline)) {
        const size_t r0_ = rowbase + (size_t)n_ * 64;
        if (fq == 0) unsafeAtomicAdd((float*)(pS + r0_ * 4 + vos), ss_d);
        *(u32x2*)(pO + r0_ * (size_t)(a.out_ld * 2) + voo) = p_d; };
    auto stage = [&](const HgEa& e, LAS uchar* VT) __attribute__((always_inline)) {
        *(LAS unsigned*)(VT + (2 * vp) * S64 + lr * 4) = (e.v[0] & 0xffffu) | (e.v[1] << 16); *(LAS unsigned*)(VT + (2 * vp + 1) * S64 + lr * 4) = (e.v[0] >> 16) | (e.v[1] & 0xffff0000u); };
    bf16x8 v2[2][2]; f32x4 oacc;
    auto compute_o = [&](int n, const HgOp& o, LAS uchar* VTc) __attribute__((always_inline)) {
        LAS uchar* STBc = STB0 + (n & 1) * 32 * S128;
        bf16x8 sf[4];
#pragma unroll
        for (int ks = 0; ks < 4; ++ks) sf[ks] = *(const LAS bf16x8*)(STBc + (v0_ + fr) * S128 + ks * 64 + fq * 16);
#pragma unroll
        for (int ks = 0; ks < 2; ++ks) {
#pragma unroll
            for (int vt = 0; vt < 2; ++vt) v2[vt][ks] = *(const LAS bf16x8*)(VTc + (16 * vt + fr) * S64 + ks * 64 + fq * 16); }
        oacc = (f32x4){0.f, 0.f, 0.f, 0.f};
#pragma unroll
        for (int ks = 0; ks < 4; ++ks) oacc = __builtin_amdgcn_mfma_f32_16x16x32_bf16(sf[ks], o.qf[ks], oacc, 0, 0, 0); };
    auto compute_s = [&](int n, const HgOp& o, const f32x4 er_next) __attribute__((always_inline)) {
        LAS uchar* STBn = STB0 + ((n + 1) & 1) * 32 * S128;
#pragma unroll
        for (int ks = 0; ks < 2; ++ks) oacc = __builtin_amdgcn_mfma_f32_16x16x32_bf16(jtile ? v2[1][ks] : v2[0][ks], o.pf[ks], oacc, 0, 0, 0);
#pragma unroll
        for (int vt = 0; vt < 2; ++vt) { st[vt] = st[vt] * o.g4;
#pragma unroll
            for (int ks = 0; ks < 2; ++ks) st[vt] = __builtin_amdgcn_mfma_f32_16x16x32_bf16(o.kf[ks], v2[vt][ks], st[vt], 0, 0, 0);
            const f32x4 se = st[vt] * er_next;
            u32x2 p; p.x = pk2(se[0], se[1]); p.y = pk2(se[2], se[3]);
            *(LAS u32x2*)(STBn + (16 * vt + fr) * S128 + (16 * w + 4 * fq) * 2) = p; }
        const float ss = (oacc[0] * oacc[0] + oacc[1] * oacc[1]) + (oacc[2] * oacc[2] + oacc[3] * oacc[3]);
        ss_d = fq_sum(ss);
        const float g0 = bflo(o.ga.x), g1 = bfhi(o.ga.x), g2 = bflo(o.ga.y), g3 = bfhi(o.ga.y);
        p_d.x = pk2(oacc[0] * anw[0] * fsilu(g0), oacc[1] * anw[1] * fsilu(g1)); p_d.y = pk2(oacc[2] * anw[2] * fsilu(g2), oacc[3] * anw[3] * fsilu(g3)); };
    auto step = [&](int n, HgEa& ea, HgEa& eb, HgOp& oa, HgOp& ob) __attribute__((always_inline)) {
        asm volatile("" : "+v"(ea.v[0]), "+v"(ea.v[1]), "+v"(ea.er), "+v"(oa.g4), "+v"(oa.ga) :: "memory");
        asm volatile("" : "+v"(oa.qf[0]), "+v"(oa.qf[1]), "+v"(oa.qf[2]), "+v"(oa.qf[3]), "+v"(oa.pf[0]), "+v"(oa.pf[1]), "+v"(oa.kf[0]), "+v"(oa.kf[1]) :: "memory");
        if (n > 0) put(n - 1);
        if (n + 2 < NCH) load_ea(n + 2, eb);
        if (n + 1 < NCH) load_g(n + 1, ob);
        if (n + 1 < NCH) stage(ea, VT0 + ((n + 1) & 1) * VIMG);
        __builtin_amdgcn_sched_barrier(0);
        if (n + 1 < NCH) load_q(n + 1, ob);
        __builtin_amdgcn_sched_barrier(0);
        compute_o(n, oa, VT0 + (n & 1) * VIMG);
        __builtin_amdgcn_sched_barrier(0);
        if (n + 1 < NCH) load_pk(n + 1, ob);
        __builtin_amdgcn_sched_barrier(0);
        compute_s(n, oa, ea.er);
        LDS_BAR(); };
    HgEa e0, e1; HgOp o0, o1;
    load_ea(0, e0); load_op(0, o0);
    stage(e0, VT0);
    load_ea(1, e1);
    LDS_BAR();
    for (int n = 0; n < NCH; n += 2) { step(n, e1, e0, o0, o1); step(n + 1, e0, e1, o1, o0); }
    put(NCH - 1);
}


template <int Q> struct CvQ { static constexpr int value = Q; };
DI void rglru_scan_unit(Frame& F, const Mix0Args& a, int u) {
    const int tid = F.tid, w = F.wave, lane = F.lane, fr = lane & 15, fq = lane >> 4;
    const int b = u >> 7, nb = (u >> 2) & 31, qq = u & 3, cb = nb * 128;
    LAS uchar* XC0 = F.lds; LAS uchar* WAT = XC0 + 2 * 64 * S128; LAS uchar* WXT = WAT + 32 * S128;
    LAS float* SEG0 = (LAS float*)(WXT + 32 * S128); LAS float* HPREV = SEG0 + 16;
    LAS uchar* CVS = F.lds + 65536 + w * 9216;
    const int gw = F.vcu * 8 + w, NGW = F.G * 8; const bool cv_on = (u == F.vcu);
    f32x4 cq0[4], cq1[4], cq2[4], cq3[4];
#pragma unroll
    for (int i = 0; i < 4; ++i) cq0[i] = cq1[i] = cq2[i] = cq3[i] = (f32x4){0.f, 0.f, 0.f, 0.f};
    { const int j = tid & 31, kg = tid >> 5; float wv[8], xv[8];
#pragma unroll
      for (int i = 0; i < 8; ++i) { const size_t o = ((size_t)(nb * 128 + 8 * kg + i)) * 128 + qq * 32 + j; wv[i] = a.wa[o]; xv[i] = a.wx[o]; }
      u32x4 p; p.x = pk2(wv[0], wv[1]); p.y = pk2(wv[2], wv[3]); p.z = pk2(wv[4], wv[5]); p.w = pk2(wv[6], wv[7]); *(LAS u32x4*)(WAT + j * S128 + kg * 16) = p;
      p.x = pk2(xv[0], xv[1]); p.y = pk2(xv[2], xv[3]); p.z = pk2(xv[4], xv[5]); p.w = pk2(xv[6], xv[7]); *(LAS u32x4*)(WXT + j * S128 + kg * 16) = p; }
    if (tid < 64) HPREV[(tid & 31) * 20 + (tid >> 5)] = 0.f;
    const int c2 = tid & 63, rg = tid >> 6;
    float cw[4][2], cbs[2];
#pragma unroll
    for (int j = 0; j < 2; ++j) { const int ch = cb + 2 * c2 + j; cbs[j] = a.conv_b[ch];
#pragma unroll
        for (int k = 0; k < 4; ++k) cw[k][j] = a.conv_w[k * 4096 + ch]; }
    const int ltile = w & 3, jtile = w >> 2, l0_ = 16 * ltile, jj = 16 * jtile + fr, co = cb + qq * 32 + jj;
    const float bav = a.ba[co], bxv = a.bx[co], sp8l2 = 8.0f * LOG2E * log1pf(__expf(-a.lam[co]));
    const size_t rowbase = (size_t)b * SEQ;
    const bf16* xcol = a.proj + C_XB + cb + 2 * c2;
    const bf16* gbcol = a.proj + C_GB + co; bf16* obcol = a.outp + a.ob_col + co;
    unsigned xr[11], gbr[4];
#define RG_LOAD(n_) do { const long r0_ = (long)rowbase + (long)(n_) * 64; \
        _Pragma("unroll") for (int i = 0; i < 11; ++i) xr[i] = ((n_) == 0 && 8 * rg - 3 + i < 0) ? 0u : *(const unsigned*)(xcol + (size_t)(r0_ + 8 * rg - 3 + i) * N1); } while (0)
#define RG_LOADG(n_) do { const long r0_ = (long)rowbase + (long)(n_) * 64; \
        _Pragma("unroll") for (int i = 0; i < 4; ++i) gbr[i] = *(const unsigned short*)(gbcol + (size_t)(r0_ + l0_ + 4 * fq + i) * N1); } while (0)
#define RG_STAGE(xc_) do { LAS uchar* X_ = (xc_); \
        _Pragma("unroll") for (int i = 0; i < 8; ++i) { f32x2 s2 = (f32x2){cbs[0], cbs[1]}; \
            _Pragma("unroll") for (int k = 0; k < 4; ++k) s2 += (f32x2){cw[k][0], cw[k][1]} * (f32x2){bflo(xr[i + k]), bfhi(xr[i + k])}; \
            *(LAS unsigned*)(X_ + (8 * rg + i) * S128 + c2 * 4) = pk2(s2.x, s2.y); } } while (0)
    RG_LOAD(0);
    RG_STAGE(XC0);
    unsigned gb_cur[4];
    RG_LOAD(1); RG_LOADG(0);
    LDS_BAR();
    const int nsl = cv_on ? min(NCH / 4, max(0, (CV_NIT - 8 * F.vcu + NGW - 1) / NGW)) : 0;
    auto rg_step = [&](int n, auto cvt) __attribute__((always_inline)) {
        constexpr int CQ = decltype(cvt)::value; constexpr bool CV = CQ >= 0;
        const size_t row0 = rowbase + (size_t)n * 64;
        LAS uchar* XCc = XC0 + (n & 1) * 64 * S128; LAS uchar* XCn = XC0 + ((n + 1) & 1) * 64 * S128;
        LAS float* SEGA = SEG0 + (n & 1) * 1280; LAS float* SEGH = SEGA + 640;
#pragma unroll
        for (int i = 0; i < 4; ++i) gb_cur[i] = gbr[i];
        if (n + 1 < NCH) RG_STAGE(XCn);
        if constexpr (CQ == 0) { if (n > 0) { const int ip = ((n >> 2) - 1) * NGW + gw; if (ip < CV_NIT) cv_finish(a.cv, ip, lane, cq0, cq1, cq2, cq3, CVS); } }
        if (n + 2 < NCH) RG_LOAD(n + 2);
        if (n + 1 < NCH) RG_LOADG(n + 1);
        if constexpr (CV) { int idx = (n >> 2) * NGW + gw; idx = idx < CV_NIT ? idx : idx - CV_NIT;
            if constexpr (CQ == 0) cv_issue_q(a.cv, idx, lane, cq0, 0); else if constexpr (CQ == 1) cv_issue_q(a.cv, idx, lane, cq1, 4); else if constexpr (CQ == 2) cv_issue_q(a.cv, idx, lane, cq2, 8); else cv_issue_q(a.cv, idx, lane, cq3, 12); }
        const f32x4 zero4 = (f32x4){0.f, 0.f, 0.f, 0.f};
        float av[4], uv[4]; float Aseg = 1.f, Hseg = 0.f;
        { bf16x8 xf[4], waf[4], wxf[4]; unsigned xcr[4];
#pragma unroll
          for (int ks = 0; ks < 4; ++ks) { xf[ks] = *(const LAS bf16x8*)(XCc + (l0_ + fr) * S128 + ks * 64 + fq * 16);
              waf[ks] = *(const LAS bf16x8*)(WAT + (16 * jtile + fr) * S128 + ks * 64 + fq * 16); wxf[ks] = *(const LAS bf16x8*)(WXT + (16 * jtile + fr) * S128 + ks * 64 + fq * 16); }
#pragma unroll
          for (int r = 0; r < 4; ++r) xcr[r] = *(const LAS unsigned short*)(XCc + (l0_ + 4 * fq + r) * S128 + (qq * 32 + jj) * 2);
          f32x4 R = zero4, I = zero4;
#pragma unroll
          for (int ks = 0; ks < 4; ++ks) { R = __builtin_amdgcn_mfma_f32_16x16x32_bf16(xf[ks], waf[ks], R, 0, 0, 0); I = __builtin_amdgcn_mfma_f32_16x16x32_bf16(xf[ks], wxf[ks], I, 0, 0, 0); }
#pragma unroll
          for (int r = 0; r < 4; ++r) {
              const float rr = fsigmoid(R[r] + bav), ig = fsigmoid(I[r] + bxv);
              const float aa = fexp2(-sp8l2 * rr); const float om = __builtin_fmaf(-aa, aa, 1.0f);
              av[r] = aa; uv[r] = __builtin_sqrtf(om) * (ig * bf2f(xcr[r]));
              Hseg = aa * Hseg + uv[r]; Aseg *= aa; } }
        const int sgi = ltile * 4 + fq;
        SEGA[jj * 20 + sgi] = Aseg; SEGH[jj * 20 + sgi] = Hseg;
        LDS_BAR();
        float carry = HPREV[jj * 20 + (n & 1)]; float sa[15], sh[15];
        { f32x4 a4[4], h4[4];
#pragma unroll
          for (int i = 0; i < 4; ++i) { a4[i] = *(const LAS f32x4*)(SEGA + jj * 20 + 4 * i); h4[i] = *(const LAS f32x4*)(SEGH + jj * 20 + 4 * i); }
#pragma unroll
          for (int s = 0; s < 15; ++s) { sa[s] = a4[s >> 2][s & 3]; sh[s] = h4[s >> 2][s & 3]; } }
#pragma unroll
        for (int s = 0; s < 15; ++s) carry = (s < sgi) ? sa[s] * carry + sh[s] : carry;
#pragma unroll
        for (int r = 0; r < 4; ++r) { carry = av[r] * carry + uv[r];
            const float o = carry * fsilu(bf2f(gb_cur[r]));
            obcol[(row0 + l0_ + 4 * fq + r) * a.out_ld] = (bf16)(pk2(o, 0.f) & 0xffffu); }
        if (sgi == 15) HPREV[jj * 20 + ((n + 1) & 1)] = carry;
    };
    int n = 0;
    for (; n < 4 * nsl; n += 4) { rg_step(n, CvQ<0>{}); rg_step(n + 1, CvQ<1>{}); rg_step(n + 2, CvQ<2>{}); rg_step(n + 3, CvQ<3>{}); }
    if (nsl > 0 && (nsl - 1) * NGW + gw < CV_NIT) cv_finish(a.cv, (nsl - 1) * NGW + gw, lane, cq0, cq1, cq2, cq3, CVS);
    for (; n < NCH; ++n) rg_step(n, CvQ<-1>{});
    if (cv_on) for (int sl = NCH / 4; sl * NGW + gw < CV_NIT; ++sl) { const int ix = sl * NGW + gw; cv_issue_q(a.cv, ix, lane, cq0, 0); cv_issue_q(a.cv, ix, lane, cq1, 4); cv_issue_q(a.cv, ix, lane, cq2, 8); cv_issue_q(a.cv, ix, lane, cq3, 12); cv_finish(a.cv, ix, lane, cq0, cq1, cq2, cq3, CVS); }
#undef RG_LOAD
#undef RG_LOADG
#undef RG_STAGE
    LDS_BAR();
}
struct Mix1Args { bf16* proj; const float* conv_w; const float* conv_b; const float* dt_bias; const float* a_log; const float* d_skip; const float* norm_w; float* ssq_y; bf16* outp; int out_ld, o_col;
                  bf16* Cg; bf16* BTg; bf16* CBg; float* TABg; int var; const float* dtp; };
constexpr int SX = 144;

DI void ssd_prep_unit(Frame& F, const Mix1Args& a, int U) {
    const int tid = F.tid, w = F.wave, lane = F.lane, fr = lane & 15, fq = lane >> 4;
    const int g = U & 7, n = (U >> 3) & 127, b = U >> 10;
    LAS uchar* CC = F.lds; LAS uchar* BC = CC + 64 * S128; LAS uchar* BT = BC + 64 * S128;
    const int c2 = tid & 63, rg = tid >> 6;
    float bw[4][2], bb[2], cw[4][2], cbs[2];
#pragma unroll
    for (int j = 0; j < 2; ++j) { const int chb = 8192 + g * 128 + 2 * c2 + j, chc = 9216 + g * 128 + 2 * c2 + j;
        bb[j] = a.conv_b[chb]; cbs[j] = a.conv_b[chc];
#pragma unroll
        for (int k = 0; k < 4; ++k) { bw[k][j] = a.conv_w[k * 10240 + chb]; cw[k][j] = a.conv_w[k * 10240 + chc]; } }
    const long r0 = (long)b * SEQ + (long)n * 64 + 8 * rg - 3;
    const bf16* bcol = a.proj + C_B + g * 128 + 2 * c2;
    const bf16* ccol = a.proj + C_C + g * 128 + 2 * c2;
    unsigned bc[11], cc[11];
#pragma unroll
    for (int i = 0; i < 11; ++i) { const bool zz = (n == 0 && 8 * rg - 3 + i < 0);
        bc[i] = zz ? 0u : *(const unsigned*)(bcol + (size_t)(r0 + i) * N3P); cc[i] = zz ? 0u : *(const unsigned*)(ccol + (size_t)(r0 + i) * N3P); }
    { float bt[2][8];
#pragma unroll
      for (int i = 0; i < 8; ++i) { float vb[2], vc[2];
#pragma unroll
          for (int j = 0; j < 2; ++j) { float sb = bb[j], sc = cbs[j];
#pragma unroll
              for (int k = 0; k < 4; ++k) { sb += bw[k][j] * (j ? bfhi(bc[i + k]) : bflo(bc[i + k])); sc += cw[k][j] * (j ? bfhi(cc[i + k]) : bflo(cc[i + k])); }
              vb[j] = fsilu(sb); vc[j] = fsilu(sc); bt[j][i] = vb[j]; }
          *(LAS unsigned*)(BC + (8 * rg + i) * S128 + c2 * 4) = pk2(vb[0], vb[1]);
          *(LAS unsigned*)(CC + (8 * rg + i) * S128 + c2 * 4) = pk2(vc[0], vc[1]); }
#pragma unroll
      for (int j = 0; j < 2; ++j) { u32x4 p; p.x = pk2(bt[j][0], bt[j][1]); p.y = pk2(bt[j][2], bt[j][3]); p.z = pk2(bt[j][4], bt[j][5]); p.w = pk2(bt[j][6], bt[j][7]);
          *(LAS u32x4*)(BT + (2 * c2 + j) * S64 + rg * 16) = p; } }
    LDS_BAR();
    const size_t T = ((size_t)(b * 128 + n)) * 8 + g;
#pragma unroll
    for (int i = 0; i < 2; ++i) { const int c = tid + 512 * i, ln = c & 63;
        *(u32x4*)(a.Cg + T * 8192 + (size_t)c * 8) = *(const LAS u32x4*)(CC + (16 * (c >> 8) + (ln & 15)) * S128 + ((c >> 6) & 3) * 64 + (ln >> 4) * 16);
        *(u32x4*)(a.BTg + T * 8192 + (size_t)c * 8) = *(const LAS u32x4*)(BT + (16 * (c >> 7) + (ln & 15)) * S64 + ((c >> 6) & 1) * 64 + (ln >> 4) * 16); }
    { const int l0_ = 16 * (w & 3);
#pragma unroll
      for (int t = 0; t < 2; ++t) { const int m0 = 16 * ((w >> 2) * 2 + t);
          const f32x4 cbv = mma_tile<4>((f32x4){0.f, 0.f, 0.f, 0.f}, BC, S128, m0, CC, S128, l0_, fr, fq);
          u32x2 p; p.x = pk2(cbv[0], cbv[1]); p.y = pk2(cbv[2], cbv[3]);
          *(u32x2*)(a.CBg + T * 4096 + (size_t)(l0_ + fr) * 64 + m0 + 4 * fq) = p; } }
#pragma unroll
    for (int t = 0; t < 2; ++t) { const int h = 16 * g + 2 * w + t;
        const size_t di = ((size_t)b * SEQ + (size_t)n * 64 + lane) * 128 + h; const size_t dq = (size_t)16384 * 128;
        const float xx = ((a.dtp[di] + a.dtp[di + dq]) + (a.dtp[di + 2 * dq] + a.dtp[di + 3 * dq])) + a.dt_bias[h];
        const float dtv = xx > 20.f ? xx : log1pf(__expf(xx)); float cs = dtv * (-__expf(a.a_log[h]) * LOG2E);
#pragma unroll
        for (int o = 1; o < 64; o <<= 1) { const float tt = __shfl_up(cs, o); if (lane >= o) cs += tt; }
        float* tp = a.TABg + (((size_t)(b * 128 + n)) * 128 + h) * 128; tp[lane] = cs; tp[64 + lane] = dtv; }
    LDS_BAR();
}

struct SsdSt { u32x4 cb; unsigned x[7]; float tb[2]; };
struct SsdOp { bf16x8 cf[4], bf[2]; u32x2 z[2]; };
DI void ssd_unit(Frame& F, const Mix1Args& a, int u) {
    const int tid = F.tid, w = F.wave, lane = F.lane, fr = lane & 15, fq = lane >> 4;
    const int b = u >> 7, h = u & 127, g = h >> 4;
    constexpr int O_XDT = 0, O_XDS = 64 * S64, O_MM = 2 * 64 * S64, IMG = 3 * 64 * S64;
    LAS uchar* IMG0 = F.lds; LAS uchar* SB0 = IMG0 + 2 * IMG; LAS float* TAB = (LAS float*)(SB0 + 2 * 64 * S128) + w * 128;
    const int c2x = tid & 31, rg4 = tid >> 5;
    float xw[4][2], xb[2];
#pragma unroll
    for (int j = 0; j < 2; ++j) { const int chx = h * 64 + 2 * c2x + j; xb[j] = a.conv_b[chx];
#pragma unroll
        for (int k = 0; k < 4; ++k) xw[k][j] = a.conv_w[k * 10240 + chx]; }
    const float Dh = a.d_skip[h];
    const int ltile = w & 3, l0_ = 16 * ltile, ph = (w >> 2) * 2;
    const size_t rowbase = (size_t)b * SEQ;
    const unsigned vo16 = (unsigned)tid * 16u, vot = (unsigned)lane * 4u;
    const unsigned voc = (unsigned)((ltile * 256 + lane) * 16), vob = (unsigned)((w * 128 + lane) * 16);
    unsigned vox[7];
#pragma unroll
    for (int i = 0; i < 7; ++i) vox[i] = (unsigned)((4 * rg4 + i) * N3P + C_X + h * 64 + 2 * c2x) * 2u;
    const unsigned voz = (unsigned)((l0_ + fr) * N3P + C_Z + h * 64 + 16 * ph + 4 * fq) * 2u;
    const unsigned voo = (unsigned)((l0_ + fr) * a.out_ld + a.o_col + h * 64 + 16 * ph + 4 * fq) * 2u, vos = (unsigned)(l0_ + fr) * 4u;
    const char* const pC = (const char*)a.Cg; const char* const pB = (const char*)a.BTg; const char* const pCB = (const char*)a.CBg;
    const char* const pP = (const char*)a.proj; const char* const pT = (const char*)a.TABg; char* const pO = (char*)a.outp; char* const pS = (char*)a.ssq_y;
    for (int i = tid; i < 64 * S128 / 16; i += 512) ((LAS u32x4*)SB0)[i] = (u32x4){0u, 0u, 0u, 0u};
    f32x4 st[4];
#pragma unroll
    for (int t = 0; t < 4; ++t) st[t] = (f32x4){0.f, 0.f, 0.f, 0.f};
    auto load_st = [&](int n_, SsdSt& r) __attribute__((always_inline)) {
        const size_t T_ = ((size_t)(b * 128 + n_)) * 8 + g; const long r0_ = (long)rowbase + (long)n_ * 64;
        const char* uCB = pCB + T_ * 8192; const char* uX = pP + (r0_ - 3) * (long)(N3P * 2); const char* uT = pT + (((size_t)(b * 128 + n_)) * 128 + h) * 512;
        r.cb = *(const u32x4*)(uCB + vo16);
#pragma unroll
        for (int i = 0; i < 7; ++i) r.x[i] = (n_ == 0 && 4 * rg4 - 3 + i < 0) ? 0u : *(const unsigned*)(uX + vox[i]);
        r.tb[0] = *(const float*)(uT + vot); r.tb[1] = *(const float*)(uT + 256 + vot); };
    auto load_z = [&](int n_, SsdOp& r) __attribute__((always_inline)) { const char* uZ = pP + ((long)rowbase + (long)n_ * 64) * (long)(N3P * 2);
#pragma unroll
        for (int t = 0; t < 2; ++t) r.z[t] = *(const u32x2*)(uZ + 32 * t + voz); };
    auto load_c = [&](int n_, SsdOp& r) __attribute__((always_inline)) { const char* uC = pC + (((size_t)(b * 128 + n_)) * 8 + g) * 16384;
#pragma unroll
        for (int ks = 0; ks < 4; ++ks) r.cf[ks] = *(const bf16x8*)(uC + ks * 1024 + voc); };
    auto load_b = [&](int n_, SsdOp& r) __attribute__((always_inline)) { const char* uB = pB + (((size_t)(b * 128 + n_)) * 8 + g) * 16384;
#pragma unroll
        for (int ks = 0; ks < 2; ++ks) r.bf[ks] = *(const bf16x8*)(uB + ks * 1024 + vob); };
    auto load_op = [&](int n_, SsdOp& r) __attribute__((always_inline)) { load_z(n_, r); load_c(n_, r); load_b(n_, r); };
    u32x2 p_d[2] = {(u32x2){0u, 0u}, (u32x2){0u, 0u}}; float ss_d = 0.f;
    auto put = [&](int n_) __attribute__((always_inline)) {
        const size_t r0_ = rowbase + (size_t)n_ * 64; char* uO = pO + r0_ * (size_t)(a.out_ld * 2); char* uS = pS + r0_ * 4;
#pragma unroll
        for (int t = 0; t < 2; ++t) *(u32x2*)(uO + 32 * t + voo) = p_d[t];
        if (fq == 0) unsafeAtomicAdd((float*)(uS + vos), ss_d); };
    float el_c = 0.f, dec_c = 0.f;
    auto stage = [&](const SsdSt& c, LAS uchar* I) __attribute__((always_inline)) {
        TAB[lane] = c.tb[0]; TAB[64 + lane] = c.tb[1];
        asm volatile("s_waitcnt lgkmcnt(0)" ::: "memory");
        const float cs_last = TAB[63];
        { const int l = tid >> 3, m8 = (tid & 7) * 8; u32x4 p = (u32x4){0u, 0u, 0u, 0u}; const u32x4 cbc = c.cb;
          if (m8 <= l) { const float csl = TAB[l]; const float dsk = Dh * frcp(fmaxf(TAB[64 + l], 1e-20f)); const f32x4 ca = *(const LAS f32x4*)(TAB + m8), cb4 = *(const LAS f32x4*)(TAB + m8 + 4);
              float mv[8];
#pragma unroll
              for (int j = 0; j < 8; ++j) { const unsigned wv = j < 2 ? cbc.x : j < 4 ? cbc.y : j < 6 ? cbc.z : cbc.w; const float cbv = (j & 1) ? bfhi(wv) : bflo(wv);
                  const float csm = j < 4 ? ca[j & 3] : cb4[j & 3];
                  mv[j] = (m8 + j <= l) ? cbv * fexp2(fminf(csl - csm, 0.f)) : 0.f; if (m8 + j == l) mv[j] += dsk; }
              p.x = pk2(mv[0], mv[1]); p.y = pk2(mv[2], mv[3]); p.z = pk2(mv[4], mv[5]); p.w = pk2(mv[6], mv[7]); }
          *(LAS u32x4*)(I + O_MM + l * S64 + m8 * 2) = p; }
        { f32x2 xv[7];
#pragma unroll
          for (int i = 0; i < 7; ++i) xv[i] = (f32x2){bflo(c.x[i]), bfhi(c.x[i])};
          float xd[2][4], xs_[2][4];
#pragma unroll
          for (int i = 0; i < 4; ++i) { const int l = 4 * rg4 + i; const float dl = TAB[64 + l], sl = fexp2(cs_last - TAB[l]);
              f32x2 s2 = (f32x2){xb[0], xb[1]};
#pragma unroll
              for (int k = 0; k < 4; ++k) s2 += (f32x2){xw[k][0], xw[k][1]} * xv[i + k];
              xd[0][i] = fsilu(s2.x) * dl; xd[1][i] = fsilu(s2.y) * dl; xs_[0][i] = xd[0][i] * sl; xs_[1][i] = xd[1][i] * sl; }
#pragma unroll
          for (int j = 0; j < 2; ++j) { u32x2 p; p.x = pk2(xd[j][0], xd[j][1]); p.y = pk2(xd[j][2], xd[j][3]); *(LAS u32x2*)(I + O_XDT + (2 * c2x + j) * S64 + rg4 * 8) = p;
              p.x = pk2(xs_[j][0], xs_[j][1]); p.y = pk2(xs_[j][2], xs_[j][3]); *(LAS u32x2*)(I + O_XDS + (2 * c2x + j) * S64 + rg4 * 8) = p; } }
        el_c = fexp2(TAB[l0_ + fr]); dec_c = fexp2(cs_last); };
    f32x4 yacc[2];
    auto compute_y = [&](int n, const SsdOp& o, LAS uchar* I, float el) __attribute__((always_inline)) {
        LAS uchar* SBc = SB0 + (n & 1) * 64 * S128;
        { bf16x8 sf[2][4], mf[2], xf[2][2];
#pragma unroll
          for (int ks = 0; ks < 4; ++ks) {
#pragma unroll
              for (int t = 0; t < 2; ++t) sf[t][ks] = *(const LAS bf16x8*)(SBc + (16 * (ph + t) + fr) * S128 + ks * 64 + fq * 16); }
#pragma unroll
          for (int ks = 0; ks < 2; ++ks) { mf[ks] = *(const LAS bf16x8*)(I + O_MM + (l0_ + fr) * S64 + ks * 64 + fq * 16);
#pragma unroll
              for (int t = 0; t < 2; ++t) xf[t][ks] = *(const LAS bf16x8*)(I + O_XDT + (16 * (ph + t) + fr) * S64 + ks * 64 + fq * 16); }
#pragma unroll
          for (int t = 0; t < 2; ++t) { f32x4 acc = (f32x4){0.f, 0.f, 0.f, 0.f};
#pragma unroll
              for (int ks = 0; ks < 4; ++ks) acc = __builtin_amdgcn_mfma_f32_16x16x32_bf16(sf[t][ks], o.cf[ks], acc, 0, 0, 0);
              acc = acc * el;
#pragma unroll
              for (int ks = 0; ks < 2; ++ks) acc = __builtin_amdgcn_mfma_f32_16x16x32_bf16(xf[t][ks], mf[ks], acc, 0, 0, 0);
              yacc[t] = acc; } } };
    auto compute_s = [&](int n, const SsdOp& o, LAS uchar* I, float dec) __attribute__((always_inline)) {
        LAS uchar* SBn = SB0 + ((n + 1) & 1) * 64 * S128;
        { bf16x8 xs2[4][2];
#pragma unroll
          for (int ks = 0; ks < 2; ++ks) {
#pragma unroll
              for (int t = 0; t < 4; ++t) xs2[t][ks] = *(const LAS bf16x8*)(I + O_XDS + (16 * t + fr) * S64 + ks * 64 + fq * 16); }
#pragma unroll
          for (int t = 0; t < 4; ++t) { st[t] = st[t] * dec;
#pragma unroll
              for (int ks = 0; ks < 2; ++ks) st[t] = __builtin_amdgcn_mfma_f32_16x16x32_bf16(o.bf[ks], xs2[t][ks], st[t], 0, 0, 0);
              u32x2 p; p.x = pk2(st[t][0], st[t][1]); p.y = pk2(st[t][2], st[t][3]); *(LAS u32x2*)(SBn + (16 * t + fr) * S128 + (16 * w + 4 * fq) * 2) = p; } }
        { float ss = 0.f;
#pragma unroll
          for (int t = 0; t < 2; ++t) {
              const float z0 = bflo(o.z[t].x), z1 = bfhi(o.z[t].x), z2 = bflo(o.z[t].y), z3 = bfhi(o.z[t].y);
              const float y0 = yacc[t][0] * fsilu(z0), y1 = yacc[t][1] * fsilu(z1), y2 = yacc[t][2] * fsilu(z2), y3 = yacc[t][3] * fsilu(z3);
              ss += (y0 * y0 + y1 * y1) + (y2 * y2 + y3 * y3);
              p_d[t].x = pk2(y0, y1); p_d[t].y = pk2(y2, y3); }
          ss_d = fq_sum(ss); } };
    auto step = [&](int n, SsdSt& sa, SsdSt& sb, SsdOp& oa, SsdOp& ob) __attribute__((always_inline)) {
        asm volatile("" : "+v"(sa.cb), "+v"(sa.x[0]), "+v"(sa.x[1]), "+v"(sa.x[2]), "+v"(sa.x[3]), "+v"(sa.x[4]), "+v"(sa.x[5]), "+v"(sa.x[6]), "+v"(sa.tb[0]), "+v"(sa.tb[1]) :: "memory");
        asm volatile("" : "+v"(oa.cf[0]), "+v"(oa.cf[1]), "+v"(oa.cf[2]), "+v"(oa.cf[3]), "+v"(oa.bf[0]), "+v"(oa.bf[1]), "+v"(oa.z[0]), "+v"(oa.z[1]) :: "memory");
        if (n > 0) put(n - 1);
        if (n + 2 < NCH) load_st(n + 2, sb);
        if (n + 1 < NCH) load_z(n + 1, ob);
        __builtin_amdgcn_sched_barrier(0);
        const float el = el_c, dec = dec_c;
        if (n + 1 < NCH) stage(sa, IMG0 + ((n + 1) & 1) * IMG);
        __builtin_amdgcn_sched_barrier(0);
        if (n + 1 < NCH) load_c(n + 1, ob);
        __builtin_amdgcn_sched_barrier(0);
        compute_y(n, oa, IMG0 + (n & 1) * IMG, el);
        __builtin_amdgcn_sched_barrier(0);
        if (n + 1 < NCH) load_b(n + 1, ob);
        __builtin_amdgcn_sched_barrier(0);
        compute_s(n, oa, IMG0 + (n & 1) * IMG, dec);
        LDS_BAR(); };
    SsdSt s0, s1; SsdOp o0, o1;
    load_st(0, s0); load_op(0, o0);
    stage(s0, IMG0);
    load_st(1, s1);
    LDS_BAR();
    for (int n = 0; n < NCH; n += 2) { step(n, s1, s0, o0, o1); step(n + 1, s0, s1, o1, o0); }
    put(NCH - 1);
}
#if MODE_MULTI && (NAIVE_MIX0 || NAIVE_MIX1)
__global__ void __launch_bounds__(256) naive_hgrn2(Mix0Args a) {
    __shared__ float red[8][32];
    const int u = blockIdx.x, tid = threadIdx.x, b = u >> 7, h = (u >> 2) & 31, vs = u & 3, v = tid & 31, dg = tid >> 5;
    float S[16], lb[16];
#pragma unroll
    for (int i = 0; i < 16; ++i) { S[i] = 0.f; const int col = h * 128 + dg * 16 + i; const float l0 = a.lb_logits[col], l1 = a.lb_logits[4096 + col], l2 = a.lb_logits[8192 + col];
        const float mx = fmaxf(l0, fmaxf(l1, l2)); const float e0 = expf(l0 - mx), e1 = expf(l1 - mx), e2 = expf(l2 - mx); lb[i] = e0 / (e0 + e1 + e2); }
    const float anw = a.a_norm_w[h * 128 + vs * 32 + v];
    for (int t = 0; t < SEQ; ++t) {
        bf16* row = a.proj + ((size_t)b * SEQ + t) * N1;
        const float vv = bf2f(row[C_I + h * 128 + vs * 32 + v]);
        float part = 0.f;
#pragma unroll
        for (int i = 0; i < 16; ++i) { const int d = h * 128 + dg * 16 + i; const float q = bf2f(row[C_Q + d]), z = bf2f(row[C_F + d]);
            const float sg = 1.0f / (1.0f + expf(-z)); const float fg = lb[i] + (1.0f - lb[i]) * sg; const float kk = (1.0f - lb[i]) * (1.0f - sg);
            S[i] = fg * S[i] + kk * vv; part += (q / (1.0f + expf(-q))) * S[i]; }
        red[dg][v] = part;
        __syncthreads();
        if (dg == 0) { float o = 0.f;
#pragma unroll
            for (int g = 0; g < 8; ++g) o += red[g][v];
            float ss = o * o;
#pragma unroll
            for (int off = 1; off < 32; off <<= 1) ss += __shfl_xor(ss, off);
            if (v == 0) unsafeAtomicAdd(a.ssq_a + (size_t)b * SEQ + t, ss);
            const float ga = bf2f(row[C_GA + h * 128 + vs * 32 + v]);
            row[C_I + h * 128 + vs * 32 + v] = (bf16)(pk2(o * anw * (ga / (1.0f + expf(-ga))), 0.f) & 0xffffu); }
        __syncthreads();
    }
}
__global__ void __launch_bounds__(256) naive_rglru(Mix0Args a) {
    __shared__ float xcs[128]; __shared__ float redr[8][32]; __shared__ float redi[8][32];
    const int u = blockIdx.x, tid = threadIdx.x, b = u >> 7, nb = (u >> 2) & 31, qq = u & 3, j = tid & 31, kg = tid >> 5, cb = nb * 128, co = cb + qq * 32 + j;
    float wa[16], wx[16];
#pragma unroll
    for (int i = 0; i < 16; ++i) { const size_t o = ((size_t)(nb * 128 + kg * 16 + i)) * 128 + qq * 32 + j; wa[i] = a.wa[o]; wx[i] = a.wx[o]; }
    const float bav = a.ba[co], bxv = a.bx[co], sp = log1pf(expf(-a.lam[co]));
    float hst = 0.f;
    for (int t = 0; t < SEQ; ++t) {
        const size_t rowi = (size_t)b * SEQ + t;
        if (tid < 128) { const int ch = cb + tid; float s = a.conv_b[ch];
#pragma unroll
            for (int k = 0; k < 4; ++k) { const int tt = t - 3 + k; if (tt >= 0) s += a.conv_w[k * 4096 + ch] * bf2f(a.proj[((size_t)b * SEQ + tt) * N1 + C_XB + ch]); }
            xcs[tid] = s; }
        __syncthreads();
        float pr = 0.f, pi = 0.f;
#pragma unroll
        for (int i = 0; i < 16; ++i) { const float x = xcs[kg * 16 + i]; pr += x * wa[i]; pi += x * wx[i]; }
        redr[kg][j] = pr; redi[kg][j] = pi;
        __syncthreads();
        if (kg == 0) { float R = bav, I = bxv;
#pragma unroll
            for (int g = 0; g < 8; ++g) { R += redr[g][j]; I += redi[g][j]; }
            const float r = 1.0f / (1.0f + expf(-R)), ig = 1.0f / (1.0f + expf(-I));
            const float la = -8.0f * r * sp; const float aa = expf(la); const float uu = sqrtf(-expm1f(2.0f * la)) * (ig * xcs[qq * 32 + j]);
            hst = aa * hst + uu;
            bf16* gp = a.proj + rowi * N1 + C_GB + co; const float gb = bf2f(*gp);
            *gp = (bf16)(pk2(hst * (gb / (1.0f + expf(-gb))), 0.f) & 0xffffu); }
        __syncthreads();
    }
}
__global__ void __launch_bounds__(256) naive_ssd(Mix1Args a) {
    __shared__ float xs[64]; __shared__ float red[4][32];
    const int u = blockIdx.x, tid = threadIdx.x, b = u >> 7, h = u & 127, g = h >> 4, k = tid & 127, pg = tid >> 7, wv = tid >> 6, lane = tid & 63;
    float S[32];
#pragma unroll
    for (int i = 0; i < 32; ++i) S[i] = 0.f;
    const float A = -expf(a.a_log[h]), dtb = a.dt_bias[h], Dh = a.d_skip[h];
    const int chb = 8192 + g * 128 + k, chc = 9216 + g * 128 + k;
    for (int t = 0; t < SEQ; ++t) {
        const size_t rowi = (size_t)b * SEQ + t;
        float sb = a.conv_b[chb], sc = a.conv_b[chc];
#pragma unroll
        for (int kk = 0; kk < 4; ++kk) { const int tt = t - 3 + kk; if (tt >= 0) { const bf16* r = a.proj + ((size_t)b * SEQ + tt) * N3P + C_X;
            sb += a.conv_w[kk * 10240 + chb] * bf2f(r[chb]); sc += a.conv_w[kk * 10240 + chc] * bf2f(r[chc]); } }
        const float Bv = sb / (1.0f + expf(-sb)), Cv = sc / (1.0f + expf(-sc));
        if (tid < 64) { const int chx = h * 64 + tid; float s = a.conv_b[chx];
#pragma unroll
            for (int kk = 0; kk < 4; ++kk) { const int tt = t - 3 + kk; if (tt >= 0) s += a.conv_w[kk * 10240 + chx] * bf2f(a.proj[((size_t)b * SEQ + tt) * N3P + C_X + chx]); }
            xs[tid] = s / (1.0f + expf(-s)); }
        const float xx = bf2f(a.proj[rowi * N3P + C_DT + h]) + dtb; const float dt = xx > 20.f ? xx : log1pf(expf(xx)); const float da = expf(dt * A);
        __syncthreads();
#pragma unroll
        for (int i = 0; i < 32; ++i) { S[i] = S[i] * da + dt * xs[pg * 32 + i] * Bv; float y = Cv * S[i];
#pragma unroll
            for (int off = 1; off < 64; off <<= 1) y += __shfl_xor(y, off);
            if (lane == 0) red[wv][i] = y; }
        __syncthreads();
        if (tid < 64) { const int p = tid; const float y = red[(p >> 5) * 2][p & 31] + red[(p >> 5) * 2 + 1][p & 31] + Dh * xs[p];
            bf16* zp = a.proj + rowi * N3P + C_Z + h * 64 + p; const float z = bf2f(*zp); const float yy = y * (z / (1.0f + expf(-z)));
            float ss = yy * yy;
#pragma unroll
            for (int off = 1; off < 64; off <<= 1) ss += __shfl_xor(ss, off);
            if (p == 0) unsafeAtomicAdd(a.ssq_y + rowi, ss);
            *zp = (bf16)(pk2(yy, 0.f) & 0xffffu); }
        __syncthreads();
    }
}
#endif
struct Args { const float* in[22]; float* out; unsigned char* ws; int ph_lo, ph_hi, dummy, pad; };
constexpr int NPHASE = 10;
__global__ void __launch_bounds__(512, 2) fwd(Args args) {
    extern __shared__ __attribute__((aligned(16))) unsigned char lds[];
    Frame F;
    F.lds = (LAS uchar*)lds;
    F.MISC = (volatile LAS unsigned*)(F.lds + MISC_OFF);
    F.tid = threadIdx.x; F.lane = F.tid & 63; F.wave = __builtin_amdgcn_readfirstlane(F.tid >> 6);
    F.G = gridDim.x; { const int bx = blockIdx.x; F.vcu = (F.G % 8 == 0) ? (bx % 8) * (F.G / 8) + bx / 8 : bx; }
    unsigned char* ws = args.ws;
    F.ctl = (unsigned*)(ws + WS_CTL);
    for (int u = F.tid; u < (LDS_BYTES - LDSCTL_OFF) / 4; u += 512) ((LAS unsigned*)(F.lds + LDSCTL_OFF))[u] = 0u;
    __syncthreads();
    const int lo = args.ph_lo, hi = args.ph_hi;
    XcdBarrier bar; bar.bar = F.ctl + CW_BAR; bar.x = 0; bar.st = nullptr;
    if (hi - lo > 1) bar = xcd_barrier_post(F.ctl + CW_BAR, F.MISC + 8);
#define IN(k) (lo <= (k) && (k) < hi)
#define BOTH(k) (IN(k) && IN((k) + 1))
    const float* x = args.in[0]; const float* norm_w = args.in[1];
    bf16* W1 = (bf16*)(ws + WS_W1); bf16* W2 = (bf16*)(ws + WS_W2); bf16* W3 = (bf16*)(ws + WS_W3); bf16* W4 = (bf16*)(ws + WS_W4);
    bf16* HN = (bf16*)(ws + WS_HN); bf16* PROJ = (bf16*)(ws + WS_PROJ);
    float* ssq_a = (float*)(F.ctl + CW_SSQA); float* ssq_h1 = (float*)(F.ctl + CW_SSQH1); float* ssq_y = (float*)(F.ctl + CW_SSQY); float* ssq_h2 = (float*)(F.ctl + CW_SSQH2);
    constexpr int NOJ = 1 << 30;
    const bool dmy = args.dummy != 0; float* ssq_dmy = (float*)(F.ctl + CW_DUMMY);

    if (IN(0)) { const P0Args pa{x, norm_w, args.in[2], args.in[12], args.in[13], args.in[20], W1, W2, W3, W4, HN};
        p0_prologue(F, pa); if (BOTH(0)) xcd_barrier(bar); }
    if (IN(1)) { pg8::Gemm g{HN, W1, M, N1, D, D, D, NOJ, 0, 0}; pg8::StaticOrder S; S.init(M, N1, F.G, (int)blockIdx.x);
        pg8::EpiBf16 E{PROJ, N1, nullptr};
        pg8::gemm_phase<pg8::EpiBf16, pg8::StaticOrder, true, true>(F.lds, g, S, E);
        if (BOTH(1)) xcd_barrier(bar); }
    if (IN(2) || IN(3)) { const Mix0Args ma{PROJ, args.in[3], args.in[4], args.in[5], args.in[6], args.in[7], args.in[8], args.in[9], args.in[10], args.in[11], dmy ? ssq_dmy : ssq_a,
            PROJ, N1, dmy ? C_F : C_I, dmy ? C_F : C_GB, (bf16*)(ws + WS_PG), (bf16*)(ws + WS_HN), (float*)(ws + WS_GL), dmy ? 1 : 0,
            CvJob{args.in[12], args.in[13], args.in[20], norm_w + D, args.in[19], W2, W3, W4}, (bf16*)(ws + WS_W1), (float*)(ws + WS_W1 + 128 * MiB)};
        if (IN(2)) { hgrn2_prep_all(F, ma); if (BOTH(2)) xcd_barrier(bar); }
        if (IN(3)) { for (int u = F.vcu; u < 256; u += F.G) hgrn2_scan_unit(F, ma, u);
                     for (int u = F.vcu; u < 256; u += F.G) rglru_scan_unit(F, ma, u); if (BOTH(3)) xcd_barrier(bar); } }
    if (IN(4)) { pg8::Gemm g{PROJ + C_I, W2, M, D, K2, N1, K2, 64, (long)(C_GB - C_I - 4096) * 2, 0}; pg8::StaticOrder S; S.init(M, D, F.G, (int)blockIdx.x, 4);
        pg8::EpiRes16 E{x, nullptr, HN, ssq_a, nullptr, dmy ? ssq_dmy : ssq_h1};
        pg8::gemm_phase<pg8::EpiRes16, pg8::StaticOrder, true, true>(F.lds, g, S, E);
        if (BOTH(4)) xcd_barrier(bar); }
    if (IN(5)) { { pg8::Gemm g{HN, W3, M, N3DT, D, D, D, NOJ, 0, 0}; pg8::StaticOrder S; S.init(M, N3DT, F.G, (int)blockIdx.x);
          pg8::EpiBf16 E{PROJ, N3P, ssq_h1};
          pg8::gemm_phase<pg8::EpiBf16, pg8::StaticOrder, true, true>(F.lds, g, S, E); }
        { pg8::Gemm g{HN, W3 + (size_t)N3DT * D, M, 256, 1024, D, D, NOJ, 0, 2048}; pg8::KSplitOrder S; S.init(M, F.G, (int)blockIdx.x);
          pg8::EpiDtPart E{(float*)(ws + WS_W1), ssq_h1};
          pg8::gemm_phase<pg8::EpiDtPart, pg8::KSplitOrder, true, true>(F.lds, g, S, E); }
        if (BOTH(5)) xcd_barrier(bar); }
    if (IN(6) || IN(7)) { const Mix1Args ma{PROJ, args.in[14], args.in[15], args.in[16], args.in[17], args.in[18], args.in[19], dmy ? ssq_dmy : ssq_y, dmy ? (bf16*)(ws + WS_DUMMY1) : PROJ, dmy ? 8192 : N3P, dmy ? 0 : C_Z,
            (bf16*)(ws + WS_PREP), (bf16*)(ws + WS_PREP + 32 * MiB), (bf16*)(ws + WS_PREP + 64 * MiB), (float*)(ws + WS_PREP + 80 * MiB), dmy ? (args.dummy >> 4) : 0, (const float*)(ws + WS_W1)};
        if (IN(6)) { for (int U = F.vcu; U < 2048; U += F.G) ssd_prep_unit(F, ma, U); if (BOTH(6)) xcd_barrier(bar); }
        if (IN(7)) { for (int u = F.vcu; u < 256; u += F.G) ssd_unit(F, ma, u); if (BOTH(7)) xcd_barrier(bar); } }
    const bool fuse_fin = (F.G == 256);
    if (IN(8)) { pg8::Gemm g{PROJ + C_Z, W4, M, D, K4, N3P, K4, NOJ, 0, 0};
        if (fuse_fin) { pg8::StaticOrder S; S.init(M, D, F.G, (int)blockIdx.x, 2);
            pg8::EpiFinal E{HN, dmy ? (float*)(ws + WS_DUMMY1) : args.out, args.in[21], ssq_y, dmy ? ssq_dmy : ssq_h2, F.ctl + CW_PANEL + (dmy ? 64 * 64 : 0), F.ctl + CW_CODE};
            pg8::gemm_phase<pg8::EpiFinal, pg8::StaticOrder, true, true>(F.lds, g, S, E); }
        else { pg8::StaticOrder S; S.init(M, D, F.G, (int)blockIdx.x, 4);
            pg8::EpiRes16 E{nullptr, HN, dmy ? (bf16*)(ws + WS_DUMMY1) : HN, nullptr, ssq_y, dmy ? ssq_dmy : ssq_h2};
            pg8::gemm_phase<pg8::EpiRes16, pg8::StaticOrder, true, true>(F.lds, g, S, E);
            if (BOTH(8)) xcd_barrier(bar); } }
    if (IN(9) && !fuse_fin) p7_final(F, HN, dmy ? (float*)(ws + WS_DUMMY1) : args.out, ssq_h2, args.in[21]);
#undef IN
#undef BOTH
}

extern "C" void kernel_launch(void* const* d_in, const int* in_sizes, int n_in, void* d_out, int out_size, void* d_ws, size_t ws_size, hipStream_t stream) {
    static int grid = 0;
    if (grid == 0) {
        if (n_in != 22 || out_size != M * D || ws_size < WS_END) { fprintf(stderr, "kernel_launch: unexpected problem (n_in %d out %d ws %zu)\n", n_in, out_size, ws_size); grid = -1; return; }
        int dev = 0, cus = 0, per_cu = 0;
        if (hipGetDevice(&dev) != hipSuccess || hipDeviceGetAttribute(&cus, hipDeviceAttributeMultiprocessorCount, dev) != hipSuccess) { grid = -1; return; }
        if (hipFuncSetAttribute((const void*)fwd, hipFuncAttributeMaxDynamicSharedMemorySize, LDS_BYTES) != hipSuccess) { fprintf(stderr, "kernel_launch: hipFuncSetAttribute failed\n"); grid = -1; return; }
        if (hipOccupancyMaxActiveBlocksPerMultiprocessor(&per_cu, (const void*)fwd, 512, LDS_BYTES) != hipSuccess || per_cu < 1) fprintf(stderr, "kernel_launch: occupancy query reports %d\n", per_cu);
        (void)hipGetLastError();
        grid = cus;
    }
    if (grid < 0) return;
    (void)hipMemsetAsync((char*)d_ws + WS_CTL, 0, CTL_ZERO_BYTES, stream);
    Args a{};
    for (int i = 0; i < 22; ++i) a.in[i] = (const float*)d_in[i];
    a.out = (float*)d_out; a.ws = (unsigned char*)d_ws;
#if MODE_MULTI
    for (int ph = 0; ph < NPHASE; ++ph) {
        a.ph_lo = ph; a.ph_hi = ph + 1;
#if NAIVE_MIX0
        if (ph == 2) continue;
        if (ph == 3) { const Mix0Args ma{(bf16*)((char*)d_ws + WS_PROJ), a.in[3], a.in[4], a.in[5], a.in[6], a.in[7], a.in[8], a.in[9], a.in[10], a.in[11], (float*)((char*)d_ws + WS_CTL) + CW_SSQA, (bf16*)((char*)d_ws + WS_PROJ), N1, C_I, C_GB, nullptr, nullptr, nullptr, 0, CvJob{}};
            hipLaunchKernelGGL(naive_hgrn2, dim3(256), dim3(256), 0, stream, ma); hipLaunchKernelGGL(naive_rglru, dim3(256), dim3(256), 0, stream, ma); continue; }
#endif
#if NAIVE_MIX1
        if (ph == 6) continue;
        if (ph == 7) { const Mix1Args ma{(bf16*)((char*)d_ws + WS_PROJ), a.in[14], a.in[15], a.in[16], a.in[17], a.in[18], a.in[19], (float*)((char*)d_ws + WS_CTL) + CW_SSQY, (bf16*)((char*)d_ws + WS_PROJ), N3P, C_Z, nullptr, nullptr, nullptr, nullptr, 0, nullptr};
            hipLaunchKernelGGL(naive_ssd, dim3(256), dim3(256), 0, stream, ma); continue; }
#endif
        if ((PROBE_REP >> ph) & 1) { a.dummy = 1 | (PROBE_VAR << 4); hipLaunchKernelGGL(fwd, dim3(grid), dim3(512), LDS_BYTES, stream, a); a.dummy = 0; }
        hipLaunchKernelGGL(fwd, dim3(grid), dim3(512), LDS_BYTES, stream, a);
    }
#else
    a.ph_lo = 0; a.ph_hi = NPHASE;
    hipLaunchKernelGGL(fwd, dim3(grid), dim3(512), LDS_BYTES, stream, a);
#endif
}
```
